# Optimizing an MI355X kernel written in HIP

```python
import math
import jax, jax.numpy as jnp
from jax import lax
import numpy as np

D_MODEL = 2048
BATCH = 2
SEQ = 8192
DEPTH = 4
DEC_BATCH = 8
DEC_SEQ = 4096
PAST_LEN = 128

D_MIX = D_MODEL
ATTN_WIDTH = D_MIX // 2
LRU_WIDTH = D_MIX - ATTN_WIDTH
HEAD_DIM = 128
N_HEADS = ATTN_WIDTH // HEAD_DIM
N_KV_HEADS = 2
GROUP = N_HEADS // N_KV_HEADS
KV_WIDTH = N_KV_HEADS * HEAD_DIM
WINDOW = 128
BLOCK = WINDOW
N_BUCKETS = 32
MAX_DISTANCE = 128
LRU_BLOCKS = 8
LRU_BLOCK_DIM = LRU_WIDTH // LRU_BLOCKS
LRU_CONV = 4
LRU_C = 8.0
D_FF = 3 * D_MODEL
FFN_CONV = 3
EPS = 1e-6
IN_COLS = ATTN_WIDTH + 2 * KV_WIDTH + 2 * LRU_WIDTH

kernel_name = "hymba_window_gqa_rglru_convglu_adaln_encoder"


def rmsnorm(x, g):
    xf = x.astype(jnp.float32)
    y = xf * lax.rsqrt(jnp.mean(xf * xf, axis=-1, keepdims=True) + EPS)
    return (y * g.astype(jnp.float32)).astype(x.dtype)


def dwconv(x, w, b, pad_left):
    K = w.shape[0]
    S = x.shape[1]
    xp = jnp.pad(x, ((0, 0), (pad_left, K - 1 - pad_left), (0, 0)))
    out = xp[:, 0:S] * w[0] + b
    for k in range(1, K):
        out = out + xp[:, k:k + S] * w[k]
    return out


def t5_bucket(rel):
    nb = N_BUCKETS // 2
    max_exact = nb // 2
    n = jnp.abs(rel)
    nf = jnp.maximum(n, 1).astype(jnp.float32)
    large = max_exact + (jnp.log(nf / max_exact) / math.log(MAX_DISTANCE / max_exact)
                         * (nb - max_exact)).astype(jnp.int32)
    large = jnp.minimum(large, nb - 1)
    return jnp.where(rel > 0, nb, 0) + jnp.where(n < max_exact, n, large)


def band_blocks(t, nb):
    B, S = t.shape[0], t.shape[1]
    tp = jnp.pad(t, ((0, 0), (WINDOW, WINDOW), (0, 0), (0, 0)))
    parts = [tp[:, o * BLOCK:o * BLOCK + S].reshape(B, nb, BLOCK, N_KV_HEADS, HEAD_DIM) for o in range(3)]
    return jnp.concatenate(parts, axis=2)


def windowed_attention(q, k, v, sink, rel_bias):
    B, S = q.shape[0], q.shape[1]
    nb = S // BLOCK
    qi = jnp.arange(BLOCK)[:, None]
    kj = jnp.arange(3 * BLOCK)[None, :]
    rel = kj - BLOCK - qi
    bias = rel_bias[t5_bucket(rel)].astype(jnp.float32)
    bias = jnp.transpose(bias, (2, 0, 1)).reshape(N_KV_HEADS, GROUP, BLOCK, 3 * BLOCK)
    kpos = jnp.arange(nb)[:, None] * BLOCK - BLOCK + jnp.arange(3 * BLOCK)[None, :]
    valid = (jnp.abs(rel) <= WINDOW)[None] & ((kpos >= 0) & (kpos < S))[:, None, :]
    mask = valid[None, :, None, None]

    qb = q.reshape(B, nb, BLOCK, N_KV_HEADS, GROUP, HEAD_DIM).astype(jnp.float32)
    kb = band_blocks(k, nb).astype(jnp.float32)
    vb = band_blocks(v, nb).astype(jnp.float32)
    s = jnp.einsum('bnqhgd,bnkhd->bnhgqk', qb, kb) * (HEAD_DIM ** -0.5) + bias
    s = jnp.where(mask, s, -1e30)
    sk = sink.astype(jnp.float32).reshape(N_KV_HEADS, GROUP, 1, 1)
    m = jnp.maximum(jnp.max(s, axis=-1, keepdims=True), sk)
    p = jnp.exp(s - m)
    denom = jnp.sum(p, axis=-1, keepdims=True) + jnp.exp(sk - m)
    o = jnp.einsum('bnhgqk,bnkhd->bnqhgd', p / denom, vb)
    return o.reshape(B, S, ATTN_WIDTH).astype(q.dtype)


def linear_combine(e1, e2):
    a1, b1 = e1
    a2, b2 = e2
    return (a1 * a2, a2 * b1 + b2)


def rglru_branch(xr, yg, conv_w, conv_b, w_a, b_a, w_x, b_x, lam):
    B, S = xr.shape[0], xr.shape[1]
    xc = dwconv(xr, conv_w, conv_b, LRU_CONV // 2).astype(jnp.float32)
    xb = xc.reshape(B, S, LRU_BLOCKS, LRU_BLOCK_DIM)
    r = jax.nn.sigmoid(jnp.einsum('bsnc,rncj->rbsnj', xb, w_a.astype(jnp.float32)).reshape(2, B, S, LRU_WIDTH)
                       + b_a.astype(jnp.float32)[:, None, None])
    ig = jax.nn.sigmoid(jnp.einsum('bsnc,rncj->rbsnj', xb, w_x.astype(jnp.float32)).reshape(2, B, S, LRU_WIDTH)
                        + b_x.astype(jnp.float32)[:, None, None])
    log_a = -LRU_C * r * jax.nn.softplus(-lam.astype(jnp.float32))[:, None, None]
    a = jnp.exp(log_a)
    b = jnp.sqrt(-jnp.expm1(2.0 * log_a)) * ig * xc[None]
    _, h_f = lax.associative_scan(linear_combine, (a[0], b[0]), axis=1)
    _, h_b = lax.associative_scan(linear_combine, (a[1], b[1]), axis=1, reverse=True)
    return ((h_f + h_b) * jax.nn.gelu(yg.astype(jnp.float32))).astype(xr.dtype)


def setup_inputs(seed: int = 0) -> dict:
    key = jax.random.key(seed)
    ks = jax.random.split(key, 32)

    def nrm(k, shape, scale):
        return jax.random.normal(k, shape, jnp.float32) * scale

    def gain(k, shape):
        return 1.0 + 0.02 * jax.random.normal(k, shape, jnp.float32)

    u = jax.random.uniform(ks[17], (DEPTH, 2, LRU_WIDTH), jnp.float32, minval=0.9, maxval=0.999)
    a0 = u ** (1.0 / LRU_C)
    lam = jnp.log(a0) - jnp.log1p(-a0)
    return {
        "x_prompt": nrm(ks[0], (BATCH, SEQ, D_MODEL), 1.0),
        "x_sample": nrm(ks[1], (DEC_BATCH, DEC_SEQ, D_MODEL), 1.0),
        "c_prompt": nrm(ks[2], (BATCH, D_MODEL), 1.0),
        "c_sample": nrm(ks[3], (DEC_BATCH, D_MODEL), 1.0),
        "rel_bias": nrm(ks[4], (N_BUCKETS, N_HEADS), 0.5),
        "w_mod": nrm(ks[5], (DEPTH, D_MODEL, 6 * D_MODEL), 0.5 * D_MODEL ** -0.5),
        "b_mod": nrm(ks[6], (DEPTH, 6 * D_MODEL), 0.01),
        "norm1_g": gain(ks[7], (DEPTH, D_MODEL)),
        "norm2_g": gain(ks[8], (DEPTH, D_MODEL)),
        "w_in": nrm(ks[9], (DEPTH, D_MODEL, IN_COLS), D_MODEL ** -0.5),
        "q_norm_g": gain(ks[10], (DEPTH, HEAD_DIM)),
        "k_norm_g": gain(ks[11], (DEPTH, HEAD_DIM)),
        "attn_sink": nrm(ks[12], (DEPTH, N_HEADS), 1.0),
        "lru_conv_w": nrm(ks[13], (DEPTH, LRU_CONV, LRU_WIDTH), LRU_CONV ** -0.5),
        "lru_conv_b": nrm(ks[14], (DEPTH, LRU_WIDTH), 0.01),
        "lru_w_a": nrm(ks[15], (DEPTH, 2, LRU_BLOCKS, LRU_BLOCK_DIM, LRU_BLOCK_DIM), LRU_BLOCK_DIM ** -0.5),
        "lru_b_a": nrm(ks[16], (DEPTH, 2, LRU_WIDTH), 0.01),
        "lru_w_x": nrm(ks[18], (DEPTH, 2, LRU_BLOCKS, LRU_BLOCK_DIM, LRU_BLOCK_DIM), LRU_BLOCK_DIM ** -0.5),
        "lru_b_x": nrm(ks[19], (DEPTH, 2, LRU_WIDTH), 0.01),
        "lru_lambda": lam,
        "attn_out_g": gain(ks[20], (DEPTH, ATTN_WIDTH)),
        "lru_out_g": gain(ks[21], (DEPTH, LRU_WIDTH)),
        "w_out": nrm(ks[22], (DEPTH, D_MIX, D_MODEL), D_MIX ** -0.5),
        "ffn_w_gate": nrm(ks[23], (DEPTH, D_MODEL, D_FF), D_MODEL ** -0.5),
        "ffn_w_up": nrm(ks[24], (DEPTH, D_MODEL, D_FF), D_MODEL ** -0.5),
        "ffn_conv_w": nrm(ks[25], (DEPTH, FFN_CONV, D_FF), FFN_CONV ** -0.5),
        "ffn_conv_b": nrm(ks[26], (DEPTH, D_FF), 0.01),
        "ffn_w_down": nrm(ks[27], (DEPTH, D_FF, D_MODEL), D_FF ** -0.5),
    }


def reference(x_prompt, x_sample, c_prompt, c_sample, rel_bias, w_mod, b_mod, norm1_g, norm2_g, w_in,
              q_norm_g, k_norm_g, attn_sink, lru_conv_w, lru_conv_b, lru_w_a, lru_b_a, lru_w_x, lru_b_x,
              lru_lambda, attn_out_g, lru_out_g, w_out, ffn_w_gate, ffn_w_up, ffn_conv_w, ffn_conv_b,
              ffn_w_down):
    split_at = [ATTN_WIDTH, ATTN_WIDTH + KV_WIDTH, ATTN_WIDTH + 2 * KV_WIDTH,
                ATTN_WIDTH + 2 * KV_WIDTH + LRU_WIDTH]

    def mixer(h, l):
        B, S = h.shape[0], h.shape[1]
        z = h @ w_in[l]
        q, k, v, xr, yg = jnp.split(z, split_at, axis=-1)
        q = rmsnorm(q.reshape(B, S, N_HEADS, HEAD_DIM), q_norm_g[l])
        k = rmsnorm(k.reshape(B, S, N_KV_HEADS, HEAD_DIM), k_norm_g[l])
        v = v.reshape(B, S, N_KV_HEADS, HEAD_DIM)
        attn = windowed_attention(q, k, v, attn_sink[l], rel_bias)
        lru = rglru_branch(xr, yg, lru_conv_w[l], lru_conv_b[l], lru_w_a[l], lru_b_a[l],
                           lru_w_x[l], lru_b_x[l], lru_lambda[l])
        merged = jnp.concatenate([rmsnorm(attn, attn_out_g[l]), rmsnorm(lru, lru_out_g[l])], axis=-1)
        return merged @ w_out[l]

    def ffn(h, l):
        g = dwconv(h @ ffn_w_gate[l], ffn_conv_w[l], ffn_conv_b[l], FFN_CONV // 2)
        u = h @ ffn_w_up[l]
        return (jax.nn.gelu(g) * u) @ ffn_w_down[l]

    def run(x, c):
        cs = jax.nn.silu(c)
        for l in range(DEPTH):
            mod = (cs @ w_mod[l] + b_mod[l])[:, None, :]
            sh1, sc1, g1, sh2, sc2, g2 = jnp.split(mod, 6, axis=-1)
            h = rmsnorm(x, norm1_g[l]) * (1.0 + sc1) + sh1
            x = x + g1 * mixer(h, l)
            h = rmsnorm(x, norm2_g[l]) * (1.0 + sc2) + sh2
            x = x + g2 * ffn(h, l)
        return x

    y_prompt = run(x_prompt, c_prompt)
    y_sample = run(x_sample, c_sample)
    return (y_prompt, y_sample)
```

```cpp
#include <hip/hip_runtime.h>
#include <cstdio>
#include <cstdint>
#define HYB 0
#define DBLMASK 0

namespace pg8 {
#define PG8_LAS __attribute__((address_space(3)))
typedef unsigned short bf16_t;
typedef short bf16x8 __attribute__((ext_vector_type(8)));
typedef float f32x4 __attribute__((ext_vector_type(4)));
typedef unsigned u32x4 __attribute__((ext_vector_type(4)));
constexpr int BM = 256, BK = 64, HALF = 128, HTB = HALF * BK * 2  , STAGE_BYTES = 8 * HTB, NXCD = 8, WGM = 4;

__host__ __device__ __forceinline__ int lds_byte(int r, int c) { const int st = (r >> 4) * 2 + (c >> 5), rr = r & 15, cc = c & 31, ob = rr * 64 + cc * 2; return st * 1024 + (ob ^ (((ob >> 9) & 1) << 5)); }
__host__ __device__ __forceinline__ void stage_rc(int b, int& R, int& C) { const int st = b / 1024, sb = b % 1024, swz = sb ^ (((sb >> 9) & 1) << 5); R = (st >> 1) * 16 + swz / 64; C = (st & 1) * 32 + (swz % 64) / 2; }
__host__ __device__ __forceinline__ int perm32(int rho) { const int n = rho >> 4, i = rho & 15; return 8 * (i >> 2) + 4 * n + (i & 3); }

struct Unit { int pm, pn; };
struct Gemm { const bf16_t* A; const bf16_t* Bt; int M, N, K; };

struct StaticOrder {
    int nM, nN, nwg, G, c;
    __host__ __device__ void init(int M, int N, int G_, int c_) { nM = M / BM; nN = N / BM; nwg = nM * nN; G = G_; c = c_; }
    __host__ __device__ bool next(int i, Unit& u) const {
        const long L = (long)i * G + c; if (L >= nwg) return false;
        int wgid = (int)L; { const int q = nwg / NXCD, r = nwg % NXCD, xcd = wgid % NXCD, off = wgid / NXCD; wgid = (xcd < r ? xcd * (q + 1) : r * (q + 1) + (xcd - r) * q) + off; }
        const int nig = WGM * nN, gid = wgid / nig, fm = gid * WGM, gsz = (nM - fm) < WGM ? (nM - fm) : WGM;
        u.pm = fm + ((wgid % nig) % gsz); u.pn = (wgid % nig) / gsz; return true;
    }
    __device__ __forceinline__ void a_ready(const Unit&) const {}
    __device__ __forceinline__ void done(const Unit&) const {}
};

__device__ __forceinline__ unsigned cvt_pk_bf16(float lo, float hi) { unsigned r; asm volatile("v_cvt_pk_bf16_f32 %0, %1, %2" : "=v"(r) : "v"(lo), "v"(hi)); return r; }
typedef float f32x2 __attribute__((ext_vector_type(2)));
typedef unsigned u32x2 __attribute__((ext_vector_type(2)));
constexpr int ROWS_P = 16384;
constexpr int MODSTRIDE = 12288;
__device__ __forceinline__ int batch_of_row(int row) { return row < ROWS_P ? (row >> 13) : 2 + ((row - ROWS_P) >> 12); }

struct EpiStoreBf16 {
    static constexpr bool PERM = true, AFTER_DRAIN = false, HAS_MID = false;
    bf16_t* O; int ldc;
    __device__ __forceinline__ void operator()(const f32x4 (&acc)[2][2][4][2], const Unit& u, int wr, int wc, int fr_, int fq_) const {
        int fr = fr_, fq = fq_; asm volatile("" : "+v"(fr), "+v"(fq));
        const int row0 = u.pm * BM + wr * 64 + fr, col0 = u.pn * BM + wc * 32 + 8 * fq;
#pragma unroll
        for (int ai = 0; ai < 2; ++ai)
#pragma unroll
            for (int m = 0; m < 4; ++m) { bf16_t* rowp = O + (size_t)(row0 + ai * HALF + m * 16) * ldc + col0;
#pragma unroll
                for (int bj = 0; bj < 2; ++bj) { const f32x4 v0 = acc[ai][bj][m][0], v1 = acc[ai][bj][m][1];
                    u32x4 w; w.x = cvt_pk_bf16(v0[0], v0[1]); w.y = cvt_pk_bf16(v0[2], v0[3]); w.z = cvt_pk_bf16(v1[0], v1[1]); w.w = cvt_pk_bf16(v1[2], v1[3]);
                    *(u32x4*)(rowp + bj * HALF) = w; } }
    }
};
struct EpiResid {
    static constexpr bool PERM = false, AFTER_DRAIN = false, HAS_MID = false;
    const float* base_p; const float* base_s; float* out; const float* gate; int row_off;
    __device__ __forceinline__ void operator()(const f32x4 (&acc)[2][2][4][2], const Unit& u, int wr, int wc, int fr_, int fq_) const {
        int fr = fr_, fq = fq_; asm volatile("" : "+v"(fr), "+v"(fq));
        const int grow0 = row_off + u.pm * BM; const int b = batch_of_row(grow0);
        const float* g = gate + (size_t)b * MODSTRIDE;
        const float* bt = grow0 < ROWS_P ? base_p + (size_t)grow0 * 2048 : base_s + (size_t)(grow0 - ROWS_P) * 2048;
        float* ot = out + (size_t)grow0 * 2048;
        const int col0 = u.pn * BM + wc * 32 + 4 * fq;
        f32x4 gv[2][2];
#pragma unroll
        for (int bj = 0; bj < 2; ++bj)
#pragma unroll
            for (int n = 0; n < 2; ++n) gv[bj][n] = *(const f32x4*)(g + col0 + bj * HALF + n * 16);
#pragma unroll
        for (int ai = 0; ai < 2; ++ai)
#pragma unroll
            for (int m = 0; m < 4; ++m) { const size_t off = (size_t)(wr * 64 + fr + ai * HALF + m * 16) * 2048 + col0;
#pragma unroll
                for (int bj = 0; bj < 2; ++bj)
#pragma unroll
                    for (int n = 0; n < 2; ++n) { const f32x4 bs = *(const f32x4*)(bt + off + bj * HALF + n * 16);
                        *(f32x4*)(ot + off + bj * HALF + n * 16) = bs + gv[bj][n] * acc[ai][bj][m][n]; }
                asm volatile("" ::: "memory"); }
    }
};
struct EpiStoreBf16N {
    static constexpr bool PERM = true, AFTER_DRAIN = false, HAS_MID = false;
    bf16_t* O; int ldc; const float* rstd; const float* bias;
    __device__ __forceinline__ void operator()(const f32x4 (&acc)[2][2][4][2], const Unit& u, int wr, int wc, int fr_, int fq_) const {
        int fr = fr_, fq = fq_; asm volatile("" : "+v"(fr), "+v"(fq));
        const int row0 = u.pm * BM + wr * 64 + fr, col0 = u.pn * BM + wc * 32 + 8 * fq;
        const float* bp = bias + (size_t)batch_of_row(u.pm * BM) * ldc + col0;
        f32x4 bv[2][2];
#pragma unroll
        for (int bj = 0; bj < 2; ++bj)
#pragma unroll
            for (int n = 0; n < 2; ++n) bv[bj][n] = *(const f32x4*)(bp + bj * HALF + 4 * n);
#pragma unroll
        for (int ai = 0; ai < 2; ++ai)
#pragma unroll
            for (int m = 0; m < 4; ++m) { const int r = row0 + ai * HALF + m * 16; const float rs = rstd[r]; bf16_t* rowp = O + (size_t)r * ldc + col0;
#pragma unroll
                for (int bj = 0; bj < 2; ++bj) { const f32x4 v0 = acc[ai][bj][m][0] * rs + bv[bj][0], v1 = acc[ai][bj][m][1] * rs + bv[bj][1];
                    u32x4 w; w.x = cvt_pk_bf16(v0[0], v0[1]); w.y = cvt_pk_bf16(v0[2], v0[3]); w.z = cvt_pk_bf16(v1[0], v1[1]); w.w = cvt_pk_bf16(v1[2], v1[3]);
                    *(u32x4*)(rowp + bj * HALF) = w; } }
    }
};
template <bool MID> struct EpiResid2 {
    static constexpr bool PERM = true, AFTER_DRAIN = false, HAS_MID = MID;
    _Float16* XR; float* out32; const float* gate; const float* gm; bf16_t* XG; float* SSQ; const float* ratio; const float* s2;
    __device__ __forceinline__ void mid(f32x4 (&acc)[2][2][4][2], const Unit& u, int wr, int fr) const {
        unsigned z_ = 0u; asm volatile("" : "+v"(z_)); const int fq = (int)__builtin_amdgcn_mbcnt_hi(~0u, __builtin_amdgcn_mbcnt_lo(~0u, z_)) >> 4, base = u.pm * BM + wr * 64 + fr + (fq >> 1) * HALF + (fq & 1) * 32;
        const float v0 = ratio[base], v1 = ratio[base + 16];
#pragma unroll
        for (int ai = 0; ai < 2; ++ai)
#pragma unroll
            for (int m = 0; m < 4; ++m) { const float r = __shfl((m & 1) ? v1 : v0, fr + 16 * (ai * 2 + (m >> 1)));
#pragma unroll
                for (int bj = 0; bj < 2; ++bj)
#pragma unroll
                    for (int n = 0; n < 2; ++n) acc[ai][bj][m][n] = acc[ai][bj][m][n] * r; }
    }
    __device__ __forceinline__ void operator()(const f32x4 (&acc)[2][2][4][2], const Unit& u, int wr, int wc, int fr_, int fq_) const {
        int fr = fr_, fq = fq_; asm volatile("" : "+v"(fr), "+v"(fq));
        typedef __attribute__((address_space(1))) const f32x4 gcf4; typedef __attribute__((address_space(1))) f32x4 gf4; typedef __attribute__((address_space(1))) u32x4 gu4; typedef _Float16 h16x8 __attribute__((ext_vector_type(8))); typedef __attribute__((address_space(1))) h16x8 gh8; typedef __attribute__((address_space(1))) const h16x8 gch8; typedef __attribute__((address_space(1))) float gf1;
        const int grow0 = u.pm * BM; const int b = batch_of_row(grow0);
        const float* g = gate + (size_t)b * MODSTRIDE;
        const size_t t0 = (size_t)grow0 * 2048;
        const int col0 = u.pn * BM + wc * 32 + 8 * fq;
        float ss[2][4], rs[2][4];
#pragma unroll
        for (int ai = 0; ai < 2; ++ai)
#pragma unroll
            for (int m = 0; m < 4; ++m) { ss[ai][m] = 0.f; rs[ai][m] = MID ? s2[grow0 + wr * 64 + fr + ai * HALF + m * 16] : 1.0f; }
#pragma unroll
        for (int bj = 0; bj < 2; ++bj) { const int co = col0 + bj * HALF;
            const f32x4 gv0 = *(gcf4*)(g + co), gv1 = *(gcf4*)(g + co + 4); f32x4 gm0 = (f32x4){0.f, 0.f, 0.f, 0.f}, gm1 = gm0; if (gm) { gm0 = *(gcf4*)(gm + (size_t)b * MODSTRIDE + co); gm1 = *(gcf4*)(gm + (size_t)b * MODSTRIDE + co + 4); }
#pragma unroll
            for (int ai = 0; ai < 2; ++ai) { h16x8 raw[4];
#pragma unroll
                for (int m = 0; m < 4; ++m) raw[m] = *(gch8*)(XR + t0 + (size_t)(wr * 64 + fr + ai * HALF + m * 16) * 2048 + co);
#pragma unroll
                for (int m = 0; m < 4; ++m) { const size_t off = t0 + (size_t)(wr * 64 + fr + ai * HALF + m * 16) * 2048 + co;
                    const f32x4 b0 = (f32x4){(float)raw[m][0], (float)raw[m][1], (float)raw[m][2], (float)raw[m][3]}, b1 = (f32x4){(float)raw[m][4], (float)raw[m][5], (float)raw[m][6], (float)raw[m][7]};
                    const f32x4 o0 = b0 + gv0 * (acc[ai][bj][m][0] * rs[ai][m]), o1 = b1 + gv1 * (acc[ai][bj][m][1] * rs[ai][m]);
                    if (out32) { *(gf4*)(out32 + off) = o0; *(gf4*)(out32 + off + 4) = o1; }
                    else { h16x8 w; w[0] = (_Float16)o0[0]; w[1] = (_Float16)o0[1]; w[2] = (_Float16)o0[2]; w[3] = (_Float16)o0[3]; w[4] = (_Float16)o1[0]; w[5] = (_Float16)o1[1]; w[6] = (_Float16)o1[2]; w[7] = (_Float16)o1[3]; *(gh8*)(XR + off) = w; }
                    if (gm) { const f32x4 x0 = o0 * gm0, x1 = o1 * gm1; ss[ai][m] += ((o0[0] * o0[0] + o0[1] * o0[1]) + (o0[2] * o0[2] + o0[3] * o0[3])) + ((o1[0] * o1[0] + o1[1] * o1[1]) + (o1[2] * o1[2] + o1[3] * o1[3]));
                        u32x4 w; w.x = cvt_pk_bf16(x0[0], x0[1]); w.y = cvt_pk_bf16(x0[2], x0[3]); w.z = cvt_pk_bf16(x1[0], x1[1]); w.w = cvt_pk_bf16(x1[2], x1[3]); *(gu4*)(XG + off) = w; } }
                asm volatile("" ::: "memory"); } }
        if (gm) {
#pragma unroll
            for (int ai = 0; ai < 2; ++ai)
#pragma unroll
                for (int m = 0; m < 4; ++m) { float s = ss[ai][m]; s += __shfl_xor(s, 16); s += __shfl_xor(s, 32); if (fq == 0) *(gf1*)(SSQ + (size_t)(grow0 + wr * 64 + fr + ai * HALF + m * 16) * 32 + u.pn * 4 + wc) = s; } }
    }
};
constexpr int GLU_BLOCKS = 802, GLU_TILES = 201;
struct GluMap {
    static constexpr bool UNIFORM = false;
    static __device__ __forceinline__ void block(int gb, int& base, int& t0, int& S) {
        if (gb < 266) { const int s = gb >= 133 ? 1 : 0; const int j = gb - 133 * s; base = s * 8192; t0 = 62 * j - 1; S = 8192; }
        else if (gb < GLU_BLOCKS) { const int g2 = gb - 266; const int s = g2 / 67, j = g2 - 67 * s; base = ROWS_P + s * 4096; t0 = 62 * j - 1; S = 4096; }
        else { base = 0; t0 = 0; S = 0; }
    }
    __device__ __forceinline__ unsigned rowq(int pm, int q, int r) const { int base, t0, S; block(4 * pm + q, base, t0, S); int t = t0 + r; t = t >= S ? S - 1 : t; t = t < 0 ? 0 : t; return (unsigned)(base + t); }
    __device__ __forceinline__ unsigned row(int pm, int R) const { int base, t0, S; block(4 * pm + (R >> 6), base, t0, S); int t = t0 + (R & 63); t = t >= S ? S - 1 : t; t = t < 0 ? 0 : t; return (unsigned)(base + t); }
};
template <int CTRL> __device__ __forceinline__ float dppf(float x) { return __builtin_bit_cast(float, __builtin_amdgcn_update_dpp(0, __builtin_bit_cast(int, x), CTRL, 0xf, 0xf, false)); }
__device__ __forceinline__ float gelu_tanh_f(float x) {
    const float u = x * (1.0f + 0.044715f * x * x); const float e = __builtin_amdgcn_exp2f(-2.302208198f * u);
    return x * __builtin_amdgcn_rcpf(1.0f + e);
}
struct EpiGLU {
    static constexpr bool PERM = true, AFTER_DRAIN = false, HAS_MID = false;
    bf16_t* act; const float* cw; const float* cb;
    const float* rstd; const float* bias;
    __device__ __forceinline__ void operator()(const f32x4 (&acc)[2][2][4][2], const Unit& u, int wr, int wc, int fr_, int fq_) const {
        int fr = fr_, fq = fq_; asm volatile("" : "+v"(fr), "+v"(fq));
        const int c0 = u.pn * HALF + wc * 32 + 8 * fq;
        f32x4 w0[2], w1[2], w2[2], bb[2];
#pragma unroll
        for (int n = 0; n < 2; ++n) { w0[n] = *(const f32x4*)(cw + c0 + 4 * n); w1[n] = *(const f32x4*)(cw + 6144 + c0 + 4 * n); w2[n] = *(const f32x4*)(cw + 2 * 6144 + c0 + 4 * n); bb[n] = *(const f32x4*)(cb + c0 + 4 * n); }
#pragma unroll
        for (int ai = 0; ai < 2; ++ai) {
            int base, t0, S; GluMap::block(4 * u.pm + 2 * ai + wr, base, t0, S);
            f32x4 gt[4][2], bg[2], bu[2]; float rs[4];
            { const float* bp = bias + (size_t)batch_of_row(base) * 12288 + u.pn * BM + wc * 32 + 8 * fq;
#pragma unroll
              for (int n = 0; n < 2; ++n) { bg[n] = *(const f32x4*)(bp + 4 * n); bu[n] = *(const f32x4*)(bp + HALF + 4 * n); } }
#pragma unroll
            for (int m = 0; m < 4; ++m) { const int tok = t0 + 16 * m + fr; const bool in = tok >= 0 && tok < S; int tc = tok >= S ? S - 1 : tok; tc = tc < 0 ? 0 : tc; rs[m] = rstd[base + tc];
#pragma unroll
                for (int n = 0; n < 2; ++n) gt[m][n] = in ? acc[ai][0][m][n] * rs[m] + bg[n] : (f32x4){0.f, 0.f, 0.f, 0.f}; }
#pragma unroll
            for (int m = 0; m < 4; ++m) { const int i = 16 * m + fr, tok = t0 + i; u32x4 w;
                unsigned pk[4];
#pragma unroll
                for (int n = 0; n < 2; ++n) { f32x4 pv, nx;
#pragma unroll
                    for (int e = 0; e < 4; ++e) {
                        const float rcur = dppf<0x121>(gt[m][n][e]), rprv = dppf<0x121>(gt[m > 0 ? m - 1 : 0][n][e]);
                        const float lcur = dppf<0x12F>(gt[m][n][e]), lnxt = dppf<0x12F>(gt[m < 3 ? m + 1 : 3][n][e]);
                        pv[e] = fr == 0 ? rprv : rcur; nx[e] = fr == 15 ? lnxt : lcur; }
                    const f32x4 g = w0[n] * pv + w1[n] * gt[m][n] + w2[n] * nx + bb[n];
                    const f32x4 up = acc[ai][1][m][n] * rs[m] + bu[n];
                    const float a0 = gelu_tanh_f(g[0]) * up[0], a1 = gelu_tanh_f(g[1]) * up[1], a2 = gelu_tanh_f(g[2]) * up[2], a3 = gelu_tanh_f(g[3]) * up[3];
                    pk[2 * n] = cvt_pk_bf16(a0, a1); pk[2 * n + 1] = cvt_pk_bf16(a2, a3); }
                w.x = pk[0]; w.y = pk[1]; w.z = pk[2]; w.w = pk[3];
                if (i >= 1 && i <= 62 && tok < S) *(u32x4*)(act + (size_t)(base + tok) * 6144 + c0) = w; }
        }
    }
};

struct EpiGLU2 {
    static constexpr bool PERM = true, AFTER_DRAIN = false, HAS_MID = false;
    bf16_t* act; const float* cw; const float* cb; const float* rstd; const float* bias; float* halo; PG8_LAS float* xch;
    __device__ __forceinline__ void operator()(const f32x4 (&acc)[2][2][4][2], const Unit& u, int wr, int wc, int fr_, int fq_) const {
        int fr = fr_, fq = fq_; asm volatile("" : "+v"(fr), "+v"(fq));
        const int lc = wc * 32 + 8 * fq, c0 = u.pn * HALF + lc;
        f32x4 w0[2], w1[2], w2[2], bb[2], bg[2], bu[2];
        { const float* bp = bias + (size_t)batch_of_row(u.pm * BM) * 12288 + u.pn * BM + lc;
#pragma unroll
          for (int n = 0; n < 2; ++n) { w0[n] = *(const f32x4*)(cw + c0 + 4 * n); w1[n] = *(const f32x4*)(cw + 6144 + c0 + 4 * n); w2[n] = *(const f32x4*)(cw + 2 * 6144 + c0 + 4 * n); bb[n] = *(const f32x4*)(cb + c0 + 4 * n);
              bg[n] = *(const f32x4*)(bp + 4 * n); bu[n] = *(const f32x4*)(bp + HALF + 4 * n); } }
        f32x4 gt[2][4][2]; float rs[2][4];
#pragma unroll
        for (int ai = 0; ai < 2; ++ai)
#pragma unroll
            for (int m = 0; m < 4; ++m) { rs[ai][m] = rstd[u.pm * BM + ai * HALF + wr * 64 + 16 * m + fr];
#pragma unroll
                for (int n = 0; n < 2; ++n) gt[ai][m][n] = acc[ai][0][m][n] * rs[ai][m] + bg[n]; }
#pragma unroll
        for (int ai = 0; ai < 2; ++ai) { const int blk = 2 * ai + wr;
#pragma unroll
            for (int n = 0; n < 2; ++n) { if (fr == 0) *(PG8_LAS f32x4*)(xch + (blk * 2 + 0) * HALF + lc + 4 * n) = gt[ai][0][n]; if (fr == 15) *(PG8_LAS f32x4*)(xch + (blk * 2 + 1) * HALF + lc + 4 * n) = gt[ai][3][n]; } }
        asm volatile("s_waitcnt lgkmcnt(0)" ::: "memory"); __builtin_amdgcn_s_barrier(); asm volatile("" ::: "memory");
#pragma unroll
        for (int ai = 0; ai < 2; ++ai) { const int blk = 2 * ai + wr; f32x4 pvb[2], nxb[2];
#pragma unroll
            for (int n = 0; n < 2; ++n) { pvb[n] = *(const PG8_LAS f32x4*)(xch + ((blk > 0 ? blk - 1 : 0) * 2 + 1) * HALF + lc + 4 * n); nxb[n] = *(const PG8_LAS f32x4*)(xch + ((blk < 3 ? blk + 1 : 3) * 2 + 0) * HALF + lc + 4 * n); }
#pragma unroll
            for (int m = 0; m < 4; ++m) { const int i = 16 * m + fr; u32x4 w; unsigned pk[4]; f32x4 upv[2];
#pragma unroll
                for (int n = 0; n < 2; ++n) { f32x4 pv, nx;
#pragma unroll
                    for (int e = 0; e < 4; ++e) {
                        const float rcur = dppf<0x121>(gt[ai][m][n][e]), rprv = m > 0 ? dppf<0x121>(gt[ai][m > 0 ? m - 1 : 0][n][e]) : pvb[n][e];
                        const float lcur = dppf<0x12F>(gt[ai][m][n][e]), lnxt = m < 3 ? dppf<0x12F>(gt[ai][m < 3 ? m + 1 : 3][n][e]) : nxb[n][e];
                        pv[e] = fr == 0 ? rprv : rcur; nx[e] = fr == 15 ? lnxt : lcur; }
                    const f32x4 g = w0[n] * pv + w1[n] * gt[ai][m][n] + w2[n] * nx + bb[n];
                    upv[n] = acc[ai][1][m][n] * rs[ai][m] + bu[n];
                    const float a0 = gelu_tanh_f(g[0]) * upv[n][0], a1 = gelu_tanh_f(g[1]) * upv[n][1], a2 = gelu_tanh_f(g[2]) * upv[n][2], a3 = gelu_tanh_f(g[3]) * upv[n][3];
                    pk[2 * n] = cvt_pk_bf16(a0, a1); pk[2 * n + 1] = cvt_pk_bf16(a2, a3); }
                w.x = pk[0]; w.y = pk[1]; w.z = pk[2]; w.w = pk[3];
                const int trow = 64 * blk + i;
                if (trow != 0 && trow != 255) __builtin_nontemporal_store(w, (u32x4*)(act + (size_t)(u.pm * BM + trow) * 6144 + c0));
                int slot = -1; if (trow == 0) slot = 0; else if (trow == 1) slot = 1; else if (trow == 254) slot = 2; else if (trow == 255) slot = 3;
                if (slot >= 0) { float* hp = halo + ((size_t)u.pm * 6 + slot) * 6144 + c0; *(f32x4*)hp = gt[ai][m][0]; *(f32x4*)(hp + 4) = gt[ai][m][1];
                    if (slot == 0 || slot == 3) { float* hu = halo + ((size_t)u.pm * 6 + (slot == 0 ? 4 : 5)) * 6144 + c0; *(f32x4*)hu = upv[0]; *(f32x4*)(hu + 4) = upv[1]; } } }
        }
    }
};
struct IdentMap { static constexpr bool UNIFORM = true; __device__ __forceinline__ unsigned row(int pm, int R) const { return (unsigned)(pm * BM + R); } __device__ __forceinline__ unsigned rowq(int pm, int q, int r) const { return (unsigned)(pm * BM + 64 * q + r); } };
template <class Epi, class Sched, class AMap>
__device__ __forceinline__ void gemm_phase(PG8_LAS unsigned char* lds, const Gemm g, const Sched& S, const Epi& E, const AMap& AM, int wave) {
    unsigned z_ = 0u; asm volatile("" : "+v"(z_)); const int ln_ = (int)__builtin_amdgcn_mbcnt_hi(~0u, __builtin_amdgcn_mbcnt_lo(~0u, z_)); const int tid_ = wave * 64 + ln_;
    const int tid = tid_, wid = wave, lane = ln_, wr = wid >> 2, wc = wid & 3, fr = lane & 15, fq = lane >> 4;
    const int K = g.K, nt = K / BK;
    int RA[2], CA[2]; unsigned voffB[2], voffA[2];
#pragma unroll
    for (int i = 0; i < 2; ++i) { int R, C; stage_rc(tid * 16 + i * 8192, R, C); const int Rb = Epi::PERM ? ((R & ~31) + perm32(R & 31)) : R; RA[i] = R; CA[i] = C; voffA[i] = (unsigned)(R * K + C) * 2u; voffB[i] = (unsigned)(Rb * K + C) * 2u; }
    const size_t kstep = (size_t)(BK * 2);
    const size_t qstep = (size_t)64 * K * 2;
    const size_t hstep = (size_t)HALF * K * 2;
    const size_t tstep = 2 * hstep;
    const unsigned ldsw = (unsigned)wid * 1024u;
    const int aoff = lds_byte(wr * 64 + fr, fq * 8), boff = lds_byte(wc * 32 + fr, fq * 8);
#define PG8_SA(b, h) (((b) * 2 + (h)) * HTB)
#define PG8_SB(b, h) ((4 + (b) * 2 + (h)) * HTB)
#define PG8_STAGE(bufoff, gbase, voff) do { _Pragma("unroll") for (int _i = 0; _i < 2; ++_i) \
        __builtin_amdgcn_global_load_lds((const unsigned*)((const char*)(gbase) + (size_t)_i * qstep + (voff)[0]), (PG8_LAS unsigned*)(lds + (bufoff) + ldsw + _i * 8192), 16, 0, 0); } while (0)
#define PG8_LDA(dst, b, h) do { _Pragma("unroll") for (int m = 0; m < 4; ++m) _Pragma("unroll") for (int k = 0; k < 2; ++k) dst[m][k] = *(const PG8_LAS bf16x8*)(lds + PG8_SA(b, h) + aoff + m * 2048 + k * 1024); } while (0)
#define PG8_LDB(dst, b, h) do { _Pragma("unroll") for (int n = 0; n < 2; ++n) _Pragma("unroll") for (int k = 0; k < 2; ++k) dst[n][k] = *(const PG8_LAS bf16x8*)(lds + PG8_SB(b, h) + boff + n * 2048 + k * 1024); } while (0)
#define PG8_MMA(ai, bj, At, Bt) do { __builtin_amdgcn_s_setprio(1); _Pragma("unroll") for (int m = 0; m < 4; ++m) _Pragma("unroll") for (int n = 0; n < 2; ++n) _Pragma("unroll") for (int k = 0; k < 2; ++k) \
        acc[ai][bj][m][n] = __builtin_amdgcn_mfma_f32_16x16x32_bf16(Bt[n][k], At[m][k], acc[ai][bj][m][n], 0, 0, 0); __builtin_amdgcn_s_setprio(0); } while (0)
#define PG8_WAIT_V(n) asm volatile("s_waitcnt vmcnt(" #n ")" ::: "memory")
#define PG8_WAIT_L(n) asm volatile("s_waitcnt lgkmcnt(" #n ")" ::: "memory")
#define PG8_BAR __builtin_amdgcn_s_barrier()
#define PG8_SCHED __builtin_amdgcn_sched_barrier(0)
#define PG8_STAGE_A(bufoff, kb, h, NX) do { if constexpr (AMap::UNIFORM) { const char* _b = ((NX) ? nA : cA) + (kb) + (h) * hstep; PG8_STAGE(bufoff, _b, voffA); } \
        else { unsigned _o[2]; _o[0] = (NX) ? offN[h][0] : offC[h][0]; _o[1] = (NX) ? offN[h][1] : offC[h][1]; PG8_STAGE(bufoff, Ab + (kb), _o); } } while (0)
#define PG8_OFFS(dst, pm) do { _Pragma("unroll") for (int _h = 0; _h < 2; ++_h) _Pragma("unroll") for (int _i = 0; _i < 2; ++_i) dst[_h][_i] = (AM.rowq((pm), 2 * _h + _i, RA[_i] & 63) * (unsigned)K + (unsigned)CA[_i]) * 2u; } while (0)
    Unit cur, nxt; int ui = 0;
    if (!S.next(0, cur)) return;
    f32x4 acc[2][2][4][2];
#pragma unroll
    for (int a = 0; a < 2; ++a)
#pragma unroll
        for (int b = 0; b < 2; ++b)
#pragma unroll
            for (int m = 0; m < 4; ++m)
#pragma unroll
                for (int n = 0; n < 2; ++n) acc[a][b][m][n] = (f32x4){0.f, 0.f, 0.f, 0.f};
    bf16x8 At[4][2], B0[2][2], B1[2][2];
    unsigned offC[2][2], offN[2][2];
    if constexpr (!AMap::UNIFORM) { PG8_OFFS(offC, cur.pm); }
    const char* const Ab = (const char*)g.A;
    const char* cA = (const char*)g.A + (size_t)cur.pm * tstep; const char* nA = cA;
    const char* cB = (const char*)g.Bt + (size_t)cur.pn * tstep;
    S.a_ready(cur);
    PG8_STAGE(PG8_SB(0, 0), cB, voffB); PG8_STAGE(PG8_SB(0, 1), cB + hstep, voffB); PG8_STAGE_A(PG8_SA(0, 0), 0, 0, false); PG8_STAGE_A(PG8_SA(0, 1), 0, 1, false);
    if (wr == 1) PG8_BAR;
    PG8_WAIT_V(2); PG8_BAR;
    PG8_STAGE(PG8_SB(1, 0), cB + kstep, voffB); PG8_STAGE_A(PG8_SA(1, 0), kstep, 0, false); PG8_STAGE(PG8_SB(1, 1), cB + hstep + kstep, voffB);
    PG8_WAIT_V(6); PG8_BAR;
    for (;;) {
        const bool has_next = S.next(ui + 1, nxt);
        const char* nB = has_next ? (const char*)g.Bt + (size_t)nxt.pn * tstep : cB;
        if constexpr (AMap::UNIFORM) { nA = has_next ? (const char*)g.A + (size_t)nxt.pm * tstep : cA; }
        else { if (has_next) { PG8_OFFS(offN, nxt.pm); } else {
#pragma unroll
            for (int _h = 0; _h < 2; ++_h)
#pragma unroll
                for (int _i = 0; _i < 2; ++_i) offN[_h][_i] = offC[_h][_i]; } }
        for (int t = 0; t < nt; t += 2) {
            const bool last = (t == nt - 2);
            const size_t k1 = (size_t)(t + 1) * kstep, k2 = last ? (size_t)0 : (size_t)(t + 2) * kstep, k3 = k2 + kstep;
            const char* b2 = last ? nB : cB + (size_t)(t + 2) * kstep; const char* b3 = b2 + kstep;
            if (last && has_next) S.a_ready(nxt);
            if constexpr (Epi::HAS_MID) { if (t == nt / 2) E.mid(acc, cur, wr, fr); }
            PG8_LDB(B0, 0, 0); PG8_LDB(B1, 0, 1); PG8_SCHED; PG8_LDA(At, 0, 0); PG8_STAGE_A(PG8_SA(1, 1), k1, 1, false);
            PG8_WAIT_V(8); PG8_WAIT_L(0); PG8_BAR; PG8_MMA(0, 0, At, B0); PG8_MMA(0, 1, At, B1); PG8_BAR; PG8_SCHED;
            PG8_LDA(At, 0, 1); PG8_STAGE(PG8_SB(0, 0), b2, voffB); PG8_STAGE(PG8_SB(0, 1), b2 + hstep, voffB); PG8_STAGE_A(PG8_SA(0, 0), k2, 0, last);
            PG8_WAIT_V(8); PG8_WAIT_L(0); PG8_BAR; PG8_MMA(1, 0, At, B0); PG8_MMA(1, 1, At, B1); PG8_BAR; PG8_SCHED;
            PG8_LDB(B0, 1, 0); PG8_LDB(B1, 1, 1); PG8_SCHED; PG8_LDA(At, 1, 0); PG8_STAGE_A(PG8_SA(0, 1), k2, 1, last);
            PG8_WAIT_V(8); PG8_WAIT_L(0); PG8_BAR; PG8_MMA(0, 0, At, B0); PG8_MMA(0, 1, At, B1); PG8_BAR; PG8_SCHED;
            PG8_LDA(At, 1, 1); PG8_STAGE(PG8_SB(1, 0), b3, voffB); PG8_STAGE(PG8_SB(1, 1), b3 + hstep, voffB); PG8_STAGE_A(PG8_SA(1, 0), k3, 0, last);
            PG8_WAIT_V(8); PG8_WAIT_L(0); PG8_BAR; PG8_MMA(1, 0, At, B0); PG8_MMA(1, 1, At, B1); PG8_BAR; PG8_SCHED;
        }
        if (wr == 0) PG8_BAR;
        E(acc, cur, wr, wc, fr, fq); S.done(cur);
        if (!has_next) break;
#pragma unroll
        for (int a = 0; a < 2; ++a)
#pragma unroll
            for (int b = 0; b < 2; ++b)
#pragma unroll
                for (int m = 0; m < 4; ++m)
#pragma unroll
                    for (int n = 0; n < 2; ++n) acc[a][b][m][n] = (f32x4){0.f, 0.f, 0.f, 0.f};
        cur = nxt; cB = nB; cA = nA; ++ui;
        if constexpr (!AMap::UNIFORM) {
#pragma unroll
        for (int _h = 0; _h < 2; ++_h)
#pragma unroll
            for (int _i = 0; _i < 2; ++_i) offC[_h][_i] = offN[_h][_i]; }
        if (wr == 1) PG8_BAR;
    }
    PG8_WAIT_V(0);
    PG8_BAR;
#undef PG8_SA
#undef PG8_SB
#undef PG8_STAGE
#undef PG8_LDA
#undef PG8_LDB
#undef PG8_MMA
#undef PG8_WAIT_V
#undef PG8_WAIT_L
#undef PG8_BAR
#undef PG8_SCHED
#undef PG8_OFFS
#undef PG8_STAGE_A
}
}

#define LAS __attribute__((address_space(3)))
typedef unsigned short bf16_t;
typedef float f32x4 __attribute__((ext_vector_type(4)));
typedef float f32x2 __attribute__((ext_vector_type(2)));
typedef unsigned u32x4 __attribute__((ext_vector_type(4)));
typedef unsigned u32x2 __attribute__((ext_vector_type(2)));
typedef short bf16x8 __attribute__((ext_vector_type(8)));
typedef short s16x4 __attribute__((ext_vector_type(4)));
constexpr int D = 2048, T = 49152, ROWS_P = 16384, NB = 10, DEPTH = 4;
constexpr int ZC = 3584, ZQ = 0, ZK = 1024, ZV = 1280, ZX = 1536, ZY = 2560;
constexpr int DFF = 6144, MODSTRIDE = 12288;
constexpr float EPS = 1e-6f;
constexpr size_t MiB = 1u << 20;
constexpr size_t WS_CTL = 0, CTL_ZERO_BYTES = 64 * 1024, WS_MOD = 1 * MiB, WS_SUM = 3 * MiB  , WS_CAR = 9 * MiB  , WS_LW = 12 * MiB  ,
                 WS_WIN = 16 * MiB, WS_WOUT = 72 * MiB, WS_WGU = 104 * MiB, WS_WDN = 296 * MiB, WS_H = 392 * MiB, WS_Z = 584 * MiB,
                 WS_ATT = 920 * MiB, WS_LRU = 1016 * MiB, WS_AB = 1112 * MiB, WS_LC = 1112 * MiB  ,
                 WS_SSQX = 1496 * MiB  , WS_SSQA = 1502 * MiB  , WS_SSQL = 1503 * MiB + 512 * 1024, WS_RSTD = 1505 * MiB, WS_RATIO = 1505 * MiB + 256 * 1024, WS_S2 = 1505 * MiB + 512 * 1024,
                 WS_BIN = 1506 * MiB  , WS_BGU = 1507 * MiB  , WS_END = 1510 * MiB;
constexpr size_t WS_XR = 1160 * MiB;
constexpr size_t WS_HALO = 1352 * MiB;
constexpr size_t WS_MRG = WS_ATT;
constexpr size_t WS_LSP = 3 * MiB - 65536;
constexpr size_t WS_ACT = WS_Z;
constexpr size_t WS_GUC = WS_Z, WS_ACTC = WS_Z + 192 * MiB;
static_assert(WS_ACT + (size_t)T * DFF * 2 <= WS_XR && WS_XR + (size_t)T * D * 2 <= WS_HALO && WS_HALO + (size_t)192 * 6 * DFF * 4 <= WS_SSQX, "act overlay / residual stream / halo");
constexpr int LDS_BYTES = 147456, LDS_CTL = LDS_BYTES - 256;
constexpr int NWAVES = 8;
constexpr int CW_BAR = 1024;

__device__ __forceinline__ void rowinfo(int row, int& b, int& t, int& S) { if (row < ROWS_P) { b = row >> 13; t = row & 8191; S = 8192; } else { const int r = row - ROWS_P; b = 2 + (r >> 12); t = r & 4095; S = 4096; } }
__device__ __forceinline__ float bf2f(unsigned short u) { return __uint_as_float(((unsigned)u) << 16); }
__device__ __forceinline__ float bflo(unsigned w) { return __uint_as_float(w << 16); }
__device__ __forceinline__ float bfhi(unsigned w) { return __uint_as_float(w & 0xffff0000u); }
__device__ __forceinline__ unsigned f2bf(float f) { unsigned u = __float_as_uint(f); return (u + 0x7fffu + ((u >> 16) & 1u)) >> 16; }
__device__ __forceinline__ unsigned pk2(float lo, float hi) { return f2bf(lo) | (f2bf(hi) << 16); }
__device__ __forceinline__ float wave_sum(float v) {
#pragma unroll
    for (int o = 1; o < 64; o <<= 1) v += __shfl_xor(v, o);
    return v; }
__device__ __forceinline__ float wave_max(float v) {
#pragma unroll
    for (int o = 1; o < 64; o <<= 1) v = fmaxf(v, __shfl_xor(v, o));
    return v; }
__device__ __forceinline__ float gelu_tanh(float x) { const float u = 0.7978845608028654f * (x + 0.044715f * x * x * x); return x / (1.0f + __expf(-2.0f * u)); }
__device__ __forceinline__ float sigmoidf(float x) { return 1.0f / (1.0f + __expf(-x)); }
#define LDS_WAIT() asm volatile("s_waitcnt lgkmcnt(0)" ::: "memory")
#define VM_WAIT() asm volatile("s_waitcnt vmcnt(0)" ::: "memory")
#define WG_BAR() do { asm volatile("s_waitcnt vmcnt(0) lgkmcnt(0)" ::: "memory"); __builtin_amdgcn_s_barrier(); asm volatile("" ::: "memory"); } while (0)

__device__ __forceinline__ unsigned char* ws_now(unsigned char* p) { asm volatile("" : "+s"(p)); return p; }
__device__ __forceinline__ int lane_id() { unsigned z = 0u; asm volatile("" : "+v"(z)); return (int)__builtin_amdgcn_mbcnt_hi(~0u, __builtin_amdgcn_mbcnt_lo(~0u, z)); }
#define XB_TMO      128
#define XB_XCNT(j)  (256  + 64 * (j))
#define XB_XSUB(j)  (1280 + 64 * (j))
#define XB_XGEN(j)  (2304 + 64 * (j))
#define XB_TOP      3328
#define XB_TOPGEN   3392
#define XCD_BAR_WORDS 3456
#define XB_SPIN_CAP (1u << 18)

__device__ __forceinline__ unsigned xb_ld(unsigned* p)              { return __hip_atomic_load(p, __ATOMIC_RELAXED, __HIP_MEMORY_SCOPE_AGENT); }
__device__ __forceinline__ unsigned xb_add(unsigned* p, unsigned v) { return __hip_atomic_fetch_add(p, v, __ATOMIC_RELAXED, __HIP_MEMORY_SCOPE_AGENT); }
__device__ __forceinline__ unsigned xb_xcc_id() { return (unsigned)__builtin_amdgcn_s_getreg((3 << 11) | 20) & 0xFu; }
#define XB_SPIN(cond, bar) do { unsigned _sp = 0; while (cond) { __builtin_amdgcn_s_sleep(1); \
    if ((++_sp & 255u) == 0u) { if (xb_ld(&(bar)[XB_TMO])) break; if (_sp > XB_SPIN_CAP) { atomicAdd(&(bar)[XB_TMO], 1u); break; } } } } while (0)

struct XcdBarrier {
    unsigned* bar; unsigned x; int wv;
    volatile LAS unsigned* st;
};

__device__ __forceinline__ XcdBarrier xcd_barrier_post(unsigned* bar, volatile LAS unsigned* st, int wv) {
    XcdBarrier b; b.bar = bar; b.x = xb_xcc_id(); b.st = st; b.wv = wv;
    if (wv == 0 && lane_id() == 0) (void)xb_add(&bar[XB_XCNT(b.x)], 1u);
    return b;
}
__device__ __forceinline__ void xcd_barrier_complete(unsigned* bar, unsigned x, unsigned& nloc, unsigned& nx) {
    const unsigned G = gridDim.x * gridDim.y * gridDim.z;
    unsigned sum, cnt, mine, sp = 0u;
    for (;;) {
        sum = 0u; cnt = 0u; mine = 0u;
#pragma unroll
        for (unsigned j = 0; j < 16; ++j) { const unsigned c = xb_ld(&bar[XB_XCNT(j)]); sum += c; cnt += (c > 0u) ? 1u : 0u; mine = (j == x) ? c : mine; }
        if (sum == G) break;
        __builtin_amdgcn_s_sleep(1);
        if ((++sp & 255u) == 0u) { if (xb_ld(&bar[XB_TMO])) break; if (sp > XB_SPIN_CAP) { atomicAdd(&bar[XB_TMO], 1u); break; } }
    }
    nloc = mine > 0u ? mine : 1u; nx = cnt > 0u ? cnt : 1u;
}

__device__ __forceinline__ void xcd_barrier(const XcdBarrier& b) {
    asm volatile("s_waitcnt vmcnt(0)" ::: "memory");
    __syncthreads();
    if (b.wv == 0 && lane_id() == 0) {
        unsigned* bar = b.bar; asm volatile("" : "+s"(bar));
        __builtin_amdgcn_s_waitcnt(0);
        unsigned nloc = b.st[0], nx = b.st[1];
        if (nloc == 0u) { xcd_barrier_complete(bar, b.x, nloc, nx); b.st[0] = nloc; b.st[1] = nx; }
        const unsigned old = xb_add(&bar[XB_XSUB(b.x)], 1u);
        const unsigned gen = old / nloc;
        if (old + 1u == (gen + 1u) * nloc) {
            __builtin_amdgcn_fence(__ATOMIC_RELEASE, "agent");
            asm volatile("s_waitcnt vmcnt(0)" ::: "memory");
            const unsigned og = xb_add(&bar[XB_TOP], 1u);
            const unsigned tg = og / nx;
            if (og + 1u == (tg + 1u) * nx) xb_add(&bar[XB_TOPGEN], 1u);
            else XB_SPIN(xb_ld(&bar[XB_TOPGEN]) == tg, bar);
            __builtin_amdgcn_fence(__ATOMIC_ACQUIRE, "agent");
            xb_add(&bar[XB_XGEN(b.x)], 1u);
            asm volatile("s_waitcnt vmcnt(0)" ::: "memory");
        } else {
            XB_SPIN(xb_ld(&bar[XB_XGEN(b.x)]) == gen, bar);
            __builtin_amdgcn_fence(__ATOMIC_ACQUIRE, "agent");
            asm volatile("s_waitcnt vmcnt(0)" ::: "memory");
        }
    }
    __syncthreads();
}

struct Args { const float* in[28]; float* out; unsigned char* ws; int ph_lo, ph_hi, flags, pad; };
struct Frame {
    LAS unsigned char* lds; int tid, lane, wave, G, bid;
};
#define KAS __attribute__((address_space(4)))
__device__ __forceinline__ const KAS unsigned char* karg_base() { const KAS unsigned char* p = (const KAS unsigned char*)__builtin_amdgcn_kernarg_segment_ptr(); asm volatile("" : "+s"(p)); return p; }
__device__ __forceinline__ const float* karg_in(int k) { return *(const float* const KAS*)(karg_base() + 8 * k); }
__device__ __forceinline__ float* karg_out() { return *(float* const KAS*)(karg_base() + 8 * 28); }
__device__ __forceinline__ unsigned char* karg_ws() { return *(unsigned char* const KAS*)(karg_base() + 8 * 29); }
#define INP(k) (karg_in(k))
__device__ __forceinline__ Frame fresh(const Frame& F0) { Frame F = F0; int ln = lane_id(); asm volatile("" : "+v"(ln)); F.lane = ln; F.tid = F0.wave * 64 + ln; return F; }

__device__ __forceinline__ void p0_transpose_item(const float* W, int K, int N, bf16_t* WT, int mode, LAS float* scr, int item, int lane, const float* ks0 = nullptr, const float* ks1 = nullptr) {
    const int nblk = N / 64, kb = item / nblk, nb = item % nblk, k0 = 64 * kb, n0 = 64 * nb;
    const int drow0 = mode == 0 ? n0 : ((n0 >> 7) * 256 + (n0 & 127) + (mode == 2 ? 128 : 0));
    f32x4 v[16];
#pragma unroll
    for (int i = 0; i < 16; ++i) v[i] = *(const f32x4*)(W + (size_t)(k0 + 4 * i + (lane >> 4)) * N + n0 + 4 * (lane & 15));
#pragma unroll
    for (int i = 0; i < 16; ++i) { const int kk = 4 * i + (lane >> 4); float sc = 1.0f; if (ks0) sc = (k0 + kk < 1024 ? ks0[k0 + kk] : ks1[k0 + kk - 1024]);
        LAS float* d = scr + kk * 65 + 4 * (lane & 15); d[0] = v[i].x * sc; d[1] = v[i].y * sc; d[2] = v[i].z * sc; d[3] = v[i].w * sc; }
    LDS_WAIT(); asm volatile("" ::: "memory");
    const int c = lane & 7;
#pragma unroll
    for (int j = 0; j < 8; ++j) { const int n = (lane >> 3) + 8 * j; const LAS float* s = scr + (8 * c) * 65 + n;
        u32x4 o; o.x = pk2(s[0 * 65], s[1 * 65]); o.y = pk2(s[2 * 65], s[3 * 65]); o.z = pk2(s[4 * 65], s[5 * 65]); o.w = pk2(s[6 * 65], s[7 * 65]);
        *(u32x4*)(WT + (size_t)(drow0 + n) * K + k0 + 8 * c) = o; }
    LDS_WAIT(); asm volatile("" ::: "memory");
}
__device__ __forceinline__ void phase_prologue(const Frame& F0, const Args& a) { const Frame F = fresh(F0);
    unsigned char* ws = karg_ws();
    bf16_t* WIN = (bf16_t*)(ws + WS_WIN); bf16_t* WOUT = (bf16_t*)(ws + WS_WOUT); bf16_t* WGU = (bf16_t*)(ws + WS_WGU); bf16_t* WDN = (bf16_t*)(ws + WS_WDN);
    LAS float* scr = (LAS float*)(F.lds + F.wave * 16640);
    const int gw = F.bid * NWAVES + F.wave, NGW = F.G * NWAVES;
    constexpr int I_IN = (D / 64) * (ZC / 64), I_OUT = (D / 64) * (D / 64), I_G = (D / 64) * (DFF / 64), I_D = (DFF / 64) * (D / 64), I_L = I_IN + I_OUT + 2 * I_G + I_D;
    for (int it = gw; it < DEPTH * I_L; it += NGW) { const int l = it / I_L; int r = it - l * I_L;
        if (r < I_IN) { p0_transpose_item(INP(9) + (size_t)l * D * ZC, D, ZC, WIN + (size_t)l * ZC * D, 0, scr, r, F.lane); continue; } r -= I_IN;
        if (r < I_OUT) { p0_transpose_item(INP(22) + (size_t)l * D * D, D, D, WOUT + (size_t)l * D * D, 0, scr, r, F.lane, INP(20) + l * 1024, INP(21) + l * 1024); continue; } r -= I_OUT;
        if (r < I_G) { p0_transpose_item(INP(23) + (size_t)l * D * DFF, D, DFF, WGU + (size_t)l * 2 * DFF * D, 1, scr, r, F.lane); continue; } r -= I_G;
        if (r < I_G) { p0_transpose_item(INP(24) + (size_t)l * D * DFF, D, DFF, WGU + (size_t)l * 2 * DFF * D, 2, scr, r, F.lane); continue; } r -= I_G;
        p0_transpose_item(INP(27) + (size_t)l * DFF * D, DFF, D, WDN + (size_t)l * D * DFF, 0, scr, r, F.lane); }
    { bf16_t* LW = (bf16_t*)(ws + WS_LW);
      for (int it = gw; it < DEPTH * 8 * 8 * 16; it += NGW) { const int ks = it & 3, gs = (it >> 2) & 3, w = (it >> 4) & 7, n = (it >> 7) & 7, l = it >> 10;
          const float* src = (gs < 2 ? INP(15) : INP(17)) + ((size_t)((l * 2 + (gs & 1)) * 8 + n) * 128) * 128;
          const int c0 = 32 * ks + 8 * (F.lane >> 4), jc = 16 * w + (F.lane & 15); float v[8];
#pragma unroll
          for (int j = 0; j < 8; ++j) v[j] = src[(size_t)(c0 + j) * 128 + jc];
          u32x4 o; o.x = pk2(v[0], v[1]); o.y = pk2(v[2], v[3]); o.z = pk2(v[4], v[5]); o.w = pk2(v[6], v[7]);
          *(u32x4*)(LW + ((size_t)it * 64 + F.lane) * 8) = o; } }
    { float* LSP = (float*)(ws + WS_LSP); for (int i = F.bid * 512 + F.tid; i < DEPTH * 2048; i += F.G * 512) LSP[i] = log1pf(expf(-INP(19)[i])); }
    WG_BAR();
    { LAS float* cs = (LAS float*)F.lds; LAS float* red = (LAS float*)(F.lds + 81920); float* MOD = (float*)(ws + WS_MOD);
      const float* c_p = INP(2); const float* c_s = INP(3); const float* w_mod = INP(5); const float* b_mod = INP(6); const float* n1g = INP(7); const float* n2g = INP(8);
      for (int i = F.tid; i < NB * D; i += 512) { const int b = i >> 11, k = i & 2047; const float c = b < 2 ? c_p[b * D + k] : c_s[(b - 2) * D + k]; cs[i] = c / (1.0f + __expf(-c)); }
      WG_BAR();
      for (int item = F.bid; item < DEPTH * 192; item += F.G) { const int l = item / 192, col0 = (item % 192) * 64, w = F.wave, lane = F.lane;
          float acc[NB];
#pragma unroll
          for (int b = 0; b < NB; ++b) acc[b] = 0.f;
          const float* W = w_mod + (size_t)l * D * MODSTRIDE + col0 + lane;
          for (int k0 = 256 * w; k0 < 256 * w + 256; k0 += 16) { float wv[16];
#pragma unroll
              for (int j = 0; j < 16; ++j) wv[j] = W[(size_t)(k0 + j) * MODSTRIDE];
#pragma unroll
              for (int j4 = 0; j4 < 4; ++j4)
#pragma unroll
                  for (int b = 0; b < NB; ++b) { const f32x4 c4 = *(const LAS f32x4*)(cs + b * D + k0 + 4 * j4); acc[b] += (c4.x * wv[4 * j4] + c4.y * wv[4 * j4 + 1]) + (c4.z * wv[4 * j4 + 2] + c4.w * wv[4 * j4 + 3]); } }
#pragma unroll
          for (int b = 0; b < NB; ++b) red[(w * NB + b) * 64 + lane] = acc[b];
          WG_BAR();
          for (int i = F.tid; i < NB * 64; i += 512) { const int b = i >> 6, cc = i & 63, col = col0 + cc; float s = b_mod[l * MODSTRIDE + col];
#pragma unroll
              for (int ww = 0; ww < 8; ++ww) s += red[(ww * NB + b) * 64 + cc];
              const int slot = col >> 11, c = col & 2047;
              if (slot == 1) s = n1g[l * D + c] * (1.0f + s); else if (slot == 4) s = n2g[l * D + c] * (1.0f + s);
              MOD[((size_t)l * NB + b) * MODSTRIDE + col] = s; }
          WG_BAR(); } }
}

__device__ __forceinline__ void phase_norm0(const Frame& F0, const float* x_p, const float* x_s, const float* mod0, bf16_t* XG, float* RSTD, _Float16* XR) { const Frame F = fresh(F0);
    const int gw = F.bid * NWAVES + F.wave, NGW = F.G * NWAVES, lane = F.lane;
    for (int row = gw; row < T; row += NGW) { const int b = row < ROWS_P ? (row >> 13) : 2 + ((row - ROWS_P) >> 12);
        const float* xr = row < ROWS_P ? x_p + (size_t)row * D : x_s + (size_t)(row - ROWS_P) * D; const float* gm = mod0 + (size_t)b * MODSTRIDE + D;
        f32x4 v[8]; float ss = 0.f;
#pragma unroll
        for (int j = 0; j < 8; ++j) { v[j] = ((const f32x4*)xr)[lane + 64 * j]; ss += (v[j].x * v[j].x + v[j].y * v[j].y) + (v[j].z * v[j].z + v[j].w * v[j].w); }
        ss = wave_sum(ss); if (lane == 0) RSTD[row] = rsqrtf(ss * (1.0f / D) + EPS);
#pragma unroll
        for (int j = 0; j < 8; ++j) { const f32x4 g = ((const f32x4*)gm)[lane + 64 * j]; const f32x4 o = v[j] * g; u32x2 p; p.x = pk2(o.x, o.y); p.y = pk2(o.z, o.w); ((u32x2*)(XG + (size_t)row * D))[lane + 64 * j] = p;
            typedef _Float16 h16x4 __attribute__((ext_vector_type(4))); h16x4 q; q[0] = (_Float16)v[j].x; q[1] = (_Float16)v[j].y; q[2] = (_Float16)v[j].z; q[3] = (_Float16)v[j].w; ((h16x4*)(XR + (size_t)row * D))[lane + 64 * j] = q; } }
}
__device__ __forceinline__ void phase_rstd(const Frame& F0, int mode, const float* SSQX, float* RSTD, const float* SSQA, const float* SSQL, float* RATIO, float* S2) { const Frame F = fresh(F0);
    for (int row = F.bid * 512 + F.tid; row < T; row += F.G * 512) {
        if (mode == 0) { const f32x4* p = (const f32x4*)(SSQX + (size_t)row * 32); f32x4 s = p[0];
#pragma unroll
            for (int j = 1; j < 8; ++j) s += p[j];
            RSTD[row] = rsqrtf(((s.x + s.y) + (s.z + s.w)) * (1.0f / D) + EPS); }
        else { const f32x4* pa = (const f32x4*)(SSQA + (size_t)row * 8); const f32x4* pl = (const f32x4*)(SSQL + (size_t)row * 8); const f32x4 a = pa[0] + pa[1], l = pl[0] + pl[1];
            const float s1 = rsqrtf(((a.x + a.y) + (a.z + a.w)) * (1.0f / 1024.0f) + EPS), s2 = rsqrtf(((l.x + l.y) + (l.z + l.w)) * (1.0f / 1024.0f) + EPS);
            RATIO[row] = s1 / s2; S2[row] = s2; } }
}
__device__ __forceinline__ void phase_bias(const Frame& F0, const float* MOD, const bf16_t* WIN, const bf16_t* WGU, float* BIN, float* BGU) { const Frame F = fresh(F0);
    const int fr = F.lane & 15, fq = F.lane >> 4;
    constexpr int T_IN = ZC / 16, T_GU = 2 * DFF / 16, T_L = T_IN + T_GU;
    for (int tile = F.bid * NWAVES + F.wave; tile < DEPTH * T_L; tile += F.G * NWAVES) { const int l = tile / T_L; int r = tile - l * T_L; const int which = r >= T_IN ? 1 : 0; if (which) r -= T_IN;
        const int N = which ? 2 * DFF : ZC, n0 = 16 * r;
        const bf16_t* wp = (which ? WGU + (size_t)l * 2 * DFF * D : WIN + (size_t)l * ZC * D) + (size_t)(n0 + fr) * D + 8 * fq;
        const float* sp = MOD + ((size_t)l * NB + (fr < NB ? fr : 0)) * MODSTRIDE + (which ? 3 : 0) * D + 8 * fq;
        f32x4 acc = (f32x4){0.f, 0.f, 0.f, 0.f};
#pragma unroll 4
        for (int ks = 0; ks < D / 32; ++ks) { const bf16x8 af = *(const bf16x8*)(wp + 32 * ks); f32x4 s0 = *(const f32x4*)(sp + 32 * ks), s1 = *(const f32x4*)(sp + 32 * ks + 4);
            if (fr >= NB) { s0 = (f32x4){0.f, 0.f, 0.f, 0.f}; s1 = s0; }
            unsigned hi[4], lo[4]; const float sv[8] = {s0.x, s0.y, s0.z, s0.w, s1.x, s1.y, s1.z, s1.w};
#pragma unroll
            for (int j = 0; j < 4; ++j) { const unsigned h0 = f2bf(sv[2 * j]), h1 = f2bf(sv[2 * j + 1]); hi[j] = h0 | (h1 << 16); lo[j] = pk2(sv[2 * j] - __uint_as_float(h0 << 16), sv[2 * j + 1] - __uint_as_float(h1 << 16)); }
            const u32x4 hv = (u32x4){hi[0], hi[1], hi[2], hi[3]}, lv = (u32x4){lo[0], lo[1], lo[2], lo[3]};
            acc = __builtin_amdgcn_mfma_f32_16x16x32_bf16(af, __builtin_bit_cast(bf16x8, hv), acc, 0, 0, 0); acc = __builtin_amdgcn_mfma_f32_16x16x32_bf16(af, __builtin_bit_cast(bf16x8, lv), acc, 0, 0, 0); }
        if (fr < NB) { float* bp = (which ? BGU + (size_t)l * NB * 2 * DFF : BIN + (size_t)l * NB * ZC) + (size_t)fr * N + n0 + 4 * fq; *(f32x4*)bp = acc; }
    }
}

constexpr int AT_ROW = 272, AT_BUF = 2 * 64 * AT_ROW + 256  , AT_KS = 0, AT_VS = 64 * AT_ROW, AT_RSK = 2 * 64 * AT_ROW, AT_BIAS = 2 * AT_BUF, AT_GQ = AT_BIAS + 8 * 384 * 4;
static_assert(AT_GQ + 512 <= LDS_CTL, "attention LDS map");
constexpr float LOG2E = 1.4426950408889634f;
__device__ __forceinline__ int t5_bucket(int rel) { const int n = rel < 0 ? -rel : rel; int v; if (n < 8) v = n; else { v = (31 - __clz(n * n)) + 2; v = v > 15 ? 15 : v; } return (rel > 0 ? 16 : 0) + v; }
__device__ __forceinline__ s16x4 lds_tr16(LAS unsigned char* p) { typedef short v4i16_t __attribute__((ext_vector_type(4))); return __builtin_bit_cast(s16x4, __builtin_amdgcn_ds_read_tr16_b64_v4i16((LAS v4i16_t*)p)); }
__device__ __forceinline__ void phase_attn(const Frame& F0, const bf16_t* Z, const float* qg, const float* kg, const float* sink, const float* relb, bf16_t* MRG, float* SSQA) { const Frame F = fresh(F0);
    LAS unsigned char* lds = F.lds; const int tid = F.tid, lane = F.lane, w = F.wave, fr = lane & 15, fq = lane >> 4, g = w & 3, hq = w >> 2;
    LAS float* bias = (LAS float*)(lds + AT_BIAS);
    for (int i = tid; i < 8 * 384; i += 512) { const int h = i / 384, rel = i - 384 * h - 192; bias[i] = (rel >= -128 && rel <= 128) ? relb[t5_bucket(rel) * 8 + h] * LOG2E - 12.0f : -1e30f; }
    LAS float* gqt = (LAS float*)(lds + AT_GQ);
    if (tid < 128) gqt[tid] = qg[tid] * kg[tid];
    WG_BAR();
    const int p0 = tid, p1 = tid + 512;
    const int per_x = ((T / 64) * 2 + 7) / 8, slots = F.G / 8;
    for (int it_ = F.bid >> 3; it_ < per_x; it_ += slots) { const int item = (F.bid & 7) * per_x + it_; if (item >= (T / 64) * 2) break;
        const int qb = item >> 1, kvh = item & 1, q0 = qb * 64, h = kvh * 4 + g; int b_, t0, S; rowinfo(q0, b_, t0, S); const int seq0 = q0 - t0;
        bf16x8 Qf[2][4];
#pragma unroll
        for (int qt = 0; qt < 2; ++qt) { const bf16_t* qp = Z + (size_t)(q0 + 32 * hq + 16 * qt + fr) * ZC + ZQ + h * 128 + 8 * fq; u32x4 raw[4]; float ss = 0.f;
#pragma unroll
            for (int ks = 0; ks < 4; ++ks) { raw[ks] = *(const u32x4*)(qp + 32 * ks); const unsigned rw[4] = {raw[ks].x, raw[ks].y, raw[ks].z, raw[ks].w};
#pragma unroll
                for (int e = 0; e < 4; ++e) { const float a0 = bflo(rw[e]), a1 = bfhi(rw[e]); ss += a0 * a0 + a1 * a1; } }
            ss += __shfl_xor(ss, 16); ss += __shfl_xor(ss, 32);
            const float rs = rsqrtf(ss * (1.0f / 128.0f) + EPS) * (0.08838834764831845f * LOG2E);
#pragma unroll
            for (int ks = 0; ks < 4; ++ks) { const unsigned rw[4] = {raw[ks].x, raw[ks].y, raw[ks].z, raw[ks].w}; u32x4 o;
                const f32x4 g0 = *(const LAS f32x4*)(gqt + 32 * ks + 8 * fq), g1 = *(const LAS f32x4*)(gqt + 32 * ks + 8 * fq + 4);
                o.x = pg8::cvt_pk_bf16(bflo(rw[0]) * rs * g0[0], bfhi(rw[0]) * rs * g0[1]); o.y = pg8::cvt_pk_bf16(bflo(rw[1]) * rs * g0[2], bfhi(rw[1]) * rs * g0[3]);
                o.z = pg8::cvt_pk_bf16(bflo(rw[2]) * rs * g1[0], bfhi(rw[2]) * rs * g1[1]); o.w = pg8::cvt_pk_bf16(bflo(rw[3]) * rs * g1[2], bfhi(rw[3]) * rs * g1[3]);
                Qf[qt][ks] = __builtin_bit_cast(bf16x8, o); } }
        f32x4 O[8][2];
#pragma unroll
        for (int dt = 0; dt < 8; ++dt) { O[dt][0] = (f32x4){0.f, 0.f, 0.f, 0.f}; O[dt][1] = (f32x4){0.f, 0.f, 0.f, 0.f}; }
        float lsum[2] = {0.f, 0.f};
        const int c_lo = t0 >= 128 ? 0 : (128 - t0) / 64, c_hi = (t0 + 192 <= S) ? 4 : 4 - (t0 + 192 - S) / 64;
        u32x4 kr[2], vr[2];
#define AT_FETCH(c) do { const size_t rb = (size_t)(seq0 + t0 - 128 + 64 * (c)); \
          kr[0] = *(const u32x4*)(Z + (rb + (p0 >> 4)) * ZC + ZK + kvh * 128 + 8 * (p0 & 15)); kr[1] = *(const u32x4*)(Z + (rb + (p1 >> 4)) * ZC + ZK + kvh * 128 + 8 * (p1 & 15)); \
          vr[0] = *(const u32x4*)(Z + (rb + (p0 >> 4)) * ZC + ZV + kvh * 128 + 8 * (p0 & 15)); vr[1] = *(const u32x4*)(Z + (rb + (p1 >> 4)) * ZC + ZV + kvh * 128 + 8 * (p1 & 15)); } while (0)
#define AT_PARK(buf) do { LAS unsigned char* bb = lds + (buf) * AT_BUF; _Pragma("unroll") for (int i = 0; i < 2; ++i) { const int p = i ? p1 : p0, key = p >> 4, part = p & 15; \
                *(LAS u32x4*)(bb + AT_KS + key * AT_ROW + part * 16) = kr[i]; *(LAS u32x4*)(bb + AT_VS + key * AT_ROW + part * 16) = vr[i]; \
                const unsigned kw[4] = {kr[i].x, kr[i].y, kr[i].z, kr[i].w}; float ss = 0.f; \
                _Pragma("unroll") for (int e = 0; e < 4; ++e) { const float a0 = bflo(kw[e]), a1 = bfhi(kw[e]); ss += a0 * a0 + a1 * a1; } \
                ss += __shfl_xor(ss, 1); ss += __shfl_xor(ss, 2); ss += __shfl_xor(ss, 4); ss += __shfl_xor(ss, 8); \
                if (part == 0) ((LAS float*)(bb + AT_RSK))[key] = rsqrtf(ss * (1.0f / 128.0f) + EPS); } } while (0)
        AT_FETCH(c_lo);
        WG_BAR();
        AT_PARK(0);
        WG_BAR();
        for (int c = c_lo; c <= c_hi; ++c) { LAS unsigned char* bb = lds + ((c - c_lo) & 1) * AT_BUF;
            if (c < c_hi) AT_FETCH(c + 1);
            f32x4 Sx[4][2];
#pragma unroll
            for (int kt = 0; kt < 4; ++kt) { Sx[kt][0] = (f32x4){0.f, 0.f, 0.f, 0.f}; Sx[kt][1] = (f32x4){0.f, 0.f, 0.f, 0.f};
#pragma unroll
                for (int ks = 0; ks < 4; ++ks) { const bf16x8 kf = *(const LAS bf16x8*)(bb + AT_KS + (16 * kt + fr) * AT_ROW + (32 * ks + 8 * fq) * 2);
                    Sx[kt][0] = __builtin_amdgcn_mfma_f32_16x16x32_bf16(kf, Qf[0][ks], Sx[kt][0], 0, 0, 0); Sx[kt][1] = __builtin_amdgcn_mfma_f32_16x16x32_bf16(kf, Qf[1][ks], Sx[kt][1], 0, 0, 0); } }
            bf16x8 Pf[2][2];
            f32x4 rk[4];
#pragma unroll
            for (int kt = 0; kt < 4; ++kt) rk[kt] = *(const LAS f32x4*)(bb + AT_RSK + (16 * kt + 4 * fq) * 4);
#pragma unroll
            for (int qt = 0; qt < 2; ++qt) { float pv[4][4]; const LAS float* bp = bias + h * 384 + 64 * c + 64 + 4 * fq - (32 * hq + 16 * qt + fr);
#pragma unroll
                for (int kt = 0; kt < 4; ++kt)
#pragma unroll
                    for (int i = 0; i < 4; ++i) { const float p = __builtin_amdgcn_exp2f(Sx[kt][qt][i] * rk[kt][i] + bp[16 * kt + i]); pv[kt][i] = p; lsum[qt] += p; }
#pragma unroll
                for (int s = 0; s < 2; ++s) { u32x4 o; o.x = pg8::cvt_pk_bf16(pv[2 * s][0], pv[2 * s][1]); o.y = pg8::cvt_pk_bf16(pv[2 * s][2], pv[2 * s][3]); o.z = pg8::cvt_pk_bf16(pv[2 * s + 1][0], pv[2 * s + 1][1]); o.w = pg8::cvt_pk_bf16(pv[2 * s + 1][2], pv[2 * s + 1][3]);
                    Pf[qt][s] = __builtin_bit_cast(bf16x8, o); } }
#pragma unroll
            for (int dt = 0; dt < 8; ++dt)
#pragma unroll
                for (int s = 0; s < 2; ++s) { LAS unsigned char* vb = bb + AT_VS + (32 * s + 4 * fq + (fr >> 2)) * AT_ROW + (16 * dt + 4 * (fr & 3)) * 2;
                    const s16x4 lo = lds_tr16(vb), hi = lds_tr16(vb + 16 * AT_ROW);
                    const bf16x8 vf = (bf16x8){lo[0], lo[1], lo[2], lo[3], hi[0], hi[1], hi[2], hi[3]};
                    O[dt][0] = __builtin_amdgcn_mfma_f32_16x16x32_bf16(vf, Pf[0][s], O[dt][0], 0, 0, 0); O[dt][1] = __builtin_amdgcn_mfma_f32_16x16x32_bf16(vf, Pf[1][s], O[dt][1], 0, 0, 0); }
            if (c < c_hi) { AT_PARK(((c - c_lo) & 1) ^ 1); WG_BAR(); }
        }
#undef AT_FETCH
#undef AT_PARK
        const float sk = __builtin_amdgcn_exp2f(sink[h] * LOG2E - 12.0f);
#pragma unroll
        for (int qt = 0; qt < 2; ++qt) { float l = lsum[qt]; l += __shfl_xor(l, 16); l += __shfl_xor(l, 32); const float inv = 1.0f / (l + sk);
            const int row = q0 + 32 * hq + 16 * qt + fr; bf16_t* op = MRG + (size_t)row * D + h * 128 + 4 * fq; float ss = 0.f;
#pragma unroll
            for (int dt = 0; dt < 8; ++dt) { u32x2 o; o.x = pg8::cvt_pk_bf16(O[dt][qt][0] * inv, O[dt][qt][1] * inv); o.y = pg8::cvt_pk_bf16(O[dt][qt][2] * inv, O[dt][qt][3] * inv); *(u32x2*)(op + 16 * dt) = o;
                const float e0 = bflo(o.x), e1 = bfhi(o.x), e2 = bflo(o.y), e3 = bfhi(o.y); ss += (e0 * e0 + e1 * e1) + (e2 * e2 + e3 * e3); }
            ss += __shfl_xor(ss, 16); ss += __shfl_xor(ss, 32); if (fq == 0) SSQA[(size_t)row * 8 + h] = ss; }
    }
    WG_BAR();
}

constexpr int LR_HF = 0, LR_HF_ROW = 528, LR_XCB = 67584, LR_YG = 102656, LR_YG_ROW = 272, LR_END = 137472;
static_assert(LR_END <= LDS_CTL, "LRU LDS map");
__device__ __forceinline__ int xcb_off(int tok) { return tok * 272 + (tok >> 5) * 64; }
struct LruConsts { float ba_f, ba_b, bx_f, bx_b, sp_f, sp_b; };
__device__ __forceinline__ void lru_fetch_xr(const Frame& F, const bf16_t* Z, int row0, int n, unsigned (&xr)[19]) {
    const int cp = F.tid & 63, tg = F.tid >> 6, ch = 128 * n + 2 * cp; int b_, t0, S; rowinfo(row0, b_, t0, S);
#pragma unroll
    for (int i = 0; i < 19; ++i) { const int tt = t0 + 16 * tg - 2 + i; unsigned v = 0u; if (tt >= 0 && tt < S) v = *(const unsigned*)(Z + (size_t)(row0 + 16 * tg - 2 + i) * ZC + ZX + ch); xr[i] = v; }
}
__device__ __forceinline__ void lru_park_xc(const Frame& F, const float* cw, const float* cb, int n, const unsigned (&xr)[19]) {
    const int cp = F.tid & 63, tg = F.tid >> 6, ch = 128 * n + 2 * cp;
    const float w00 = cw[ch], w01 = cw[ch + 1], w10 = cw[1024 + ch], w11 = cw[1024 + ch + 1], w20 = cw[2048 + ch], w21 = cw[2048 + ch + 1], w30 = cw[3072 + ch], w31 = cw[3072 + ch + 1], b0 = cb[ch], b1 = cb[ch + 1];
#pragma unroll
    for (int i = 0; i < 16; ++i) { const float y0 = b0 + w00 * bflo(xr[i]) + w10 * bflo(xr[i + 1]) + w20 * bflo(xr[i + 2]) + w30 * bflo(xr[i + 3]), y1 = b1 + w01 * bfhi(xr[i]) + w11 * bfhi(xr[i + 1]) + w21 * bfhi(xr[i + 2]) + w31 * bfhi(xr[i + 3]);
        const int tk = 16 * tg + i; *(LAS unsigned*)(F.lds + LR_XCB + xcb_off(tk) + 4 * cp) = pk2(y0, y1); }
}
typedef _Float16 f16x8 __attribute__((ext_vector_type(8)));
__device__ __forceinline__ void lru_ab2(f32x2 ga, f32x2 gx, f32x2 xc, float ba, float bx, float sp, f32x2& la, f32x2& a, f32x2& b) {
    const f32x2 ta = (ga + ba) * (-LOG2E), tx = (gx + bx) * (-LOG2E);
    f32x2 da, dx; da.x = 1.0f + __builtin_amdgcn_exp2f(ta.x); da.y = 1.0f + __builtin_amdgcn_exp2f(ta.y); dx.x = 1.0f + __builtin_amdgcn_exp2f(tx.x); dx.y = 1.0f + __builtin_amdgcn_exp2f(tx.y);
    const f32x2 dd = da * dx; f32x2 rc; rc.x = __builtin_amdgcn_rcpf(dd.x); rc.y = __builtin_amdgcn_rcpf(dd.y);
    const f32x2 r = dx * rc, ig = da * rc;
    la = r * (-8.0f * sp);
    const f32x2 tl = la * LOG2E; a.x = __builtin_amdgcn_exp2f(tl.x); a.y = __builtin_amdgcn_exp2f(tl.y);
    const f32x2 x2 = la * 2.0f;
    const f32x2 ser = -x2 * (1.0f + x2 * (0.5f + x2 * 0.16666667f)), alt = (1.0f - a) * (1.0f + a);
    f32x2 om; om.x = x2.x > -0.25f ? ser.x : alt.x; om.y = x2.y > -0.25f ? ser.y : alt.y;
    f32x2 sq; sq.x = __builtin_amdgcn_sqrtf(om.x); sq.y = __builtin_amdgcn_sqrtf(om.y);
    b = sq * ig * xc;
}
__device__ __forceinline__ void lru_load_w(const bf16_t* LWl, int n, int w, int lane, int gs, bf16x8 (&Wf)[4]) {
    int lo = lane * 8; asm volatile("" : "+v"(lo));
#pragma unroll
    for (int ks = 0; ks < 4; ++ks) Wf[ks] = *(const bf16x8*)(LWl + (size_t)(((n * 8 + w) * 4 + gs) * 4 + ks) * 512 + lo);
}
__device__ __forceinline__ LruConsts lru_consts(const float* b_a, const float* b_x, const float* lam, int ch) {
    LruConsts c; c.ba_f = b_a[ch]; c.ba_b = b_a[1024 + ch]; c.bx_f = b_x[ch]; c.bx_b = b_x[1024 + ch]; c.sp_f = lam[ch]; c.sp_b = lam[1024 + ch]; return c;
}
__device__ __forceinline__ void phase_lru1(const Frame& F0, const bf16_t* Z, const bf16_t* LWl, const float* cw, const float* cb, const float* b_a, const float* b_x, const float* lam, float* SUM, f16x8* LC) { const Frame F = fresh(F0);
    const int lane = F.lane, w = F.wave, fr = lane & 15, fq = lane >> 4, n = F.bid & 7, ch = 128 * n + 16 * w + fr;
    bf16x8 Waf[4], Wab[4], Wxf[4], Wxb[4]; lru_load_w(LWl, n, w, lane, 0, Waf); lru_load_w(LWl, n, w, lane, 1, Wab); lru_load_w(LWl, n, w, lane, 2, Wxf); lru_load_w(LWl, n, w, lane, 3, Wxb);
    const LruConsts C = lru_consts(b_a, b_x, lam, ch);
    const int arow = 32 * (fr >> 2) + (fr & 3);
    unsigned xr[19];
    if (F.bid < (T / 128) * 8) lru_fetch_xr(F, Z, (F.bid >> 3) * 128, n, xr);
    for (int item = F.bid; item < (T / 128) * 8; item += F.G) { const int chunk = item >> 3;
        WG_BAR(); lru_park_xc(F, cw, cb, n, xr);
        if (item + F.G < (T / 128) * 8) lru_fetch_xr(F, Z, ((item + F.G) >> 3) * 128, n, xr);
        asm volatile("s_waitcnt lgkmcnt(0)" ::: "memory"); __builtin_amdgcn_s_barrier(); asm volatile("" ::: "memory");
        float RAf = 1.f, RBf = 0.f, RAb = 1.f, RBb = 0.f;
#pragma unroll 2
        for (int tau = 0; tau < 8; ++tau) {
            f32x4 gaf = (f32x4){0.f, 0.f, 0.f, 0.f}, gab = gaf, gxf = gaf, gxb = gaf;
#pragma unroll
            for (int ks = 0; ks < 4; ++ks) { const bf16x8 af = *(const LAS bf16x8*)(F.lds + LR_XCB + xcb_off(arow + 4 * tau) + (32 * ks + 8 * fq) * 2);
                gaf = __builtin_amdgcn_mfma_f32_16x16x32_bf16(af, Waf[ks], gaf, 0, 0, 0); gab = __builtin_amdgcn_mfma_f32_16x16x32_bf16(af, Wab[ks], gab, 0, 0, 0);
                gxf = __builtin_amdgcn_mfma_f32_16x16x32_bf16(af, Wxf[ks], gxf, 0, 0, 0); gxb = __builtin_amdgcn_mfma_f32_16x16x32_bf16(af, Wxb[ks], gxb, 0, 0, 0); }
            float xc[4];
#pragma unroll
            for (int i = 0; i < 4; ++i) xc[i] = bf2f(*(const LAS bf16_t*)(F.lds + LR_XCB + xcb_off(32 * fq + 4 * tau + i) + (16 * w + fr) * 2));
            f16x8 cf, cbk;
#pragma unroll
            for (int p = 0; p < 2; ++p) { f32x2 la, a, b; const f32x2 x = (f32x2){xc[2 * p], xc[2 * p + 1]};
                lru_ab2((f32x2){gaf[2 * p], gaf[2 * p + 1]}, (f32x2){gxf[2 * p], gxf[2 * p + 1]}, x, C.ba_f, C.bx_f, C.sp_f, la, a, b);
                RBf = a.x * RBf + b.x; RAf = a.x * RAf; RBf = a.y * RBf + b.y; RAf = a.y * RAf;
                cf[4 * p] = (_Float16)la.x; cf[4 * p + 1] = (_Float16)b.x; cf[4 * p + 2] = (_Float16)la.y; cf[4 * p + 3] = (_Float16)b.y;
                lru_ab2((f32x2){gab[2 * p], gab[2 * p + 1]}, (f32x2){gxb[2 * p], gxb[2 * p + 1]}, x, C.ba_b, C.bx_b, C.sp_b, la, a, b);
                RBb = RAb * b.x + RBb; RAb = RAb * a.x; RBb = RAb * b.y + RBb; RAb = RAb * a.y;
                cbk[4 * p] = (_Float16)la.x; cbk[4 * p + 1] = (_Float16)b.x; cbk[4 * p + 2] = (_Float16)la.y; cbk[4 * p + 3] = (_Float16)b.y; }
            f16x8* cp = LC + ((size_t)(item * 8 + w) * 16 + tau) * 64 + lane;
            __builtin_nontemporal_store(cf, cp); __builtin_nontemporal_store(cbk, cp + 8 * 64); }
#pragma unroll
        for (int st = 0; st < 2; ++st) { const int o = 16 << st; const bool early = ((fq >> st) & 1) == 0;
            const float pAf = __shfl_xor(RAf, o), pBf = __shfl_xor(RBf, o), pAb = __shfl_xor(RAb, o), pBb = __shfl_xor(RBb, o);
            const float XAf = early ? RAf : pAf, XBf = early ? RBf : pBf, YAf = early ? pAf : RAf, YBf = early ? pBf : RBf;
            const float XAb = early ? RAb : pAb, XBb = early ? RBb : pBb, YAb = early ? pAb : RAb, YBb = early ? pBb : RBb;
            RAf = YAf * XAf; RBf = YAf * XBf + YBf; RAb = XAb * YAb; RBb = XAb * YBb + XBb; }
        if (fq == 0) { float* s = SUM + (size_t)chunk * 4096 + ch; s[0] = RAf; s[1024] = RBf; s[2048] = RAb; s[3072] = RBb; }
    }
    WG_BAR();
}
__device__ __forceinline__ void phase_lru_carry(const Frame& F0, const float* SUM, float* CAR) { const Frame F = fresh(F0);
    for (int id = F.bid * 512 + F.tid; id < NB * 2048; id += F.G * 512) { const int s = id >> 11, dir = (id >> 10) & 1, ch = id & 1023;
        const int c0 = s < 2 ? 64 * s : 128 + 32 * (s - 2), nc = s < 2 ? 64 : 32; float h = 0.f;
        for (int j0 = 0; j0 < nc; j0 += 8) { float A[8], B[8];
#pragma unroll
            for (int k = 0; k < 8; ++k) { const int j = dir == 0 ? j0 + k : nc - 1 - (j0 + k); const size_t o = (size_t)(c0 + j) * 4096 + (dir ? 2048 : 0) + ch; A[k] = SUM[o]; B[k] = SUM[o + 1024]; }
#pragma unroll
            for (int k = 0; k < 8; ++k) { const int j = dir == 0 ? j0 + k : nc - 1 - (j0 + k); CAR[(size_t)(c0 + j) * 2048 + (dir ? 1024 : 0) + ch] = h; h = A[k] * h + B[k]; } } }
}
__device__ __forceinline__ void lru_unpack_ab(const f16x8 (&c)[8], float (&a)[32], float (&b)[32]) {
#pragma unroll
    for (int tau = 0; tau < 8; ++tau)
#pragma unroll
        for (int i = 0; i < 4; ++i) { a[4 * tau + i] = __builtin_amdgcn_exp2f((float)c[tau][2 * i] * LOG2E); b[4 * tau + i] = (float)c[tau][2 * i + 1]; }
}
__device__ __forceinline__ void phase_lru2(const Frame& F0, const bf16_t* Z, const f16x8* LC, const float* CAR, bf16_t* MRG, float* SSQL) { const Frame F = fresh(F0);
    const int lane = F.lane, w = F.wave, fr = lane & 15, fq = lane >> 4, n = F.bid & 7, ch = 128 * n + 16 * w + fr;
    constexpr int NITEM = (T / 128) * 8;
    f16x8 cf_[8], cb_[8]; float cf = 0.f, cbk = 0.f; u32x4 yv[4];
#define LR2_FETCH(it) do { const int chunk_ = (it) >> 3; const f16x8* cp_ = LC + (size_t)((it) * 8 + w) * 16 * 64 + lane; \
        _Pragma("unroll") for (int tau = 0; tau < 8; ++tau) { cf_[tau] = __builtin_nontemporal_load(cp_ + tau * 64); cb_[tau] = __builtin_nontemporal_load(cp_ + (8 + tau) * 64); } \
        cf = CAR[(size_t)chunk_ * 2048 + ch]; cbk = CAR[(size_t)chunk_ * 2048 + 1024 + ch]; \
        _Pragma("unroll") for (int i = 0; i < 4; ++i) { const int p = F.tid + 512 * i, tk = p >> 4, part = p & 15; yv[i] = *(const u32x4*)(Z + (size_t)(chunk_ * 128 + tk) * ZC + ZY + 128 * n + 8 * part); } } while (0)
    if (F.bid < NITEM) LR2_FETCH(F.bid);
    for (int item = F.bid; item < NITEM; item += F.G) { const int chunk = item >> 3, row0 = chunk * 128;
        WG_BAR();
#pragma unroll
        for (int i = 0; i < 4; ++i) { const int p = F.tid + 512 * i, tk = p >> 4, part = p & 15; *(LAS u32x4*)(F.lds + LR_YG + tk * LR_YG_ROW + part * 16) = yv[i]; }
        float a[32], b[32], hf[32]; const float cfw = cf, cbw = cbk;
        lru_unpack_ab(cf_, a, b);
        { float IA = 1.f, IB = 0.f;
#pragma unroll
          for (int t = 0; t < 32; ++t) { IB = a[t] * IB + b[t]; IA = a[t] * IA; }
          { const float xA = __shfl_up(IA, 16), xB = __shfl_up(IB, 16); if (fq >= 1) { IB = IA * xB + IB; IA = IA * xA; } }
          { const float xA = __shfl_up(IA, 32), xB = __shfl_up(IB, 32); if (fq >= 2) { IB = IA * xB + IB; IA = IA * xA; } }
          float EA = __shfl_up(IA, 16), EB = __shfl_up(IB, 16); if (fq == 0) { EA = 1.f; EB = 0.f; }
          float h = EA * cfw + EB;
#pragma unroll
          for (int t = 0; t < 32; ++t) { h = a[t] * h + b[t]; hf[t] = h; } }
        lru_unpack_ab(cb_, a, b);
        if (item + F.G < NITEM) LR2_FETCH(item + F.G);
        asm volatile("s_waitcnt lgkmcnt(0)" ::: "memory"); __builtin_amdgcn_s_barrier(); asm volatile("" ::: "memory");
        { float IA = 1.f, IB = 0.f;
#pragma unroll
          for (int t = 31; t >= 0; --t) { IB = a[t] * IB + b[t]; IA = a[t] * IA; }
          { const float xA = __shfl_down(IA, 16), xB = __shfl_down(IB, 16); if (fq <= 2) { IB = IA * xB + IB; IA = IA * xA; } }
          { const float xA = __shfl_down(IA, 32), xB = __shfl_down(IB, 32); if (fq <= 1) { IB = IA * xB + IB; IA = IA * xA; } }
          float EA = __shfl_down(IA, 16), EB = __shfl_down(IB, 16); if (fq == 3) { EA = 1.f; EB = 0.f; }
          float h = EA * cbw + EB;
#pragma unroll
          for (int t = 31; t >= 0; --t) { h = a[t] * h + b[t]; LAS bf16_t* yp = (LAS bf16_t*)(F.lds + LR_YG + (32 * fq + t) * LR_YG_ROW + (16 * w + fr) * 2);
              *yp = (bf16_t)f2bf((hf[t] + h) * pg8::gelu_tanh_f(bf2f(*yp))); if ((t & 7) == 0) __builtin_amdgcn_sched_barrier(0); } }
        asm volatile("s_waitcnt lgkmcnt(0)" ::: "memory"); __builtin_amdgcn_s_barrier(); asm volatile("" ::: "memory");
#pragma unroll
        for (int i = 0; i < 4; ++i) { const int p = F.tid + 512 * i, tk = p >> 4, part = p & 15; const u32x4 v = *(const LAS u32x4*)(F.lds + LR_YG + tk * LR_YG_ROW + part * 16);
            *(u32x4*)(MRG + (size_t)(row0 + tk) * D + 1024 + 128 * n + 8 * part) = v;
            float ss = (bflo(v.x) * bflo(v.x) + bfhi(v.x) * bfhi(v.x)) + (bflo(v.y) * bflo(v.y) + bfhi(v.y) * bfhi(v.y)) + (bflo(v.z) * bflo(v.z) + bfhi(v.z) * bfhi(v.z)) + (bflo(v.w) * bflo(v.w) + bfhi(v.w) * bfhi(v.w));
            ss += __shfl_xor(ss, 1); ss += __shfl_xor(ss, 2); ss += __shfl_xor(ss, 4); ss += __shfl_xor(ss, 8); if (part == 0) SSQL[(size_t)(row0 + tk) * 8 + n] = ss; }
    }
#undef LR2_FETCH
    WG_BAR();
}

__device__ __forceinline__ void phase_glu_fix(const Frame& F0, const float* HALO, const float* cw, const float* cb, bf16_t* ACT) { const Frame F = fresh(F0);
    for (int id = F.bid * 512 + F.tid; id < 384 * (DFF / 4); id += F.G * 512) { const int e = id / (DFF / 4), c = (id - e * (DFF / 4)) * 4, pm = e >> 1, side = e & 1, row = 256 * pm + (side ? 255 : 0);
        int b_, t, S; rowinfo(row, b_, t, S);
        const float* hp = HALO + (size_t)pm * 6 * DFF + c; const f32x4 z = (f32x4){0.f, 0.f, 0.f, 0.f};
        f32x4 gp, gc, gn, up;
        if (side == 0) { gp = t == 0 ? z : *(const f32x4*)(hp - 6 * DFF + 3 * DFF); gc = *(const f32x4*)(hp); gn = *(const f32x4*)(hp + DFF); up = *(const f32x4*)(hp + 4 * DFF); }
        else { gp = *(const f32x4*)(hp + 2 * DFF); gc = *(const f32x4*)(hp + 3 * DFF); gn = t == S - 1 ? z : *(const f32x4*)(hp + 6 * DFF); up = *(const f32x4*)(hp + 5 * DFF); }
        const f32x4 g = *(const f32x4*)(cw + c) * gp + *(const f32x4*)(cw + DFF + c) * gc + *(const f32x4*)(cw + 2 * DFF + c) * gn + *(const f32x4*)(cb + c);
        u32x2 o; o.x = pg8::cvt_pk_bf16(pg8::gelu_tanh_f(g[0]) * up[0], pg8::gelu_tanh_f(g[1]) * up[1]); o.y = pg8::cvt_pk_bf16(pg8::gelu_tanh_f(g[2]) * up[2], pg8::gelu_tanh_f(g[3]) * up[3]);
        *(u32x2*)(ACT + (size_t)row * DFF + c) = o; }
}

constexpr int PH_PER_LAYER = 11, PH0 = 2, N_PHASES = PH0 + DEPTH * PH_PER_LAYER;
#ifndef PHMASK
#define PHMASK 0xfff
#endif
#define PEN(k) ((PHMASK >> (k)) & 1)
#ifndef DBLMASK
#define DBLMASK 0
#endif
#define REP(k) for (int rep_ = 0; rep_ < 1 + ((DBLMASK >> (k)) & 1); ++rep_)
__global__ void __launch_bounds__(NWAVES * 64, 2) mega_fwd(Args a) {
    extern __shared__ __attribute__((aligned(16))) unsigned char lds_raw[];
    Frame F; F.lds = (LAS unsigned char*)lds_raw; F.tid = threadIdx.x; F.lane = F.tid & 63; F.wave = __builtin_amdgcn_readfirstlane(F.tid >> 6); F.G = gridDim.x; F.bid = blockIdx.x;
    unsigned char* ws = karg_ws();
    volatile LAS unsigned* MISC = (volatile LAS unsigned*)(F.lds + LDS_CTL);
    if (F.tid < 64) MISC[F.tid] = 0u;
    __syncthreads();
    const int lo = a.ph_lo, hi = a.ph_hi;
    XcdBarrier bar; bar.bar = (unsigned*)(ws + WS_CTL) + CW_BAR; bar.x = 0; bar.st = MISC; bar.wv = F.wave;
    if (hi - lo > 1) bar = xcd_barrier_post((unsigned*)(ws + WS_CTL) + CW_BAR, MISC, F.wave);
#define IN(k) (lo <= (k) && (k) < hi)
#define SEAM(k) do { if (IN(k) && IN((k) + 1)) xcd_barrier(bar); } while (0)
#define WSP(type, off) ((type*)(karg_ws() + (off)))
    PG8_LAS unsigned char* ring = (PG8_LAS unsigned char*)lds_raw;

    if (PEN(0) && IN(0)) { REP(0) phase_prologue(F, a); } SEAM(0);
    if (PEN(11) && IN(1)) { phase_bias(F, WSP(float, WS_MOD), WSP(bf16_t, WS_WIN), WSP(bf16_t, WS_WGU), WSP(float, WS_BIN), WSP(float, WS_BGU)); phase_norm0(F, karg_in(0), karg_in(1), WSP(float, WS_MOD), WSP(bf16_t, WS_H), WSP(float, WS_RSTD), WSP(_Float16, WS_XR)); } SEAM(1);
    for (int l = 0; l < DEPTH; ++l) {
        const int pb = PH0 + PH_PER_LAYER * l;
        const float* bp = l == 0 ? karg_in(0) : karg_out(); const float* bs = l == 0 ? karg_in(1) : karg_out() + (size_t)ROWS_P * D;
        if (PEN(1) && IN(pb + 0)) { if (l > 0) phase_rstd(F, 0, WSP(float, WS_SSQX), WSP(float, WS_RSTD), nullptr, nullptr, nullptr, nullptr); } SEAM(pb + 0);
        if (PEN(2) && IN(pb + 1)) { REP(2) { pg8::Gemm g{WSP(bf16_t, WS_H), WSP(bf16_t, WS_WIN) + (size_t)l * ZC * D, T, ZC, D}; pg8::StaticOrder S; S.init(T, ZC, F.G, F.bid); pg8::EpiStoreBf16N E{WSP(bf16_t, WS_Z), ZC, WSP(float, WS_RSTD), WSP(float, WS_BIN) + (size_t)l * NB * ZC};
            pg8::gemm_phase(ring, g, S, E, pg8::IdentMap{}, F.wave); } } SEAM(pb + 1);
        if (IN(pb + 2)) {
            if (PEN(3)) REP(3) phase_attn(F, WSP(bf16_t, WS_Z), karg_in(10) + l * 128, karg_in(11) + l * 128, karg_in(12) + l * 8, karg_in(4), WSP(bf16_t, WS_MRG), WSP(float, WS_SSQA));
            if (PEN(4)) REP(4) phase_lru1(F, WSP(bf16_t, WS_Z), WSP(bf16_t, WS_LW) + (size_t)l * 512 * 1024, karg_in(13) + (size_t)l * 4096, karg_in(14) + l * 1024, karg_in(16) + l * 2048, karg_in(18) + l * 2048, WSP(float, WS_LSP) + l * 2048, WSP(float, WS_SUM), (f16x8*)karg_out()); } SEAM(pb + 2);
        if (IN(pb + 3)) { if (PEN(5)) REP(5) phase_lru_carry(F, WSP(float, WS_SUM), WSP(float, WS_CAR)); } SEAM(pb + 3);
        if (IN(pb + 4)) { if (PEN(6)) REP(6) phase_lru2(F, WSP(bf16_t, WS_Z), (const f16x8*)karg_out(), WSP(float, WS_CAR), WSP(bf16_t, WS_MRG), WSP(float, WS_SSQL)); } SEAM(pb + 4);
        if (PEN(7) && IN(pb + 5)) { phase_rstd(F, 1, nullptr, nullptr, WSP(float, WS_SSQA), WSP(float, WS_SSQL), WSP(float, WS_RATIO), WSP(float, WS_S2)); } SEAM(pb + 5);
        if (PEN(8) && IN(pb + 6)) for (int rep_ = 0; rep_ < 1 + ((l == 0) ? ((DBLMASK >> 8) & 1) : 0); ++rep_) { const float* modl = WSP(float, WS_MOD) + (size_t)l * NB * MODSTRIDE; pg8::Gemm g{WSP(bf16_t, WS_MRG), WSP(bf16_t, WS_WOUT) + (size_t)l * D * D, T, D, D}; pg8::StaticOrder S; S.init(T, D, F.G, F.bid);
            pg8::EpiResid2<true> E{WSP(_Float16, WS_XR), nullptr, modl + 2 * D, modl + 4 * D, WSP(bf16_t, WS_H), WSP(float, WS_SSQX), WSP(float, WS_RATIO), WSP(float, WS_S2)}; pg8::gemm_phase(ring, g, S, E, pg8::IdentMap{}, F.wave); } SEAM(pb + 6);
        if (PEN(1) && IN(pb + 7)) { phase_rstd(F, 0, WSP(float, WS_SSQX), WSP(float, WS_RSTD), nullptr, nullptr, nullptr, nullptr); } SEAM(pb + 7);
        if (IN(pb + 8)) { if (PEN(9)) REP(9) { pg8::Gemm g{WSP(bf16_t, WS_H), WSP(bf16_t, WS_WGU) + (size_t)l * 2 * DFF * D, T, 2 * DFF, D}; pg8::StaticOrder S; S.init(T, 2 * DFF, F.G, F.bid);
            pg8::EpiGLU2 E{WSP(bf16_t, WS_ACT), karg_in(25) + (size_t)l * 3 * DFF, karg_in(26) + l * DFF, WSP(float, WS_RSTD), WSP(float, WS_BGU) + (size_t)l * NB * 2 * DFF, WSP(float, WS_HALO), (PG8_LAS float*)(ring + pg8::STAGE_BYTES)};
            pg8::gemm_phase(ring, g, S, E, pg8::IdentMap{}, F.wave); } } SEAM(pb + 8);
        if (IN(pb + 9)) { if (PEN(9)) phase_glu_fix(F, WSP(float, WS_HALO), karg_in(25) + (size_t)l * 3 * DFF, karg_in(26) + l * DFF, WSP(bf16_t, WS_ACT)); } SEAM(pb + 9);
        if (IN(pb + 10)) { if (PEN(10)) { const float* modl = WSP(float, WS_MOD) + (size_t)l * NB * MODSTRIDE; pg8::Gemm g{WSP(bf16_t, WS_ACT), WSP(bf16_t, WS_WDN) + (size_t)l * D * DFF, T, D, DFF}; pg8::StaticOrder S; S.init(T, D, F.G, F.bid);
            pg8::EpiResid2<false> E{WSP(_Float16, WS_XR), l + 1 < DEPTH ? nullptr : karg_out(), modl + 5 * D, l + 1 < DEPTH ? modl + (size_t)NB * MODSTRIDE + D : nullptr, WSP(bf16_t, WS_H), WSP(float, WS_SSQX), nullptr, nullptr};
            pg8::gemm_phase(ring, g, S, E, pg8::IdentMap{}, F.wave); } } SEAM(pb + 10);
    }
#undef IN
#undef SEAM
}
#ifndef HYB
#define HYB 0
#endif
extern "C" void kernel_launch(void* const* d_in, const int* in_sizes, int n_in, void* d_out, int out_size, void* d_ws, size_t ws_size, hipStream_t stream) {
    static int grid = 0;
    if (grid == 0) {
        if (n_in != 28 || ws_size < WS_END || out_size != T * D) { fprintf(stderr, "kernel_launch: unexpected sizes (n_in %d, ws %zu, out %d)\n", n_in, ws_size, out_size); grid = -1; return; }
        int dev = 0, cus = 0, per_cu = 0;
        if (hipGetDevice(&dev) != hipSuccess || hipDeviceGetAttribute(&cus, hipDeviceAttributeMultiprocessorCount, dev) != hipSuccess) { grid = -1; return; }
        if (hipFuncSetAttribute((const void*)mega_fwd, hipFuncAttributeMaxDynamicSharedMemorySize, LDS_BYTES) != hipSuccess) { fprintf(stderr, "kernel_launch: hipFuncSetAttribute failed\n"); grid = -1; return; }
        if (hipOccupancyMaxActiveBlocksPerMultiprocessor(&per_cu, (const void*)mega_fwd, NWAVES * 64, LDS_BYTES) != hipSuccess || per_cu < 1) { fprintf(stderr, "kernel_launch: occupancy query says %d blocks per CU\n", per_cu); grid = -1; (void)hipGetLastError(); return; }
        grid = cus & ~7;
    }
    if (grid < 0) return;
    (void)hipMemsetAsync((char*)d_ws + WS_CTL, 0, CTL_ZERO_BYTES, stream);
    Args a{};
    for (int i = 0; i < 28; ++i) a.in[i] = (const float*)d_in[i];
    a.out = (float*)d_out; a.ws = (unsigned char*)d_ws; a.flags = 0; a.pad = 0;
#if HYB & 8
    for (int p = 0; p < N_PHASES; ++p) { a.ph_lo = p; a.ph_hi = p + 1; hipLaunchKernelGGL(mega_fwd, dim3(grid), dim3(NWAVES * 64), LDS_BYTES, stream, a); }
#else
    a.ph_lo = 0; a.ph_hi = N_PHASES; hipLaunchKernelGGL(mega_fwd, dim3(grid), dim3(NWAVES * 64), LDS_BYTES, stream, a);
#endif
}
```

```cpp
#include <hip/hip_runtime.h>
#include <cstdio>
#include <cstdint>
#define HYB 0
#define DBLMASK 0

namespace pg8 {
#define PG8_LAS __attribute__((address_space(3)))
typedef unsigned short bf16_t;
typedef short bf16x8 __attribute__((ext_vector_type(8)));
typedef float f32x4 __attribute__((ext_vector_type(4)));
typedef unsigned u32x4 __attribute__((ext_vector_type(4)));
constexpr int BM = 256, BK = 64, HALF = 128, HTB = HALF * BK * 2  , STAGE_BYTES = 8 * HTB, NXCD = 8, WGM = 4;

__host__ __device__ __forceinline__ int lds_byte(int r, int c) { const int st = (r >> 4) * 2 + (c >> 5), rr = r & 15, cc = c & 31, ob = rr * 64 + cc * 2; return st * 1024 + (ob ^ (((ob >> 9) & 1) << 5)); }
__host__ __device__ __forceinline__ void stage_rc(int b, int& R, int& C) { const int st = b / 1024, sb = b % 1024, swz = sb ^ (((sb >> 9) & 1) << 5); R = (st >> 1) * 16 + swz / 64; C = (st & 1) * 32 + (swz % 64) / 2; }
__host__ __device__ __forceinline__ int perm32(int rho) { const int n = rho >> 4, i = rho & 15; return 8 * (i >> 2) + 4 * n + (i & 3); }

struct Unit { int pm, pn; };
struct Gemm { const bf16_t* A; const bf16_t* Bt; int M, N, K; };

struct StaticOrder {
    int nM, nN, nwg, G, c;
    __host__ __device__ void init(int M, int N, int G_, int c_) { nM = M / BM; nN = N / BM; nwg = nM * nN; G = G_; c = c_; }
    __host__ __device__ bool next(int i, Unit& u) const {
        const long L = (long)i * G + c; if (L >= nwg) return false;
        int wgid = (int)L; { const int q = nwg / NXCD, r = nwg % NXCD, xcd = wgid % NXCD, off = wgid / NXCD; wgid = (xcd < r ? xcd * (q + 1) : r * (q + 1) + (xcd - r) * q) + off; }
        const int nig = WGM * nN, gid = wgid / nig, fm = gid * WGM, gsz = (nM - fm) < WGM ? (nM - fm) : WGM;
        u.pm = fm + ((wgid % nig) % gsz); u.pn = (wgid % nig) / gsz; return true;
    }
    __device__ __forceinline__ void a_ready(const Unit&) const {}
    __device__ __forceinline__ void done(const Unit&) const {}
};

__device__ __forceinline__ unsigned cvt_pk_bf16(float lo, float hi) { unsigned r; asm volatile("v_cvt_pk_bf16_f32 %0, %1, %2" : "=v"(r) : "v"(lo), "v"(hi)); return r; }
typedef float f32x2 __attribute__((ext_vector_type(2)));
typedef unsigned u32x2 __attribute__((ext_vector_type(2)));
constexpr int ROWS_P = 16384;
constexpr int MODSTRIDE = 12288;
__device__ __forceinline__ int batch_of_row(int row) { return row < ROWS_P ? (row >> 13) : 2 + ((row - ROWS_P) >> 12); }

struct EpiStoreBf16 {
    static constexpr bool PERM = true, AFTER_DRAIN = false, HAS_MID = false;
    bf16_t* O; int ldc;
    __device__ __forceinline__ void operator()(const f32x4 (&acc)[2][2][4][2], const Unit& u, int wr, int wc, int fr_, int fq_) const {
        int fr = fr_, fq = fq_; asm volatile("" : "+v"(fr), "+v"(fq));
        const int row0 = u.pm * BM + wr * 64 + fr, col0 = u.pn * BM + wc * 32 + 8 * fq;
#pragma unroll
        for (int ai = 0; ai < 2; ++ai)
#pragma unroll
            for (int m = 0; m < 4; ++m) { bf16_t* rowp = O + (size_t)(row0 + ai * HALF + m * 16) * ldc + col0;
#pragma unroll
                for (int bj = 0; bj < 2; ++bj) { const f32x4 v0 = acc[ai][bj][m][0], v1 = acc[ai][bj][m][1];
                    u32x4 w; w.x = cvt_pk_bf16(v0[0], v0[1]); w.y = cvt_pk_bf16(v0[2], v0[3]); w.z = cvt_pk_bf16(v1[0], v1[1]); w.w = cvt_pk_bf16(v1[2], v1[3]);
                    *(u32x4*)(rowp + bj * HALF) = w; } }
    }
};
struct EpiResid {
    static constexpr bool PERM = false, AFTER_DRAIN = false, HAS_MID = false;
    const float* base_p; const float* base_s; float* out; const float* gate; int row_off;
    __device__ __forceinline__ void operator()(const f32x4 (&acc)[2][2][4][2], const Unit& u, int wr, int wc, int fr_, int fq_) const {
        int fr = fr_, fq = fq_; asm volatile("" : "+v"(fr), "+v"(fq));
        const int grow0 = row_off + u.pm * BM; const int b = batch_of_row(grow0);
        const float* g = gate + (size_t)b * MODSTRIDE;
        const float* bt = grow0 < ROWS_P ? base_p + (size_t)grow0 * 2048 : base_s + (size_t)(grow0 - ROWS_P) * 2048;
        float* ot = out + (size_t)grow0 * 2048;
        const int col0 = u.pn * BM + wc * 32 + 4 * fq;
        f32x4 gv[2][2];
#pragma unroll
        for (int bj = 0; bj < 2; ++bj)
#pragma unroll
            for (int n = 0; n < 2; ++n) gv[bj][n] = *(const f32x4*)(g + col0 + bj * HALF + n * 16);
#pragma unroll
        for (int ai = 0; ai < 2; ++ai)
#pragma unroll
            for (int m = 0; m < 4; ++m) { const size_t off = (size_t)(wr * 64 + fr + ai * HALF + m * 16) * 2048 + col0;
#pragma unroll
                for (int bj = 0; bj < 2; ++bj)
#pragma unroll
                    for (int n = 0; n < 2; ++n) { const f32x4 bs = *(const f32x4*)(bt + off + bj * HALF + n * 16);
                        *(f32x4*)(ot + off + bj * HALF + n * 16) = bs + gv[bj][n] * acc[ai][bj][m][n]; }
                asm volatile("" ::: "memory"); }
    }
};
struct EpiStoreBf16N {
    static constexpr bool PERM = true, AFTER_DRAIN = false, HAS_MID = false;
    bf16_t* O; int ldc; const float* rstd; const float* bias;
    __device__ __forceinline__ void operator()(const f32x4 (&acc)[2][2][4][2], const Unit& u, int wr, int wc, int fr_, int fq_) const {
        int fr = fr_, fq = fq_; asm volatile("" : "+v"(fr), "+v"(fq));
        const int row0 = u.pm * BM + wr * 64 + fr, col0 = u.pn * BM + wc * 32 + 8 * fq;
        const float* bp = bias + (size_t)batch_of_row(u.pm * BM) * ldc + col0;
        f32x4 bv[2][2];
#pragma unroll
        for (int bj = 0; bj < 2; ++bj)
#pragma unroll
            for (int n = 0; n < 2; ++n) bv[bj][n] = *(const f32x4*)(bp + bj * HALF + 4 * n);
#pragma unroll
        for (int ai = 0; ai < 2; ++ai)
#pragma unroll
            for (int m = 0; m < 4; ++m) { const int r = row0 + ai * HALF + m * 16; const float rs = rstd[r]; bf16_t* rowp = O + (size_t)r * ldc + col0;
#pragma unroll
                for (int bj = 0; bj < 2; ++bj) { const f32x4 v0 = acc[ai][bj][m][0] * rs + bv[bj][0], v1 = acc[ai][bj][m][1] * rs + bv[bj][1];
                    u32x4 w; w.x = cvt_pk_bf16(v0[0], v0[1]); w.y = cvt_pk_bf16(v0[2], v0[3]); w.z = cvt_pk_bf16(v1[0], v1[1]); w.w = cvt_pk_bf16(v1[2], v1[3]);
                    *(u32x4*)(rowp + bj * HALF) = w; } }
    }
};
template <bool MID> struct EpiResid2 {
    static constexpr bool PERM = true, AFTER_DRAIN = false, HAS_MID = MID;
    _Float16* XR; float* out32; const float* gate; const float* gm; bf16_t* XG; float* SSQ; const float* ratio; const float* s2;
    __device__ __forceinline__ void mid(f32x4 (&acc)[2][2][4][2], const Unit& u, int wr, int fr) const {
        unsigned z_ = 0u; asm volatile("" : "+v"(z_)); const int fq = (int)__builtin_amdgcn_mbcnt_hi(~0u, __builtin_amdgcn_mbcnt_lo(~0u, z_)) >> 4, base = u.pm * BM + wr * 64 + fr + (fq >> 1) * HALF + (fq & 1) * 32;
        const float v0 = ratio[base], v1 = ratio[base + 16];
#pragma unroll
        for (int ai = 0; ai < 2; ++ai)
#pragma unroll
            for (int m = 0; m < 4; ++m) { const float r = __shfl((m & 1) ? v1 : v0, fr + 16 * (ai * 2 + (m >> 1)));
#pragma unroll
                for (int bj = 0; bj < 2; ++bj)
#pragma unroll
                    for (int n = 0; n < 2; ++n) acc[ai][bj][m][n] = acc[ai][bj][m][n] * r; }
    }
    __device__ __forceinline__ void operator()(const f32x4 (&acc)[2][2][4][2], const Unit& u, int wr, int wc, int fr_, int fq_) const {
        int fr = fr_, fq = fq_; asm volatile("" : "+v"(fr), "+v"(fq));
        typedef __attribute__((address_space(1))) const f32x4 gcf4; typedef __attribute__((address_space(1))) f32x4 gf4; typedef __attribute__((address_space(1))) u32x4 gu4; typedef _Float16 h16x8 __attribute__((ext_vector_type(8))); typedef __attribute__((address_space(1))) h16x8 gh8; typedef __attribute__((address_space(1))) const h16x8 gch8; typedef __attribute__((address_space(1))) float gf1;
        const int grow0 = u.pm * BM; const int b = batch_of_row(grow0);
        const float* g = gate + (size_t)b * MODSTRIDE;
        const size_t t0 = (size_t)grow0 * 2048;
        const int col0 = u.pn * BM + wc * 32 + 8 * fq;
        float ss[2][4], rs[2][4];
#pragma unroll
        for (int ai = 0; ai < 2; ++ai)
#pragma unroll
            for (int m = 0; m < 4; ++m) { ss[ai][m] = 0.f; rs[ai][m] = MID ? s2[grow0 + wr * 64 + fr + ai * HALF + m * 16] : 1.0f; }
#pragma unroll
        for (int bj = 0; bj < 2; ++bj) { const int co = col0 + bj * HALF;
            const f32x4 gv0 = *(gcf4*)(g + co), gv1 = *(gcf4*)(g + co + 4); f32x4 gm0 = (f32x4){0.f, 0.f, 0.f, 0.f}, gm1 = gm0; if (gm) { gm0 = *(gcf4*)(gm + (size_t)b * MODSTRIDE + co); gm1 = *(gcf4*)(gm + (size_t)b * MODSTRIDE + co + 4); }
#pragma unroll
            for (int ai = 0; ai < 2; ++ai) { h16x8 raw[4];
#pragma unroll
                for (int m = 0; m < 4; ++m) raw[m] = *(gch8*)(XR + t0 + (size_t)(wr * 64 + fr + ai * HALF + m * 16) * 2048 + co);
#pragma unroll
                for (int m = 0; m < 4; ++m) { const size_t off = t0 + (size_t)(wr * 64 + fr + ai * HALF + m * 16) * 2048 + co;
                    const f32x4 b0 = (f32x4){(float)raw[m][0], (float)raw[m][1], (float)raw[m][2], (float)raw[m][3]}, b1 = (f32x4){(float)raw[m][4], (float)raw[m][5], (float)raw[m][6], (float)raw[m][7]};
                    const f32x4 o0 = b0 + gv0 * (acc[ai][bj][m][0] * rs[ai][m]), o1 = b1 + gv1 * (acc[ai][bj][m][1] * rs[ai][m]);
                    if (out32) { *(gf4*)(out32 + off) = o0; *(gf4*)(out32 + off + 4) = o1; }
                    else { h16x8 w; w[0] = (_Float16)o0[0]; w[1] = (_Float16)o0[1]; w[2] = (_Float16)o0[2]; w[3] = (_Float16)o0[3]; w[4] = (_Float16)o1[0]; w[5] = (_Float16)o1[1]; w[6] = (_Float16)o1[2]; w[7] = (_Float16)o1[3]; *(gh8*)(XR + off) = w; }
                    if (gm) { const f32x4 x0 = o0 * gm0, x1 = o1 * gm1; ss[ai][m] += ((o0[0] * o0[0] + o0[1] * o0[1]) + (o0[2] * o0[2] + o0[3] * o0[3])) + ((o1[0] * o1[0] + o1[1] * o1[1]) + (o1[2] * o1[2] + o1[3] * o1[3]));
                        u32x4 w; w.x = cvt_pk_bf16(x0[0], x0[1]); w.y = cvt_pk_bf16(x0[2], x0[3]); w.z = cvt_pk_bf16(x1[0], x1[1]); w.w = cvt_pk_bf16(x1[2], x1[3]); *(gu4*)(XG + off) = w; } }
                asm volatile("" ::: "memory"); } }
        if (gm) {
#pragma unroll
            for (int ai = 0; ai < 2; ++ai)
#pragma unroll
                for (int m = 0; m < 4; ++m) { float s = ss[ai][m]; s += __shfl_xor(s, 16); s += __shfl_xor(s, 32); if (fq == 0) *(gf1*)(SSQ + (size_t)(grow0 + wr * 64 + fr + ai * HALF + m * 16) * 32 + u.pn * 4 + wc) = s; } }
    }
};
constexpr int GLU_BLOCKS = 802, GLU_TILES = 201;
struct GluMap {
    static constexpr bool UNIFORM = false;
    static __device__ __forceinline__ void block(int gb, int& base, int& t0, int& S) {
        if (gb < 266) { const int s = gb >= 133 ? 1 : 0; const int j = gb - 133 * s; base = s * 8192; t0 = 62 * j - 1; S = 8192; }
        else if (gb < GLU_BLOCKS) { const int g2 = gb - 266; const int s = g2 / 67, j = g2 - 67 * s; base = ROWS_P + s * 4096; t0 = 62 * j - 1; S = 4096; }
        else { base = 0; t0 = 0; S = 0; }
    }
    __device__ __forceinline__ unsigned rowq(int pm, int q, int r) const { int base, t0, S; block(4 * pm + q, base, t0, S); int t = t0 + r; t = t >= S ? S - 1 : t; t = t < 0 ? 0 : t; return (unsigned)(base + t); }
    __device__ __forceinline__ unsigned row(int pm, int R) const { int base, t0, S; block(4 * pm + (R >> 6), base, t0, S); int t = t0 + (R & 63); t = t >= S ? S - 1 : t; t = t < 0 ? 0 : t; return (unsigned)(base + t); }
};
template <int CTRL> __device__ __forceinline__ float dppf(float x) { return __builtin_bit_cast(float, __builtin_amdgcn_update_dpp(0, __builtin_bit_cast(int, x), CTRL, 0xf, 0xf, false)); }
template <int CTRL> __device__ __forceinline__ float dpp_any(float x) { return __builtin_bit_cast(float, __builtin_amdgcn_mov_dpp(__builtin_bit_cast(int, x), CTRL, 0xf, 0xf, false)); }
template <int CTRL> __device__ __forceinline__ float dpp_keep(float old, float x) { return __builtin_bit_cast(float, __builtin_amdgcn_update_dpp(__builtin_bit_cast(int, old), __builtin_bit_cast(int, x), CTRL, 0xf, 0xf, false)); }
struct GeluK { float c0, c1, one;
    __device__ __forceinline__ GeluK() { c0 = -2.302208198f * 0.044715f; c1 = -2.302208198f; one = 1.0f; asm volatile("" : "+v"(c0), "+v"(c1), "+v"(one)); } };
__device__ __forceinline__ f32x4 gelu_tanh_4(f32x4 x, const GeluK& k) {
    const f32x4 p = (x * x) * k.c0 + k.c1; const f32x4 a = x * p; f32x4 e;
#pragma unroll
    for (int i = 0; i < 4; ++i) e[i] = __builtin_amdgcn_exp2f(a[i]);
    const f32x4 d = e + k.one; f32x4 r;
#pragma unroll
    for (int i = 0; i < 4; ++i) r[i] = __builtin_amdgcn_rcpf(d[i]);
    return x * r;
}
__device__ __forceinline__ float gelu_tanh_f(float x) {
    const float u = x * (1.0f + 0.044715f * x * x); const float e = __builtin_amdgcn_exp2f(-2.302208198f * u);
    return x * __builtin_amdgcn_rcpf(1.0f + e);
}
struct EpiGLU {
    static constexpr bool PERM = true, AFTER_DRAIN = false, HAS_MID = false;
    bf16_t* act; const float* cw; const float* cb;
    const float* rstd; const float* bias;
    __device__ __forceinline__ void operator()(const f32x4 (&acc)[2][2][4][2], const Unit& u, int wr, int wc, int fr_, int fq_) const {
        int fr = fr_, fq = fq_; asm volatile("" : "+v"(fr), "+v"(fq));
        const int c0 = u.pn * HALF + wc * 32 + 8 * fq;
        f32x4 w0[2], w1[2], w2[2], bb[2];
#pragma unroll
        for (int n = 0; n < 2; ++n) { w0[n] = *(const f32x4*)(cw + c0 + 4 * n); w1[n] = *(const f32x4*)(cw + 6144 + c0 + 4 * n); w2[n] = *(const f32x4*)(cw + 2 * 6144 + c0 + 4 * n); bb[n] = *(const f32x4*)(cb + c0 + 4 * n); }
#pragma unroll
        for (int ai = 0; ai < 2; ++ai) {
            int base, t0, S; GluMap::block(4 * u.pm + 2 * ai + wr, base, t0, S);
            f32x4 gt[4][2], bg[2], bu[2]; float rs[4];
            { const float* bp = bias + (size_t)batch_of_row(base) * 12288 + u.pn * BM + wc * 32 + 8 * fq;
#pragma unroll
              for (int n = 0; n < 2; ++n) { bg[n] = *(const f32x4*)(bp + 4 * n); bu[n] = *(const f32x4*)(bp + HALF + 4 * n); } }
#pragma unroll
            for (int m = 0; m < 4; ++m) { const int tok = t0 + 16 * m + fr; const bool in = tok >= 0 && tok < S; int tc = tok >= S ? S - 1 : tok; tc = tc < 0 ? 0 : tc; rs[m] = rstd[base + tc];
#pragma unroll
                for (int n = 0; n < 2; ++n) gt[m][n] = in ? acc[ai][0][m][n] * rs[m] + bg[n] : (f32x4){0.f, 0.f, 0.f, 0.f}; }
#pragma unroll
            for (int m = 0; m < 4; ++m) { const int i = 16 * m + fr, tok = t0 + i; u32x4 w;
                unsigned pk[4];
#pragma unroll
                for (int n = 0; n < 2; ++n) { f32x4 pv, nx;
#pragma unroll
                    for (int e = 0; e < 4; ++e) {
                        const float rcur = dppf<0x121>(gt[m][n][e]), rprv = dppf<0x121>(gt[m > 0 ? m - 1 : 0][n][e]);
                        const float lcur = dppf<0x12F>(gt[m][n][e]), lnxt = dppf<0x12F>(gt[m < 3 ? m + 1 : 3][n][e]);
                        pv[e] = fr == 0 ? rprv : rcur; nx[e] = fr == 15 ? lnxt : lcur; }
                    const f32x4 g = w0[n] * pv + w1[n] * gt[m][n] + w2[n] * nx + bb[n];
                    const f32x4 up = acc[ai][1][m][n] * rs[m] + bu[n];
                    const float a0 = gelu_tanh_f(g[0]) * up[0], a1 = gelu_tanh_f(g[1]) * up[1], a2 = gelu_tanh_f(g[2]) * up[2], a3 = gelu_tanh_f(g[3]) * up[3];
                    pk[2 * n] = cvt_pk_bf16(a0, a1); pk[2 * n + 1] = cvt_pk_bf16(a2, a3); }
                w.x = pk[0]; w.y = pk[1]; w.z = pk[2]; w.w = pk[3];
                if (i >= 1 && i <= 62 && tok < S) *(u32x4*)(act + (size_t)(base + tok) * 6144 + c0) = w; }
        }
    }
};

struct EpiGLU2 {
    static constexpr bool PERM = true, AFTER_DRAIN = false, HAS_MID = false;
    bf16_t* act; const float* cw; const float* cb; const float* rstd; const float* bias; float* halo; PG8_LAS float* xch;
    __device__ __forceinline__ void operator()(const f32x4 (&acc)[2][2][4][2], const Unit& u, int wr, int wc, int fr_, int fq_) const {
        int fr = fr_, fq = fq_; asm volatile("" : "+v"(fr), "+v"(fq));
        const int lc = wc * 32 + 8 * fq, c0 = u.pn * HALF + lc;
        f32x4 w0[2], w1[2], w2[2], bb[2], bg[2], bu[2];
        { const float* bp = bias + (size_t)batch_of_row(u.pm * BM) * 12288 + u.pn * BM + lc;
#pragma unroll
          for (int n = 0; n < 2; ++n) { w0[n] = *(const f32x4*)(cw + c0 + 4 * n); w1[n] = *(const f32x4*)(cw + 6144 + c0 + 4 * n); w2[n] = *(const f32x4*)(cw + 2 * 6144 + c0 + 4 * n); bb[n] = *(const f32x4*)(cb + c0 + 4 * n);
              bg[n] = *(const f32x4*)(bp + 4 * n); bu[n] = *(const f32x4*)(bp + HALF + 4 * n); } }
        const GeluK GK;
        f32x4 gt[2][4][2]; float rs[2][4];
#pragma unroll
        for (int ai = 0; ai < 2; ++ai)
#pragma unroll
            for (int m = 0; m < 4; ++m) { rs[ai][m] = rstd[u.pm * BM + ai * HALF + wr * 64 + 16 * m + fr];
#pragma unroll
                for (int n = 0; n < 2; ++n) gt[ai][m][n] = acc[ai][0][m][n] * rs[ai][m] + bg[n]; }
#pragma unroll
        for (int ai = 0; ai < 2; ++ai) { const int blk = 2 * ai + wr;
#pragma unroll
            for (int n = 0; n < 2; ++n) { if (fr == 0) *(PG8_LAS f32x4*)(xch + (blk * 2 + 0) * HALF + lc + 4 * n) = gt[ai][0][n]; if (fr == 15) *(PG8_LAS f32x4*)(xch + (blk * 2 + 1) * HALF + lc + 4 * n) = gt[ai][3][n]; } }
        asm volatile("s_waitcnt lgkmcnt(0)" ::: "memory"); __builtin_amdgcn_s_barrier(); asm volatile("" ::: "memory");
#pragma unroll
        for (int ai = 0; ai < 2; ++ai) { const int blk = 2 * ai + wr; f32x4 pvb[2], nxb[2];
#pragma unroll
            for (int n = 0; n < 2; ++n) { pvb[n] = *(const PG8_LAS f32x4*)(xch + ((blk > 0 ? blk - 1 : 0) * 2 + 1) * HALF + lc + 4 * n); nxb[n] = *(const PG8_LAS f32x4*)(xch + ((blk < 3 ? blk + 1 : 3) * 2 + 0) * HALF + lc + 4 * n); }
#pragma unroll
            for (int m = 0; m < 4; ++m) { const int i = 16 * m + fr; u32x4 w; unsigned pk[4]; f32x4 upv[2];
#pragma unroll
                for (int n = 0; n < 2; ++n) { f32x4 pv, nx;
#pragma unroll
                    for (int e = 0; e < 4; ++e) {
                        const float eprv = m > 0 ? dpp_any<0x121>(gt[ai][m > 0 ? m - 1 : 0][n][e]) : pvb[n][e], enxt = m < 3 ? dpp_any<0x12F>(gt[ai][m < 3 ? m + 1 : 3][n][e]) : nxb[n][e];
                        pv[e] = dpp_keep<0x111>(eprv, gt[ai][m][n][e]); nx[e] = dpp_keep<0x101>(enxt, gt[ai][m][n][e]); }
                    const f32x4 g = w2[n] * nx + (w1[n] * gt[ai][m][n] + (w0[n] * pv + bb[n]));
                    upv[n] = acc[ai][1][m][n] * rs[ai][m] + bu[n];
                    const f32x4 av = gelu_tanh_4(g, GK) * upv[n];
                    pk[2 * n] = cvt_pk_bf16(av[0], av[1]); pk[2 * n + 1] = cvt_pk_bf16(av[2], av[3]); }
                w.x = pk[0]; w.y = pk[1]; w.z = pk[2]; w.w = pk[3];
                const int trow = 64 * blk + i;
                if (trow != 0 && trow != 255) __builtin_nontemporal_store(w, (u32x4*)(act + (size_t)(u.pm * BM + trow) * 6144 + c0));
                int slot = -1; if (trow == 0) slot = 0; else if (trow == 1) slot = 1; else if (trow == 254) slot = 2; else if (trow == 255) slot = 3;
                if (slot >= 0) { float* hp = halo + ((size_t)u.pm * 6 + slot) * 6144 + c0; *(f32x4*)hp = gt[ai][m][0]; *(f32x4*)(hp + 4) = gt[ai][m][1];
                    if (slot == 0 || slot == 3) { float* hu = halo + ((size_t)u.pm * 6 + (slot == 0 ? 4 : 5)) * 6144 + c0; *(f32x4*)hu = upv[0]; *(f32x4*)(hu + 4) = upv[1]; } } }
        }
    }
};
struct IdentMap { static constexpr bool UNIFORM = true; __device__ __forceinline__ unsigned row(int pm, int R) const { return (unsigned)(pm * BM + R); } __device__ __forceinline__ unsigned rowq(int pm, int q, int r) const { return (unsigned)(pm * BM + 64 * q + r); } };
template <class Epi, class Sched, class AMap>
__device__ __forceinline__ void gemm_phase(PG8_LAS unsigned char* lds, const Gemm g, const Sched& S, const Epi& E, const AMap& AM, int wave) {
    unsigned z_ = 0u; asm volatile("" : "+v"(z_)); const int ln_ = (int)__builtin_amdgcn_mbcnt_hi(~0u, __builtin_amdgcn_mbcnt_lo(~0u, z_)); const int tid_ = wave * 64 + ln_;
    const int tid = tid_, wid = wave, lane = ln_, wr = wid >> 2, wc = wid & 3, fr = lane & 15, fq = lane >> 4;
    const int K = g.K, nt = K / BK;
    int RA[2], CA[2]; unsigned voffB[2], voffA[2];
#pragma unroll
    for (int i = 0; i < 2; ++i) { int R, C; stage_rc(tid * 16 + i * 8192, R, C); const int Rb = Epi::PERM ? ((R & ~31) + perm32(R & 31)) : R; RA[i] = R; CA[i] = C; voffA[i] = (unsigned)(R * K + C) * 2u; voffB[i] = (unsigned)(Rb * K + C) * 2u; }
    const size_t kstep = (size_t)(BK * 2);
    const size_t qstep = (size_t)64 * K * 2;
    const size_t hstep = (size_t)HALF * K * 2;
    const size_t tstep = 2 * hstep;
    const unsigned ldsw = (unsigned)wid * 1024u;
    const int aoff = lds_byte(wr * 64 + fr, fq * 8), boff = lds_byte(wc * 32 + fr, fq * 8);
#define PG8_SA(b, h) (((b) * 2 + (h)) * HTB)
#define PG8_SB(b, h) ((4 + (b) * 2 + (h)) * HTB)
#define PG8_STAGE(bufoff, gbase, voff) do { _Pragma("unroll") for (int _i = 0; _i < 2; ++_i) \
        __builtin_amdgcn_global_load_lds((const unsigned*)((const char*)(gbase) + (size_t)_i * qstep + (voff)[0]), (PG8_LAS unsigned*)(lds + (bufoff) + ldsw + _i * 8192), 16, 0, 0); } while (0)
#define PG8_LDA(dst, b, h) do { _Pragma("unroll") for (int m = 0; m < 4; ++m) _Pragma("unroll") for (int k = 0; k < 2; ++k) dst[m][k] = *(const PG8_LAS bf16x8*)(lds + PG8_SA(b, h) + aoff + m * 2048 + k * 1024); } while (0)
#define PG8_LDB(dst, b, h) do { _Pragma("unroll") for (int n = 0; n < 2; ++n) _Pragma("unroll") for (int k = 0; k < 2; ++k) dst[n][k] = *(const PG8_LAS bf16x8*)(lds + PG8_SB(b, h) + boff + n * 2048 + k * 1024); } while (0)
#define PG8_MMA(ai, bj, At, Bt) do { __builtin_amdgcn_s_setprio(1); _Pragma("unroll") for (int m = 0; m < 4; ++m) _Pragma("unroll") for (int n = 0; n < 2; ++n) _Pragma("unroll") for (int k = 0; k < 2; ++k) \
        acc[ai][bj][m][n] = __builtin_amdgcn_mfma_f32_16x16x32_bf16(Bt[n][k], At[m][k], acc[ai][bj][m][n], 0, 0, 0); __builtin_amdgcn_s_setprio(0); } while (0)
#define PG8_WAIT_V(n) asm volatile("s_waitcnt vmcnt(" #n ")" ::: "memory")
#define PG8_WAIT_L(n) asm volatile("s_waitcnt lgkmcnt(" #n ")" ::: "memory")
#define PG8_BAR __builtin_amdgcn_s_barrier()
#define PG8_SCHED __builtin_amdgcn_sched_barrier(0)
#define PG8_STAGE_A(bufoff, kb, h, NX) do { if constexpr (AMap::UNIFORM) { const char* _b = ((NX) ? nA : cA) + (kb) + (h) * hstep; PG8_STAGE(bufoff, _b, voffA); } \
        else { unsigned _o[2]; _o[0] = (NX) ? offN[h][0] : offC[h][0]; _o[1] = (NX) ? offN[h][1] : offC[h][1]; PG8_STAGE(bufoff, Ab + (kb), _o); } } while (0)
#define PG8_OFFS(dst, pm) do { _Pragma("unroll") for (int _h = 0; _h < 2; ++_h) _Pragma("unroll") for (int _i = 0; _i < 2; ++_i) dst[_h][_i] = (AM.rowq((pm), 2 * _h + _i, RA[_i] & 63) * (unsigned)K + (unsigned)CA[_i]) * 2u; } while (0)
    Unit cur, nxt; int ui = 0;
    if (!S.next(0, cur)) return;
    f32x4 acc[2][2][4][2];
#pragma unroll
    for (int a = 0; a < 2; ++a)
#pragma unroll
        for (int b = 0; b < 2; ++b)
#pragma unroll
            for (int m = 0; m < 4; ++m)
#pragma unroll
                for (int n = 0; n < 2; ++n) acc[a][b][m][n] = (f32x4){0.f, 0.f, 0.f, 0.f};
    bf16x8 At[4][2], B0[2][2], B1[2][2];
    unsigned offC[2][2], offN[2][2];
    if constexpr (!AMap::UNIFORM) { PG8_OFFS(offC, cur.pm); }
    const char* const Ab = (const char*)g.A;
    const char* cA = (const char*)g.A + (size_t)cur.pm * tstep; const char* nA = cA;
    const char* cB = (const char*)g.Bt + (size_t)cur.pn * tstep;
    S.a_ready(cur);
    PG8_STAGE(PG8_SB(0, 0), cB, voffB); PG8_STAGE(PG8_SB(0, 1), cB + hstep, voffB); PG8_STAGE_A(PG8_SA(0, 0), 0, 0, false); PG8_STAGE_A(PG8_SA(0, 1), 0, 1, false);
    if (wr == 1) PG8_BAR;
    PG8_WAIT_V(2); PG8_BAR;
    PG8_STAGE(PG8_SB(1, 0), cB + kstep, voffB); PG8_STAGE_A(PG8_SA(1, 0), kstep, 0, false); PG8_STAGE(PG8_SB(1, 1), cB + hstep + kstep, voffB);
    PG8_WAIT_V(6); PG8_BAR;
    for (;;) {
        const bool has_next = S.next(ui + 1, nxt);
        const char* nB = has_next ? (const char*)g.Bt + (size_t)nxt.pn * tstep : cB;
        if constexpr (AMap::UNIFORM) { nA = has_next ? (const char*)g.A + (size_t)nxt.pm * tstep : cA; }
        else { if (has_next) { PG8_OFFS(offN, nxt.pm); } else {
#pragma unroll
            for (int _h = 0; _h < 2; ++_h)
#pragma unroll
                for (int _i = 0; _i < 2; ++_i) offN[_h][_i] = offC[_h][_i]; } }
        for (int t = 0; t < nt; t += 2) {
            const bool last = (t == nt - 2);
            const size_t k1 = (size_t)(t + 1) * kstep, k2 = last ? (size_t)0 : (size_t)(t + 2) * kstep, k3 = k2 + kstep;
            const char* b2 = last ? nB : cB + (size_t)(t + 2) * kstep; const char* b3 = b2 + kstep;
            if (last && has_next) S.a_ready(nxt);
            if constexpr (Epi::HAS_MID) { if (t == nt / 2) E.mid(acc, cur, wr, fr); }
            PG8_LDB(B0, 0, 0); PG8_LDB(B1, 0, 1); PG8_SCHED; PG8_LDA(At, 0, 0); PG8_STAGE_A(PG8_SA(1, 1), k1, 1, false);
            PG8_WAIT_V(8); PG8_WAIT_L(0); PG8_BAR; PG8_MMA(0, 0, At, B0); PG8_MMA(0, 1, At, B1); PG8_BAR; PG8_SCHED;
            PG8_LDA(At, 0, 1); PG8_STAGE(PG8_SB(0, 0), b2, voffB); PG8_STAGE(PG8_SB(0, 1), b2 + hstep, voffB); PG8_STAGE_A(PG8_SA(0, 0), k2, 0, last);
            PG8_WAIT_V(8); PG8_WAIT_L(0); PG8_BAR; PG8_MMA(1, 0, At, B0); PG8_MMA(1, 1, At, B1); PG8_BAR; PG8_SCHED;
            PG8_LDB(B0, 1, 0); PG8_LDB(B1, 1, 1); PG8_SCHED; PG8_LDA(At, 1, 0); PG8_STAGE_A(PG8_SA(0, 1), k2, 1, last);
            PG8_WAIT_V(8); PG8_WAIT_L(0); PG8_BAR; PG8_MMA(0, 0, At, B0); PG8_MMA(0, 1, At, B1); PG8_BAR; PG8_SCHED;
            PG8_LDA(At, 1, 1); PG8_STAGE(PG8_SB(1, 0), b3, voffB); PG8_STAGE(PG8_SB(1, 1), b3 + hstep, voffB); PG8_STAGE_A(PG8_SA(1, 0), k3, 0, last);
            PG8_WAIT_V(8); PG8_WAIT_L(0); PG8_BAR; PG8_MMA(1, 0, At, B0); PG8_MMA(1, 1, At, B1); PG8_BAR; PG8_SCHED;
        }
        if (wr == 0) PG8_BAR;
        E(acc, cur, wr, wc, fr, fq); S.done(cur);
        if (!has_next) break;
#pragma unroll
        for (int a = 0; a < 2; ++a)
#pragma unroll
            for (int b = 0; b < 2; ++b)
#pragma unroll
                for (int m = 0; m < 4; ++m)
#pragma unroll
                    for (int n = 0; n < 2; ++n) acc[a][b][m][n] = (f32x4){0.f, 0.f, 0.f, 0.f};
        cur = nxt; cB = nB; cA = nA; ++ui;
        if constexpr (!AMap::UNIFORM) {
#pragma unroll
        for (int _h = 0; _h < 2; ++_h)
#pragma unroll
            for (int _i = 0; _i < 2; ++_i) offC[_h][_i] = offN[_h][_i]; }
        if (wr == 1) PG8_BAR;
    }
    PG8_WAIT_V(0);
    PG8_BAR;
#undef PG8_SA
#undef PG8_SB
#undef PG8_STAGE
#undef PG8_LDA
#undef PG8_LDB
#undef PG8_MMA
#undef PG8_WAIT_V
#undef PG8_WAIT_L
#undef PG8_BAR
#undef PG8_SCHED
#undef PG8_OFFS
#undef PG8_STAGE_A
}
}

#define LAS __attribute__((address_space(3)))
typedef unsigned short bf16_t;
typedef float f32x4 __attribute__((ext_vector_type(4)));
typedef float f32x2 __attribute__((ext_vector_type(2)));
typedef unsigned u32x4 __attribute__((ext_vector_type(4)));
typedef unsigned u32x2 __attribute__((ext_vector_type(2)));
typedef short bf16x8 __attribute__((ext_vector_type(8)));
typedef short s16x4 __attribute__((ext_vector_type(4)));
constexpr int D = 2048, T = 49152, ROWS_P = 16384, NB = 10, DEPTH = 4;
constexpr int ZC = 3584, ZQ = 0, ZK = 1024, ZV = 1280, ZX = 1536, ZY = 2560;
constexpr int DFF = 6144, MODSTRIDE = 12288;
constexpr float EPS = 1e-6f;
constexpr size_t MiB = 1u << 20;
constexpr size_t WS_CTL = 0, CTL_ZERO_BYTES = 64 * 1024, WS_MOD = 1 * MiB, WS_SUM = 3 * MiB  , WS_CAR = 9 * MiB  , WS_LW = 12 * MiB  ,
                 WS_WIN = 16 * MiB, WS_WOUT = 72 * MiB, WS_WGU = 104 * MiB, WS_WDN = 296 * MiB, WS_H = 392 * MiB, WS_Z = 584 * MiB,
                 WS_ATT = 920 * MiB, WS_LRU = 1016 * MiB, WS_AB = 1112 * MiB, WS_LC = 1112 * MiB  ,
                 WS_SSQX = 1496 * MiB  , WS_SSQA = 1502 * MiB  , WS_SSQL = 1503 * MiB + 512 * 1024, WS_RSTD = 1505 * MiB, WS_RATIO = 1505 * MiB + 256 * 1024, WS_S2 = 1505 * MiB + 512 * 1024,
                 WS_BIN = 1506 * MiB  , WS_BGU = 1507 * MiB  , WS_END = 1510 * MiB;
constexpr size_t WS_XR = 1160 * MiB;
constexpr size_t WS_HALO = 1352 * MiB;
constexpr size_t WS_MRG = WS_ATT;
constexpr size_t WS_LSP = 3 * MiB - 65536;
constexpr size_t WS_ACT = WS_Z;
constexpr size_t WS_GUC = WS_Z, WS_ACTC = WS_Z + 192 * MiB;
static_assert(WS_ACT + (size_t)T * DFF * 2 <= WS_XR && WS_XR + (size_t)T * D * 2 <= WS_HALO && WS_HALO + (size_t)192 * 6 * DFF * 4 <= WS_SSQX, "act overlay / residual stream / halo");
constexpr int LDS_BYTES = 147456, LDS_CTL = LDS_BYTES - 256;
constexpr int NWAVES = 8;
constexpr int CW_BAR = 1024;

__device__ __forceinline__ void rowinfo(int row, int& b, int& t, int& S) { if (row < ROWS_P) { b = row >> 13; t = row & 8191; S = 8192; } else { const int r = row - ROWS_P; b = 2 + (r >> 12); t = r & 4095; S = 4096; } }
__device__ __forceinline__ float bf2f(unsigned short u) { return __uint_as_float(((unsigned)u) << 16); }
__device__ __forceinline__ float bflo(unsigned w) { return __uint_as_float(w << 16); }
__device__ __forceinline__ float bfhi(unsigned w) { return __uint_as_float(w & 0xffff0000u); }
__device__ __forceinline__ unsigned f2bf(float f) { unsigned u = __float_as_uint(f); return (u + 0x7fffu + ((u >> 16) & 1u)) >> 16; }
__device__ __forceinline__ unsigned pk2(float lo, float hi) { return f2bf(lo) | (f2bf(hi) << 16); }
__device__ __forceinline__ float wave_sum(float v) {
#pragma unroll
    for (int o = 1; o < 64; o <<= 1) v += __shfl_xor(v, o);
    return v; }
__device__ __forceinline__ float wave_max(float v) {
#pragma unroll
    for (int o = 1; o < 64; o <<= 1) v = fmaxf(v, __shfl_xor(v, o));
    return v; }
__device__ __forceinline__ float gelu_tanh(float x) { const float u = 0.7978845608028654f * (x + 0.044715f * x * x * x); return x / (1.0f + __expf(-2.0f * u)); }
__device__ __forceinline__ float sigmoidf(float x) { return 1.0f / (1.0f + __expf(-x)); }
#define LDS_WAIT() asm volatile("s_waitcnt lgkmcnt(0)" ::: "memory")
#define VM_WAIT() asm volatile("s_waitcnt vmcnt(0)" ::: "memory")
#define WG_BAR() do { asm volatile("s_waitcnt vmcnt(0) lgkmcnt(0)" ::: "memory"); __builtin_amdgcn_s_barrier(); asm volatile("" ::: "memory"); } while (0)

__device__ __forceinline__ unsigned char* ws_now(unsigned char* p) { asm volatile("" : "+s"(p)); return p; }
__device__ __forceinline__ int lane_id() { unsigned z = 0u; asm volatile("" : "+v"(z)); return (int)__builtin_amdgcn_mbcnt_hi(~0u, __builtin_amdgcn_mbcnt_lo(~0u, z)); }
#define XB_TMO      128
#define XB_XCNT(j)  (256  + 64 * (j))
#define XB_XSUB(j)  (1280 + 64 * (j))
#define XB_XGEN(j)  (2304 + 64 * (j))
#define XB_TOP      3328
#define XB_TOPGEN   3392
#define XCD_BAR_WORDS 3456
#define XB_SPIN_CAP (1u << 18)

__device__ __forceinline__ unsigned xb_ld(unsigned* p)              { return __hip_atomic_load(p, __ATOMIC_RELAXED, __HIP_MEMORY_SCOPE_AGENT); }
__device__ __forceinline__ unsigned xb_add(unsigned* p, unsigned v) { return __hip_atomic_fetch_add(p, v, __ATOMIC_RELAXED, __HIP_MEMORY_SCOPE_AGENT); }
__device__ __forceinline__ unsigned xb_xcc_id() { return (unsigned)__builtin_amdgcn_s_getreg((3 << 11) | 20) & 0xFu; }
#define XB_SPIN(cond, bar) do { unsigned _sp = 0; while (cond) { __builtin_amdgcn_s_sleep(1); \
    if ((++_sp & 255u) == 0u) { if (xb_ld(&(bar)[XB_TMO])) break; if (_sp > XB_SPIN_CAP) { atomicAdd(&(bar)[XB_TMO], 1u); break; } } } } while (0)

struct XcdBarrier {
    unsigned* bar; unsigned x; int wv;
    volatile LAS unsigned* st;
};

__device__ __forceinline__ XcdBarrier xcd_barrier_post(unsigned* bar, volatile LAS unsigned* st, int wv) {
    XcdBarrier b; b.bar = bar; b.x = xb_xcc_id(); b.st = st; b.wv = wv;
    if (wv == 0 && lane_id() == 0) (void)xb_add(&bar[XB_XCNT(b.x)], 1u);
    return b;
}
__device__ __forceinline__ void xcd_barrier_complete(unsigned* bar, unsigned x, unsigned& nloc, unsigned& nx) {
    const unsigned G = gridDim.x * gridDim.y * gridDim.z;
    unsigned sum, cnt, mine, sp = 0u;
    for (;;) {
        sum = 0u; cnt = 0u; mine = 0u;
#pragma unroll
        for (unsigned j = 0; j < 16; ++j) { const unsigned c = xb_ld(&bar[XB_XCNT(j)]); sum += c; cnt += (c > 0u) ? 1u : 0u; mine = (j == x) ? c : mine; }
        if (sum == G) break;
        __builtin_amdgcn_s_sleep(1);
        if ((++sp & 255u) == 0u) { if (xb_ld(&bar[XB_TMO])) break; if (sp > XB_SPIN_CAP) { atomicAdd(&bar[XB_TMO], 1u); break; } }
    }
    nloc = mine > 0u ? mine : 1u; nx = cnt > 0u ? cnt : 1u;
}

__device__ __forceinline__ void xcd_barrier(const XcdBarrier& b) {
    asm volatile("s_waitcnt vmcnt(0)" ::: "memory");
    __syncthreads();
    if (b.wv == 0 && lane_id() == 0) {
        unsigned* bar = b.bar; asm volatile("" : "+s"(bar));
        __builtin_amdgcn_s_waitcnt(0);
        unsigned nloc = b.st[0], nx = b.st[1];
        if (nloc == 0u) { xcd_barrier_complete(bar, b.x, nloc, nx); b.st[0] = nloc; b.st[1] = nx; }
        const unsigned old = xb_add(&bar[XB_XSUB(b.x)], 1u);
        const unsigned gen = old / nloc;
        if (old + 1u == (gen + 1u) * nloc) {
            __builtin_amdgcn_fence(__ATOMIC_RELEASE, "agent");
            asm volatile("s_waitcnt vmcnt(0)" ::: "memory");
            const unsigned og = xb_add(&bar[XB_TOP], 1u);
            const unsigned tg = og / nx;
            if (og + 1u == (tg + 1u) * nx) xb_add(&bar[XB_TOPGEN], 1u);
            else XB_SPIN(xb_ld(&bar[XB_TOPGEN]) == tg, bar);
            __builtin_amdgcn_fence(__ATOMIC_ACQUIRE, "agent");
            xb_add(&bar[XB_XGEN(b.x)], 1u);
            asm volatile("s_waitcnt vmcnt(0)" ::: "memory");
        } else {
            XB_SPIN(xb_ld(&bar[XB_XGEN(b.x)]) == gen, bar);
            __builtin_amdgcn_fence(__ATOMIC_ACQUIRE, "agent");
            asm volatile("s_waitcnt vmcnt(0)" ::: "memory");
        }
    }
    __syncthreads();
}

struct Args { const float* in[28]; float* out; unsigned char* ws; int ph_lo, ph_hi, flags, pad; };
struct Frame {
    LAS unsigned char* lds; int tid, lane, wave, G, bid;
};
#define KAS __attribute__((address_space(4)))
__device__ __forceinline__ const KAS unsigned char* karg_base() { const KAS unsigned char* p = (const KAS unsigned char*)__builtin_amdgcn_kernarg_segment_ptr(); asm volatile("" : "+s"(p)); return p; }
__device__ __forceinline__ const float* karg_in(int k) { return *(const float* const KAS*)(karg_base() + 8 * k); }
__device__ __forceinline__ float* karg_out() { return *(float* const KAS*)(karg_base() + 8 * 28); }
__device__ __forceinline__ unsigned char* karg_ws() { return *(unsigned char* const KAS*)(karg_base() + 8 * 29); }
#define INP(k) (karg_in(k))
__device__ __forceinline__ Frame fresh(const Frame& F0) { Frame F = F0; int ln = lane_id(); asm volatile("" : "+v"(ln)); F.lane = ln; F.tid = F0.wave * 64 + ln; return F; }

__device__ __forceinline__ void p0_transpose_item(const float* W, int K, int N, bf16_t* WT, int mode, LAS float* scr, int item, int lane, const float* ks0 = nullptr, const float* ks1 = nullptr) {
    const int nblk = N / 64, kb = item / nblk, nb = item % nblk, k0 = 64 * kb, n0 = 64 * nb;
    const int drow0 = mode == 0 ? n0 : ((n0 >> 7) * 256 + (n0 & 127) + (mode == 2 ? 128 : 0));
    f32x4 v[16];
#pragma unroll
    for (int i = 0; i < 16; ++i) v[i] = *(const f32x4*)(W + (size_t)(k0 + 4 * i + (lane >> 4)) * N + n0 + 4 * (lane & 15));
#pragma unroll
    for (int i = 0; i < 16; ++i) { const int kk = 4 * i + (lane >> 4); float sc = 1.0f; if (ks0) sc = (k0 + kk < 1024 ? ks0[k0 + kk] : ks1[k0 + kk - 1024]);
        LAS float* d = scr + kk * 65 + 4 * (lane & 15); d[0] = v[i].x * sc; d[1] = v[i].y * sc; d[2] = v[i].z * sc; d[3] = v[i].w * sc; }
    LDS_WAIT(); asm volatile("" ::: "memory");
    const int c = lane & 7;
#pragma unroll
    for (int j = 0; j < 8; ++j) { const int n = (lane >> 3) + 8 * j; const LAS float* s = scr + (8 * c) * 65 + n;
        u32x4 o; o.x = pk2(s[0 * 65], s[1 * 65]); o.y = pk2(s[2 * 65], s[3 * 65]); o.z = pk2(s[4 * 65], s[5 * 65]); o.w = pk2(s[6 * 65], s[7 * 65]);
        *(u32x4*)(WT + (size_t)(drow0 + n) * K + k0 + 8 * c) = o; }
    LDS_WAIT(); asm volatile("" ::: "memory");
}
__device__ __forceinline__ void phase_prologue(const Frame& F0, const Args& a) { const Frame F = fresh(F0);
    unsigned char* ws = karg_ws();
    bf16_t* WIN = (bf16_t*)(ws + WS_WIN); bf16_t* WOUT = (bf16_t*)(ws + WS_WOUT); bf16_t* WGU = (bf16_t*)(ws + WS_WGU); bf16_t* WDN = (bf16_t*)(ws + WS_WDN);
    LAS float* scr = (LAS float*)(F.lds + F.wave * 16640);
    const int gw = F.bid * NWAVES + F.wave, NGW = F.G * NWAVES;
    constexpr int I_IN = (D / 64) * (ZC / 64), I_OUT = (D / 64) * (D / 64), I_G = (D / 64) * (DFF / 64), I_D = (DFF / 64) * (D / 64), I_L = I_IN + I_OUT + 2 * I_G + I_D;
    for (int it = gw; it < DEPTH * I_L; it += NGW) { const int l = it / I_L; int r = it - l * I_L;
        if (r < I_IN) { p0_transpose_item(INP(9) + (size_t)l * D * ZC, D, ZC, WIN + (size_t)l * ZC * D, 0, scr, r, F.lane); continue; } r -= I_IN;
        if (r < I_OUT) { p0_transpose_item(INP(22) + (size_t)l * D * D, D, D, WOUT + (size_t)l * D * D, 0, scr, r, F.lane, INP(20) + l * 1024, INP(21) + l * 1024); continue; } r -= I_OUT;
        if (r < I_G) { p0_transpose_item(INP(23) + (size_t)l * D * DFF, D, DFF, WGU + (size_t)l * 2 * DFF * D, 1, scr, r, F.lane); continue; } r -= I_G;
        if (r < I_G) { p0_transpose_item(INP(24) + (size_t)l * D * DFF, D, DFF, WGU + (size_t)l * 2 * DFF * D, 2, scr, r, F.lane); continue; } r -= I_G;
        p0_transpose_item(INP(27) + (size_t)l * DFF * D, DFF, D, WDN + (size_t)l * D * DFF, 0, scr, r, F.lane); }
    { bf16_t* LW = (bf16_t*)(ws + WS_LW);
      for (int it = gw; it < DEPTH * 8 * 8 * 16; it += NGW) { const int ks = it & 3, gs = (it >> 2) & 3, w = (it >> 4) & 7, n = (it >> 7) & 7, l = it >> 10;
          const float* src = (gs < 2 ? INP(15) : INP(17)) + ((size_t)((l * 2 + (gs & 1)) * 8 + n) * 128) * 128;
          const int c0 = 32 * ks + 8 * (F.lane >> 4), jc = 16 * w + (F.lane & 15); float v[8];
#pragma unroll
          for (int j = 0; j < 8; ++j) v[j] = src[(size_t)(c0 + j) * 128 + jc];
          u32x4 o; o.x = pk2(v[0], v[1]); o.y = pk2(v[2], v[3]); o.z = pk2(v[4], v[5]); o.w = pk2(v[6], v[7]);
          *(u32x4*)(LW + ((size_t)it * 64 + F.lane) * 8) = o; } }
    { float* LSP = (float*)(ws + WS_LSP); for (int i = F.bid * 512 + F.tid; i < DEPTH * 2048; i += F.G * 512) LSP[i] = log1pf(expf(-INP(19)[i])); }
    WG_BAR();
    { LAS float* cs = (LAS float*)F.lds; LAS float* red = (LAS float*)(F.lds + 81920); float* MOD = (float*)(ws + WS_MOD);
      const float* c_p = INP(2); const float* c_s = INP(3); const float* w_mod = INP(5); const float* b_mod = INP(6); const float* n1g = INP(7); const float* n2g = INP(8);
      for (int i = F.tid; i < NB * D; i += 512) { const int b = i >> 11, k = i & 2047; const float c = b < 2 ? c_p[b * D + k] : c_s[(b - 2) * D + k]; cs[i] = c / (1.0f + __expf(-c)); }
      WG_BAR();
      for (int item = F.bid; item < DEPTH * 192; item += F.G) { const int l = item / 192, col0 = (item % 192) * 64, w = F.wave, lane = F.lane;
          float acc[NB];
#pragma unroll
          for (int b = 0; b < NB; ++b) acc[b] = 0.f;
          const float* W = w_mod + (size_t)l * D * MODSTRIDE + col0 + lane;
          for (int k0 = 256 * w; k0 < 256 * w + 256; k0 += 16) { float wv[16];
#pragma unroll
              for (int j = 0; j < 16; ++j) wv[j] = W[(size_t)(k0 + j) * MODSTRIDE];
#pragma unroll
              for (int j4 = 0; j4 < 4; ++j4)
#pragma unroll
                  for (int b = 0; b < NB; ++b) { const f32x4 c4 = *(const LAS f32x4*)(cs + b * D + k0 + 4 * j4); acc[b] += (c4.x * wv[4 * j4] + c4.y * wv[4 * j4 + 1]) + (c4.z * wv[4 * j4 + 2] + c4.w * wv[4 * j4 + 3]); } }
#pragma unroll
          for (int b = 0; b < NB; ++b) red[(w * NB + b) * 64 + lane] = acc[b];
          WG_BAR();
          for (int i = F.tid; i < NB * 64; i += 512) { const int b = i >> 6, cc = i & 63, col = col0 + cc; float s = b_mod[l * MODSTRIDE + col];
#pragma unroll
              for (int ww = 0; ww < 8; ++ww) s += red[(ww * NB + b) * 64 + cc];
              const int slot = col >> 11, c = col & 2047;
              if (slot == 1) s = n1g[l * D + c] * (1.0f + s); else if (slot == 4) s = n2g[l * D + c] * (1.0f + s);
              MOD[((size_t)l * NB + b) * MODSTRIDE + col] = s; }
          WG_BAR(); } }
}

__device__ __forceinline__ void phase_norm0(const Frame& F0, const float* x_p, const float* x_s, const float* mod0, bf16_t* XG, float* RSTD, _Float16* XR) { const Frame F = fresh(F0);
    const int gw = F.bid * NWAVES + F.wave, NGW = F.G * NWAVES, lane = F.lane;
    for (int row = gw; row < T; row += NGW) { const int b = row < ROWS_P ? (row >> 13) : 2 + ((row - ROWS_P) >> 12);
        const float* xr = row < ROWS_P ? x_p + (size_t)row * D : x_s + (size_t)(row - ROWS_P) * D; const float* gm = mod0 + (size_t)b * MODSTRIDE + D;
        f32x4 v[8]; float ss = 0.f;
#pragma unroll
        for (int j = 0; j < 8; ++j) { v[j] = ((const f32x4*)xr)[lane + 64 * j]; ss += (v[j].x * v[j].x + v[j].y * v[j].y) + (v[j].z * v[j].z + v[j].w * v[j].w); }
        ss = wave_sum(ss); if (lane == 0) RSTD[row] = rsqrtf(ss * (1.0f / D) + EPS);
#pragma unroll
        for (int j = 0; j < 8; ++j) { const f32x4 g = ((const f32x4*)gm)[lane + 64 * j]; const f32x4 o = v[j] * g; u32x2 p; p.x = pk2(o.x, o.y); p.y = pk2(o.z, o.w); ((u32x2*)(XG + (size_t)row * D))[lane + 64 * j] = p;
            typedef _Float16 h16x4 __attribute__((ext_vector_type(4))); h16x4 q; q[0] = (_Float16)v[j].x; q[1] = (_Float16)v[j].y; q[2] = (_Float16)v[j].z; q[3] = (_Float16)v[j].w; ((h16x4*)(XR + (size_t)row * D))[lane + 64 * j] = q; } }
}
__device__ __forceinline__ void phase_rstd(const Frame& F0, int mode, const float* SSQX, float* RSTD, const float* SSQA, const float* SSQL, float* RATIO, float* S2) { const Frame F = fresh(F0);
    for (int row = F.bid * 512 + F.tid; row < T; row += F.G * 512) {
        if (mode == 0) { const f32x4* p = (const f32x4*)(SSQX + (size_t)row * 32); f32x4 s = p[0];
#pragma unroll
            for (int j = 1; j < 8; ++j) s += p[j];
            RSTD[row] = rsqrtf(((s.x + s.y) + (s.z + s.w)) * (1.0f / D) + EPS); }
        else { const f32x4* pa = (const f32x4*)(SSQA + (size_t)row * 8); const f32x4* pl = (const f32x4*)(SSQL + (size_t)row * 8); const f32x4 a = pa[0] + pa[1], l = pl[0] + pl[1];
            const float s1 = rsqrtf(((a.x + a.y) + (a.z + a.w)) * (1.0f / 1024.0f) + EPS), s2 = rsqrtf(((l.x + l.y) + (l.z + l.w)) * (1.0f / 1024.0f) + EPS);
            RATIO[row] = s1 / s2; S2[row] = s2; } }
}
__device__ __forceinline__ void phase_bias(const Frame& F0, const float* MOD, const bf16_t* WIN, const bf16_t* WGU, float* BIN, float* BGU) { const Frame F = fresh(F0);
    const int fr = F.lane & 15, fq = F.lane >> 4;
    constexpr int T_IN = ZC / 16, T_GU = 2 * DFF / 16, T_L = T_IN + T_GU;
    for (int tile = F.bid * NWAVES + F.wave; tile < DEPTH * T_L; tile += F.G * NWAVES) { const int l = tile / T_L; int r = tile - l * T_L; const int which = r >= T_IN ? 1 : 0; if (which) r -= T_IN;
        const int N = which ? 2 * DFF : ZC, n0 = 16 * r;
        const bf16_t* wp = (which ? WGU + (size_t)l * 2 * DFF * D : WIN + (size_t)l * ZC * D) + (size_t)(n0 + fr) * D + 8 * fq;
        const float* sp = MOD + ((size_t)l * NB + (fr < NB ? fr : 0)) * MODSTRIDE + (which ? 3 : 0) * D + 8 * fq;
        f32x4 acc = (f32x4){0.f, 0.f, 0.f, 0.f};
#pragma unroll 4
        for (int ks = 0; ks < D / 32; ++ks) { const bf16x8 af = *(const bf16x8*)(wp + 32 * ks); f32x4 s0 = *(const f32x4*)(sp + 32 * ks), s1 = *(const f32x4*)(sp + 32 * ks + 4);
            if (fr >= NB) { s0 = (f32x4){0.f, 0.f, 0.f, 0.f}; s1 = s0; }
            unsigned hi[4], lo[4]; const float sv[8] = {s0.x, s0.y, s0.z, s0.w, s1.x, s1.y, s1.z, s1.w};
#pragma unroll
            for (int j = 0; j < 4; ++j) { const unsigned h0 = f2bf(sv[2 * j]), h1 = f2bf(sv[2 * j + 1]); hi[j] = h0 | (h1 << 16); lo[j] = pk2(sv[2 * j] - __uint_as_float(h0 << 16), sv[2 * j + 1] - __uint_as_float(h1 << 16)); }
            const u32x4 hv = (u32x4){hi[0], hi[1], hi[2], hi[3]}, lv = (u32x4){lo[0], lo[1], lo[2], lo[3]};
            acc = __builtin_amdgcn_mfma_f32_16x16x32_bf16(af, __builtin_bit_cast(bf16x8, hv), acc, 0, 0, 0); acc = __builtin_amdgcn_mfma_f32_16x16x32_bf16(af, __builtin_bit_cast(bf16x8, lv), acc, 0, 0, 0); }
        if (fr < NB) { float* bp = (which ? BGU + (size_t)l * NB * 2 * DFF : BIN + (size_t)l * NB * ZC) + (size_t)fr * N + n0 + 4 * fq; *(f32x4*)bp = acc; }
    }
}

constexpr int AT_ROW = 272, AT_BUF = 2 * 64 * AT_ROW + 256  , AT_KS = 0, AT_VS = 64 * AT_ROW, AT_RSK = 2 * 64 * AT_ROW, AT_BIAS = 2 * AT_BUF, AT_GQ = AT_BIAS + 8 * 384 * 4;
static_assert(AT_GQ + 512 <= LDS_CTL, "attention LDS map");
constexpr float LOG2E = 1.4426950408889634f;
__device__ __forceinline__ int t5_bucket(int rel) { const int n = rel < 0 ? -rel : rel; int v; if (n < 8) v = n; else { v = (31 - __clz(n * n)) + 2; v = v > 15 ? 15 : v; } return (rel > 0 ? 16 : 0) + v; }
__device__ __forceinline__ s16x4 lds_tr16(LAS unsigned char* p) { typedef short v4i16_t __attribute__((ext_vector_type(4))); return __builtin_bit_cast(s16x4, __builtin_amdgcn_ds_read_tr16_b64_v4i16((LAS v4i16_t*)p)); }
__device__ __forceinline__ void phase_attn(const Frame& F0, const bf16_t* Z, const float* qg, const float* kg, const float* sink, const float* relb, bf16_t* MRG, float* SSQA) { const Frame F = fresh(F0);
    LAS unsigned char* lds = F.lds; const int tid = F.tid, lane = F.lane, w = F.wave, fr = lane & 15, fq = lane >> 4, g = w & 3, hq = w >> 2;
    LAS float* bias = (LAS float*)(lds + AT_BIAS);
    for (int i = tid; i < 8 * 384; i += 512) { const int h = i / 384, rel = i - 384 * h - 192; bias[i] = (rel >= -128 && rel <= 128) ? relb[t5_bucket(rel) * 8 + h] * LOG2E - 12.0f : -1e30f; }
    LAS float* gqt = (LAS float*)(lds + AT_GQ);
    if (tid < 128) gqt[tid] = qg[tid] * kg[tid];
    WG_BAR();
    const int p0 = tid, p1 = tid + 512;
    const int per_x = ((T / 64) * 2 + 7) / 8, slots = F.G / 8;
    for (int it_ = F.bid >> 3; it_ < per_x; it_ += slots) { const int item = (F.bid & 7) * per_x + it_; if (item >= (T / 64) * 2) break;
        const int qb = item >> 1, kvh = item & 1, q0 = qb * 64, h = kvh * 4 + g; int b_, t0, S; rowinfo(q0, b_, t0, S); const int seq0 = q0 - t0;
        bf16x8 Qf[2][4];
#pragma unroll
        for (int qt = 0; qt < 2; ++qt) { const bf16_t* qp = Z + (size_t)(q0 + 32 * hq + 16 * qt + fr) * ZC + ZQ + h * 128 + 8 * fq; u32x4 raw[4]; float ss = 0.f;
#pragma unroll
            for (int ks = 0; ks < 4; ++ks) { raw[ks] = *(const u32x4*)(qp + 32 * ks); const unsigned rw[4] = {raw[ks].x, raw[ks].y, raw[ks].z, raw[ks].w};
#pragma unroll
                for (int e = 0; e < 4; ++e) { const float a0 = bflo(rw[e]), a1 = bfhi(rw[e]); ss += a0 * a0 + a1 * a1; } }
            ss += __shfl_xor(ss, 16); ss += __shfl_xor(ss, 32);
            const float rs = rsqrtf(ss * (1.0f / 128.0f) + EPS) * (0.08838834764831845f * LOG2E);
#pragma unroll
            for (int ks = 0; ks < 4; ++ks) { const unsigned rw[4] = {raw[ks].x, raw[ks].y, raw[ks].z, raw[ks].w}; u32x4 o;
                const f32x4 g0 = *(const LAS f32x4*)(gqt + 32 * ks + 8 * fq), g1 = *(const LAS f32x4*)(gqt + 32 * ks + 8 * fq + 4);
                o.x = pg8::cvt_pk_bf16(bflo(rw[0]) * rs * g0[0], bfhi(rw[0]) * rs * g0[1]); o.y = pg8::cvt_pk_bf16(bflo(rw[1]) * rs * g0[2], bfhi(rw[1]) * rs * g0[3]);
                o.z = pg8::cvt_pk_bf16(bflo(rw[2]) * rs * g1[0], bfhi(rw[2]) * rs * g1[1]); o.w = pg8::cvt_pk_bf16(bflo(rw[3]) * rs * g1[2], bfhi(rw[3]) * rs * g1[3]);
                Qf[qt][ks] = __builtin_bit_cast(bf16x8, o); } }
        f32x4 O[8][2];
#pragma unroll
        for (int dt = 0; dt < 8; ++dt) { O[dt][0] = (f32x4){0.f, 0.f, 0.f, 0.f}; O[dt][1] = (f32x4){0.f, 0.f, 0.f, 0.f}; }
        float lsum[2] = {0.f, 0.f};
        const int c_lo = t0 >= 128 ? 0 : (128 - t0) / 64, c_hi = (t0 + 192 <= S) ? 4 : 4 - (t0 + 192 - S) / 64;
        u32x4 kr[2], vr[2];
#define AT_FETCH(c) do { const size_t rb = (size_t)(seq0 + t0 - 128 + 64 * (c)); \
          kr[0] = *(const u32x4*)(Z + (rb + (p0 >> 4)) * ZC + ZK + kvh * 128 + 8 * (p0 & 15)); kr[1] = *(const u32x4*)(Z + (rb + (p1 >> 4)) * ZC + ZK + kvh * 128 + 8 * (p1 & 15)); \
          vr[0] = *(const u32x4*)(Z + (rb + (p0 >> 4)) * ZC + ZV + kvh * 128 + 8 * (p0 & 15)); vr[1] = *(const u32x4*)(Z + (rb + (p1 >> 4)) * ZC + ZV + kvh * 128 + 8 * (p1 & 15)); } while (0)
#define AT_PARK(buf) do { LAS unsigned char* bb = lds + (buf) * AT_BUF; _Pragma("unroll") for (int i = 0; i < 2; ++i) { const int p = i ? p1 : p0, key = p >> 4, part = p & 15; \
                *(LAS u32x4*)(bb + AT_KS + key * AT_ROW + part * 16) = kr[i]; *(LAS u32x4*)(bb + AT_VS + key * AT_ROW + part * 16) = vr[i]; \
                const unsigned kw[4] = {kr[i].x, kr[i].y, kr[i].z, kr[i].w}; float ss = 0.f; \
                _Pragma("unroll") for (int e = 0; e < 4; ++e) { const float a0 = bflo(kw[e]), a1 = bfhi(kw[e]); ss += a0 * a0 + a1 * a1; } \
                ss += __shfl_xor(ss, 1); ss += __shfl_xor(ss, 2); ss += __shfl_xor(ss, 4); ss += __shfl_xor(ss, 8); \
                if (part == 0) ((LAS float*)(bb + AT_RSK))[key] = rsqrtf(ss * (1.0f / 128.0f) + EPS); } } while (0)
        AT_FETCH(c_lo);
        WG_BAR();
        AT_PARK(0);
        WG_BAR();
        for (int c = c_lo; c <= c_hi; ++c) { LAS unsigned char* bb = lds + ((c - c_lo) & 1) * AT_BUF;
            if (c < c_hi) AT_FETCH(c + 1);
            f32x4 Sx[4][2];
#pragma unroll
            for (int kt = 0; kt < 4; ++kt) { Sx[kt][0] = (f32x4){0.f, 0.f, 0.f, 0.f}; Sx[kt][1] = (f32x4){0.f, 0.f, 0.f, 0.f};
#pragma unroll
                for (int ks = 0; ks < 4; ++ks) { const bf16x8 kf = *(const LAS bf16x8*)(bb + AT_KS + (16 * kt + fr) * AT_ROW + (32 * ks + 8 * fq) * 2);
                    Sx[kt][0] = __builtin_amdgcn_mfma_f32_16x16x32_bf16(kf, Qf[0][ks], Sx[kt][0], 0, 0, 0); Sx[kt][1] = __builtin_amdgcn_mfma_f32_16x16x32_bf16(kf, Qf[1][ks], Sx[kt][1], 0, 0, 0); } }
            bf16x8 Pf[2][2];
            f32x4 rk[4];
#pragma unroll
            for (int kt = 0; kt < 4; ++kt) rk[kt] = *(const LAS f32x4*)(bb + AT_RSK + (16 * kt + 4 * fq) * 4);
#pragma unroll
            for (int qt = 0; qt < 2; ++qt) { float pv[4][4]; const LAS float* bp = bias + h * 384 + 64 * c + 64 + 4 * fq - (32 * hq + 16 * qt + fr);
#pragma unroll
                for (int kt = 0; kt < 4; ++kt)
#pragma unroll
                    for (int i = 0; i < 4; ++i) { const float p = __builtin_amdgcn_exp2f(Sx[kt][qt][i] * rk[kt][i] + bp[16 * kt + i]); pv[kt][i] = p; lsum[qt] += p; }
#pragma unroll
                for (int s = 0; s < 2; ++s) { u32x4 o; o.x = pg8::cvt_pk_bf16(pv[2 * s][0], pv[2 * s][1]); o.y = pg8::cvt_pk_bf16(pv[2 * s][2], pv[2 * s][3]); o.z = pg8::cvt_pk_bf16(pv[2 * s + 1][0], pv[2 * s + 1][1]); o.w = pg8::cvt_pk_bf16(pv[2 * s + 1][2], pv[2 * s + 1][3]);
                    Pf[qt][s] = __builtin_bit_cast(bf16x8, o); } }
#pragma unroll
            for (int dt = 0; dt < 8; ++dt)
#pragma unroll
                for (int s = 0; s < 2; ++s) { LAS unsigned char* vb = bb + AT_VS + (32 * s + 4 * fq + (fr >> 2)) * AT_ROW + (16 * dt + 4 * (fr & 3)) * 2;
                    const s16x4 lo = lds_tr16(vb), hi = lds_tr16(vb + 16 * AT_ROW);
                    const bf16x8 vf = (bf16x8){lo[0], lo[1], lo[2], lo[3], hi[0], hi[1], hi[2], hi[3]};
                    O[dt][0] = __builtin_amdgcn_mfma_f32_16x16x32_bf16(vf, Pf[0][s], O[dt][0], 0, 0, 0); O[dt][1] = __builtin_amdgcn_mfma_f32_16x16x32_bf16(vf, Pf[1][s], O[dt][1], 0, 0, 0); }
            if (c < c_hi) { AT_PARK(((c - c_lo) & 1) ^ 1); WG_BAR(); }
        }
#undef AT_FETCH
#undef AT_PARK
        const float sk = __builtin_amdgcn_exp2f(sink[h] * LOG2E - 12.0f);
#pragma unroll
        for (int qt = 0; qt < 2; ++qt) { float l = lsum[qt]; l += __shfl_xor(l, 16); l += __shfl_xor(l, 32); const float inv = 1.0f / (l + sk);
            const int row = q0 + 32 * hq + 16 * qt + fr; bf16_t* op = MRG + (size_t)row * D + h * 128 + 4 * fq; float ss = 0.f;
#pragma unroll
            for (int dt = 0; dt < 8; ++dt) { u32x2 o; o.x = pg8::cvt_pk_bf16(O[dt][qt][0] * inv, O[dt][qt][1] * inv); o.y = pg8::cvt_pk_bf16(O[dt][qt][2] * inv, O[dt][qt][3] * inv); *(u32x2*)(op + 16 * dt) = o;
                const float e0 = bflo(o.x), e1 = bfhi(o.x), e2 = bflo(o.y), e3 = bfhi(o.y); ss += (e0 * e0 + e1 * e1) + (e2 * e2 + e3 * e3); }
            ss += __shfl_xor(ss, 16); ss += __shfl_xor(ss, 32); if (fq == 0) SSQA[(size_t)row * 8 + h] = ss; }
    }
    WG_BAR();
}

constexpr int LR_HF = 0, LR_HF_ROW = 528, LR_XCB = 67584, LR_YG = 102656, LR_YG_ROW = 272, LR_END = 137472;
static_assert(LR_END <= LDS_CTL, "LRU LDS map");
__device__ __forceinline__ int xcb_off(int tok) { return tok * 272 + (tok >> 5) * 64; }
struct LruConsts { float ba_f, ba_b, bx_f, bx_b, sp_f, sp_b; };
__device__ __forceinline__ void lru_fetch_xr(const Frame& F, const bf16_t* Z, int row0, int n, unsigned (&xr)[19]) {
    const int cp = F.tid & 63, tg = F.tid >> 6, ch = 128 * n + 2 * cp; int b_, t0, S; rowinfo(row0, b_, t0, S);
#pragma unroll
    for (int i = 0; i < 19; ++i) { const int tt = t0 + 16 * tg - 2 + i; unsigned v = 0u; if (tt >= 0 && tt < S) v = *(const unsigned*)(Z + (size_t)(row0 + 16 * tg - 2 + i) * ZC + ZX + ch); xr[i] = v; }
}
__device__ __forceinline__ void lru_park_xc(const Frame& F, const float* cw, const float* cb, int n, const unsigned (&xr)[19]) {
    const int cp = F.tid & 63, tg = F.tid >> 6, ch = 128 * n + 2 * cp;
    const float w00 = cw[ch], w01 = cw[ch + 1], w10 = cw[1024 + ch], w11 = cw[1024 + ch + 1], w20 = cw[2048 + ch], w21 = cw[2048 + ch + 1], w30 = cw[3072 + ch], w31 = cw[3072 + ch + 1], b0 = cb[ch], b1 = cb[ch + 1];
#pragma unroll
    for (int i = 0; i < 16; ++i) { const float y0 = b0 + w00 * bflo(xr[i]) + w10 * bflo(xr[i + 1]) + w20 * bflo(xr[i + 2]) + w30 * bflo(xr[i + 3]), y1 = b1 + w01 * bfhi(xr[i]) + w11 * bfhi(xr[i + 1]) + w21 * bfhi(xr[i + 2]) + w31 * bfhi(xr[i + 3]);
        const int tk = 16 * tg + i; *(LAS unsigned*)(F.lds + LR_XCB + xcb_off(tk) + 4 * cp) = pk2(y0, y1); }
}
typedef _Float16 f16x8 __attribute__((ext_vector_type(8)));
__device__ __forceinline__ void lru_ab2(f32x2 ga, f32x2 gx, f32x2 xc, float ba, float bx, float sp, f32x2& la, f32x2& a, f32x2& b) {
    const f32x2 ta = (ga + ba) * (-LOG2E), tx = (gx + bx) * (-LOG2E);
    f32x2 da, dx; da.x = 1.0f + __builtin_amdgcn_exp2f(ta.x); da.y = 1.0f + __builtin_amdgcn_exp2f(ta.y); dx.x = 1.0f + __builtin_amdgcn_exp2f(tx.x); dx.y = 1.0f + __builtin_amdgcn_exp2f(tx.y);
    const f32x2 dd = da * dx; f32x2 rc; rc.x = __builtin_amdgcn_rcpf(dd.x); rc.y = __builtin_amdgcn_rcpf(dd.y);
    const f32x2 r = dx * rc, ig = da * rc;
    la = r * (-8.0f * sp);
    const f32x2 tl = la * LOG2E; a.x = __builtin_amdgcn_exp2f(tl.x); a.y = __builtin_amdgcn_exp2f(tl.y);
    const f32x2 x2 = la * 2.0f;
    const f32x2 ser = -x2 * (1.0f + x2 * (0.5f + x2 * 0.16666667f)), alt = (1.0f - a) * (1.0f + a);
    f32x2 om; om.x = x2.x > -0.25f ? ser.x : alt.x; om.y = x2.y > -0.25f ? ser.y : alt.y;
    f32x2 sq; sq.x = __builtin_amdgcn_sqrtf(om.x); sq.y = __builtin_amdgcn_sqrtf(om.y);
    b = sq * ig * xc;
}
__device__ __forceinline__ void lru_load_w(const bf16_t* LWl, int n, int w, int lane, int gs, bf16x8 (&Wf)[4]) {
    int lo = lane * 8; asm volatile("" : "+v"(lo));
#pragma unroll
    for (int ks = 0; ks < 4; ++ks) Wf[ks] = *(const bf16x8*)(LWl + (size_t)(((n * 8 + w) * 4 + gs) * 4 + ks) * 512 + lo);
}
__device__ __forceinline__ LruConsts lru_consts(const float* b_a, const float* b_x, const float* lam, int ch) {
    LruConsts c; c.ba_f = b_a[ch]; c.ba_b = b_a[1024 + ch]; c.bx_f = b_x[ch]; c.bx_b = b_x[1024 + ch]; c.sp_f = lam[ch]; c.sp_b = lam[1024 + ch]; return c;
}
__device__ __forceinline__ void phase_lru1(const Frame& F0, const bf16_t* Z, const bf16_t* LWl, const float* cw, const float* cb, const float* b_a, const float* b_x, const float* lam, float* SUM, f16x8* LC) { const Frame F = fresh(F0);
    const int lane = F.lane, w = F.wave, fr = lane & 15, fq = lane >> 4, n = F.bid & 7, ch = 128 * n + 16 * w + fr;
    bf16x8 Waf[4], Wab[4], Wxf[4], Wxb[4]; lru_load_w(LWl, n, w, lane, 0, Waf); lru_load_w(LWl, n, w, lane, 1, Wab); lru_load_w(LWl, n, w, lane, 2, Wxf); lru_load_w(LWl, n, w, lane, 3, Wxb);
    const LruConsts C = lru_consts(b_a, b_x, lam, ch);
    const int arow = 32 * (fr >> 2) + (fr & 3);
    unsigned xr[19];
    if (F.bid < (T / 128) * 8) lru_fetch_xr(F, Z, (F.bid >> 3) * 128, n, xr);
    for (int item = F.bid; item < (T / 128) * 8; item += F.G) { const int chunk = item >> 3;
        WG_BAR(); lru_park_xc(F, cw, cb, n, xr);
        if (item + F.G < (T / 128) * 8) lru_fetch_xr(F, Z, ((item + F.G) >> 3) * 128, n, xr);
        asm volatile("s_waitcnt lgkmcnt(0)" ::: "memory"); __builtin_amdgcn_s_barrier(); asm volatile("" ::: "memory");
        float RAf = 1.f, RBf = 0.f, RAb = 1.f, RBb = 0.f;
#pragma unroll 2
        for (int tau = 0; tau < 8; ++tau) {
            f32x4 gaf = (f32x4){0.f, 0.f, 0.f, 0.f}, gab = gaf, gxf = gaf, gxb = gaf;
#pragma unroll
            for (int ks = 0; ks < 4; ++ks) { const bf16x8 af = *(const LAS bf16x8*)(F.lds + LR_XCB + xcb_off(arow + 4 * tau) + (32 * ks + 8 * fq) * 2);
                gaf = __builtin_amdgcn_mfma_f32_16x16x32_bf16(af, Waf[ks], gaf, 0, 0, 0); gab = __builtin_amdgcn_mfma_f32_16x16x32_bf16(af, Wab[ks], gab, 0, 0, 0);
                gxf = __builtin_amdgcn_mfma_f32_16x16x32_bf16(af, Wxf[ks], gxf, 0, 0, 0); gxb = __builtin_amdgcn_mfma_f32_16x16x32_bf16(af, Wxb[ks], gxb, 0, 0, 0); }
            float xc[4];
#pragma unroll
            for (int i = 0; i < 4; ++i) xc[i] = bf2f(*(const LAS bf16_t*)(F.lds + LR_XCB + xcb_off(32 * fq + 4 * tau + i) + (16 * w + fr) * 2));
            f16x8 cf, cbk;
#pragma unroll
            for (int p = 0; p < 2; ++p) { f32x2 la, a, b; const f32x2 x = (f32x2){xc[2 * p], xc[2 * p + 1]};
                lru_ab2((f32x2){gaf[2 * p], gaf[2 * p + 1]}, (f32x2){gxf[2 * p], gxf[2 * p + 1]}, x, C.ba_f, C.bx_f, C.sp_f, la, a, b);
                RBf = a.x * RBf + b.x; RAf = a.x * RAf; RBf = a.y * RBf + b.y; RAf = a.y * RAf;
                cf[4 * p] = (_Float16)la.x; cf[4 * p + 1] = (_Float16)b.x; cf[4 * p + 2] = (_Float16)la.y; cf[4 * p + 3] = (_Float16)b.y;
                lru_ab2((f32x2){gab[2 * p], gab[2 * p + 1]}, (f32x2){gxb[2 * p], gxb[2 * p + 1]}, x, C.ba_b, C.bx_b, C.sp_b, la, a, b);
                RBb = RAb * b.x + RBb; RAb = RAb * a.x; RBb = RAb * b.y + RBb; RAb = RAb * a.y;
                cbk[4 * p] = (_Float16)la.x; cbk[4 * p + 1] = (_Float16)b.x; cbk[4 * p + 2] = (_Float16)la.y; cbk[4 * p + 3] = (_Float16)b.y; }
            f16x8* cp = LC + ((size_t)(item * 8 + w) * 16 + tau) * 64 + lane;
            __builtin_nontemporal_store(cf, cp); __builtin_nontemporal_store(cbk, cp + 8 * 64); }
#pragma unroll
        for (int st = 0; st < 2; ++st) { const int o = 16 << st; const bool early = ((fq >> st) & 1) == 0;
            const float pAf = __shfl_xor(RAf, o), pBf = __shfl_xor(RBf, o), pAb = __shfl_xor(RAb, o), pBb = __shfl_xor(RBb, o);
            const float XAf = early ? RAf : pAf, XBf = early ? RBf : pBf, YAf = early ? pAf : RAf, YBf = early ? pBf : RBf;
            const float XAb = early ? RAb : pAb, XBb = early ? RBb : pBb, YAb = early ? pAb : RAb, YBb = early ? pBb : RBb;
            RAf = YAf * XAf; RBf = YAf * XBf + YBf; RAb = XAb * YAb; RBb = XAb * YBb + XBb; }
        if (fq == 0) { float* s = SUM + (size_t)chunk * 4096 + ch; s[0] = RAf; s[1024] = RBf; s[2048] = RAb; s[3072] = RBb; }
    }
    WG_BAR();
}
__device__ __forceinline__ void phase_lru_carry(const Frame& F0, const float* SUM, float* CAR) { const Frame F = fresh(F0);
    for (int id = F.bid * 512 + F.tid; id < NB * 2048; id += F.G * 512) { const int s = id >> 11, dir = (id >> 10) & 1, ch = id & 1023;
        const int c0 = s < 2 ? 64 * s : 128 + 32 * (s - 2), nc = s < 2 ? 64 : 32; float h = 0.f;
        for (int j0 = 0; j0 < nc; j0 += 8) { float A[8], B[8];
#pragma unroll
            for (int k = 0; k < 8; ++k) { const int j = dir == 0 ? j0 + k : nc - 1 - (j0 + k); const size_t o = (size_t)(c0 + j) * 4096 + (dir ? 2048 : 0) + ch; A[k] = SUM[o]; B[k] = SUM[o + 1024]; }
#pragma unroll
            for (int k = 0; k < 8; ++k) { const int j = dir == 0 ? j0 + k : nc - 1 - (j0 + k); CAR[(size_t)(c0 + j) * 2048 + (dir ? 1024 : 0) + ch] = h; h = A[k] * h + B[k]; } } }
}
__device__ __forceinline__ void lru_unpack_ab(const f16x8 (&c)[8], float (&a)[32], float (&b)[32]) {
#pragma unroll
    for (int tau = 0; tau < 8; ++tau)
#pragma unroll
        for (int i = 0; i < 4; ++i) { a[4 * tau + i] = __builtin_amdgcn_exp2f((float)c[tau][2 * i] * LOG2E); b[4 * tau + i] = (float)c[tau][2 * i + 1]; }
}
__device__ __forceinline__ void phase_lru2(const Frame& F0, const bf16_t* Z, const f16x8* LC, const float* CAR, bf16_t* MRG, float* SSQL) { const Frame F = fresh(F0);
    const int lane = F.lane, w = F.wave, fr = lane & 15, fq = lane >> 4, n = F.bid & 7, ch = 128 * n + 16 * w + fr;
    constexpr int NITEM = (T / 128) * 8;
    f16x8 cf_[8], cb_[8]; float cf = 0.f, cbk = 0.f; u32x4 yv[4];
#define LR2_FETCH(it) do { const int chunk_ = (it) >> 3; const f16x8* cp_ = LC + (size_t)((it) * 8 + w) * 16 * 64 + lane; \
        _Pragma("unroll") for (int tau = 0; tau < 8; ++tau) { cf_[tau] = __builtin_nontemporal_load(cp_ + tau * 64); cb_[tau] = __builtin_nontemporal_load(cp_ + (8 + tau) * 64); } \
        cf = CAR[(size_t)chunk_ * 2048 + ch]; cbk = CAR[(size_t)chunk_ * 2048 + 1024 + ch]; \
        _Pragma("unroll") for (int i = 0; i < 4; ++i) { const int p = F.tid + 512 * i, tk = p >> 4, part = p & 15; yv[i] = *(const u32x4*)(Z + (size_t)(chunk_ * 128 + tk) * ZC + ZY + 128 * n + 8 * part); } } while (0)
    if (F.bid < NITEM) LR2_FETCH(F.bid);
    for (int item = F.bid; item < NITEM; item += F.G) { const int chunk = item >> 3, row0 = chunk * 128;
        WG_BAR();
#pragma unroll
        for (int i = 0; i < 4; ++i) { const int p = F.tid + 512 * i, tk = p >> 4, part = p & 15; *(LAS u32x4*)(F.lds + LR_YG + tk * LR_YG_ROW + part * 16) = yv[i]; }
        float a[32], b[32], hf[32]; const float cfw = cf, cbw = cbk;
        lru_unpack_ab(cf_, a, b);
        { float IA = 1.f, IB = 0.f;
#pragma unroll
          for (int t = 0; t < 32; ++t) { IB = a[t] * IB + b[t]; IA = a[t] * IA; }
          { const float xA = __shfl_up(IA, 16), xB = __shfl_up(IB, 16); if (fq >= 1) { IB = IA * xB + IB; IA = IA * xA; } }
          { const float xA = __shfl_up(IA, 32), xB = __shfl_up(IB, 32); if (fq >= 2) { IB = IA * xB + IB; IA = IA * xA; } }
          float EA = __shfl_up(IA, 16), EB = __shfl_up(IB, 16); if (fq == 0) { EA = 1.f; EB = 0.f; }
          float h = EA * cfw + EB;
#pragma unroll
          for (int t = 0; t < 32; ++t) { h = a[t] * h + b[t]; hf[t] = h; } }
        lru_unpack_ab(cb_, a, b);
        if (item + F.G < NITEM) LR2_FETCH(item + F.G);
        asm volatile("s_waitcnt lgkmcnt(0)" ::: "memory"); __builtin_amdgcn_s_barrier(); asm volatile("" ::: "memory");
        { float IA = 1.f, IB = 0.f;
#pragma unroll
          for (int t = 31; t >= 0; --t) { IB = a[t] * IB + b[t]; IA = a[t] * IA; }
          { const float xA = __shfl_down(IA, 16), xB = __shfl_down(IB, 16); if (fq <= 2) { IB = IA * xB + IB; IA = IA * xA; } }
          { const float xA = __shfl_down(IA, 32), xB = __shfl_down(IB, 32); if (fq <= 1) { IB = IA * xB + IB; IA = IA * xA; } }
          float EA = __shfl_down(IA, 16), EB = __shfl_down(IB, 16); if (fq == 3) { EA = 1.f; EB = 0.f; }
          float h = EA * cbw + EB;
#pragma unroll
          for (int t = 31; t >= 0; --t) { h = a[t] * h + b[t]; LAS bf16_t* yp = (LAS bf16_t*)(F.lds + LR_YG + (32 * fq + t) * LR_YG_ROW + (16 * w + fr) * 2);
              *yp = (bf16_t)f2bf((hf[t] + h) * pg8::gelu_tanh_f(bf2f(*yp))); if ((t & 7) == 0) __builtin_amdgcn_sched_barrier(0); } }
        asm volatile("s_waitcnt lgkmcnt(0)" ::: "memory"); __builtin_amdgcn_s_barrier(); asm volatile("" ::: "memory");
#pragma unroll
        for (int i = 0; i < 4; ++i) { const int p = F.tid + 512 * i, tk = p >> 4, part = p & 15; const u32x4 v = *(const LAS u32x4*)(F.lds + LR_YG + tk * LR_YG_ROW + part * 16);
            *(u32x4*)(MRG + (size_t)(row0 + tk) * D + 1024 + 128 * n + 8 * part) = v;
            float ss = (bflo(v.x) * bflo(v.x) + bfhi(v.x) * bfhi(v.x)) + (bflo(v.y) * bflo(v.y) + bfhi(v.y) * bfhi(v.y)) + (bflo(v.z) * bflo(v.z) + bfhi(v.z) * bfhi(v.z)) + (bflo(v.w) * bflo(v.w) + bfhi(v.w) * bfhi(v.w));
            ss += __shfl_xor(ss, 1); ss += __shfl_xor(ss, 2); ss += __shfl_xor(ss, 4); ss += __shfl_xor(ss, 8); if (part == 0) SSQL[(size_t)(row0 + tk) * 8 + n] = ss; }
    }
#undef LR2_FETCH
    WG_BAR();
}

__device__ __forceinline__ void phase_glu_fix(const Frame& F0, const float* HALO, const float* cw, const float* cb, bf16_t* ACT) { const Frame F = fresh(F0);
    for (int id = F.bid * 512 + F.tid; id < 384 * (DFF / 4); id += F.G * 512) { const int e = id / (DFF / 4), c = (id - e * (DFF / 4)) * 4, pm = e >> 1, side = e & 1, row = 256 * pm + (side ? 255 : 0);
        int b_, t, S; rowinfo(row, b_, t, S);
        const float* hp = HALO + (size_t)pm * 6 * DFF + c; const f32x4 z = (f32x4){0.f, 0.f, 0.f, 0.f};
        f32x4 gp, gc, gn, up;
        if (side == 0) { gp = t == 0 ? z : *(const f32x4*)(hp - 6 * DFF + 3 * DFF); gc = *(const f32x4*)(hp); gn = *(const f32x4*)(hp + DFF); up = *(const f32x4*)(hp + 4 * DFF); }
        else { gp = *(const f32x4*)(hp + 2 * DFF); gc = *(const f32x4*)(hp + 3 * DFF); gn = t == S - 1 ? z : *(const f32x4*)(hp + 6 * DFF); up = *(const f32x4*)(hp + 5 * DFF); }
        const f32x4 g = *(const f32x4*)(cw + c) * gp + *(const f32x4*)(cw + DFF + c) * gc + *(const f32x4*)(cw + 2 * DFF + c) * gn + *(const f32x4*)(cb + c);
        u32x2 o; o.x = pg8::cvt_pk_bf16(pg8::gelu_tanh_f(g[0]) * up[0], pg8::gelu_tanh_f(g[1]) * up[1]); o.y = pg8::cvt_pk_bf16(pg8::gelu_tanh_f(g[2]) * up[2], pg8::gelu_tanh_f(g[3]) * up[3]);
        *(u32x2*)(ACT + (size_t)row * DFF + c) = o; }
}

constexpr int PH_PER_LAYER = 11, PH0 = 2, N_PHASES = PH0 + DEPTH * PH_PER_LAYER;
#ifndef PHMASK
#define PHMASK 0xfff
#endif
#define PEN(k) ((PHMASK >> (k)) & 1)
#ifndef DBLMASK
#define DBLMASK 0
#endif
#define REP(k) for (int rep_ = 0; rep_ < 1 + ((DBLMASK >> (k)) & 1); ++rep_)
__global__ void __launch_bounds__(NWAVES * 64, 2) mega_fwd(Args a) {
    extern __shared__ __attribute__((aligned(16))) unsigned char lds_raw[];
    Frame F; F.lds = (LAS unsigned char*)lds_raw; F.tid = threadIdx.x; F.lane = F.tid & 63; F.wave = __builtin_amdgcn_readfirstlane(F.tid >> 6); F.G = gridDim.x; F.bid = blockIdx.x;
    unsigned char* ws = karg_ws();
    volatile LAS unsigned* MISC = (volatile LAS unsigned*)(F.lds + LDS_CTL);
    if (F.tid < 64) MISC[F.tid] = 0u;
    __syncthreads();
    const int lo = a.ph_lo, hi = a.ph_hi;
    XcdBarrier bar; bar.bar = (unsigned*)(ws + WS_CTL) + CW_BAR; bar.x = 0; bar.st = MISC; bar.wv = F.wave;
    if (hi - lo > 1) bar = xcd_barrier_post((unsigned*)(ws + WS_CTL) + CW_BAR, MISC, F.wave);
#define IN(k) (lo <= (k) && (k) < hi)
#define SEAM(k) do { if (IN(k) && IN((k) + 1)) xcd_barrier(bar); } while (0)
#define WSP(type, off) ((type*)(karg_ws() + (off)))
    PG8_LAS unsigned char* ring = (PG8_LAS unsigned char*)lds_raw;

    if (PEN(0) && IN(0)) { REP(0) phase_prologue(F, a); } SEAM(0);
    if (PEN(11) && IN(1)) { phase_bias(F, WSP(float, WS_MOD), WSP(bf16_t, WS_WIN), WSP(bf16_t, WS_WGU), WSP(float, WS_BIN), WSP(float, WS_BGU)); phase_norm0(F, karg_in(0), karg_in(1), WSP(float, WS_MOD), WSP(bf16_t, WS_H), WSP(float, WS_RSTD), WSP(_Float16, WS_XR)); } SEAM(1);
    for (int l = 0; l < DEPTH; ++l) {
        const int pb = PH0 + PH_PER_LAYER * l;
        const float* bp = l == 0 ? karg_in(0) : karg_out(); const float* bs = l == 0 ? karg_in(1) : karg_out() + (size_t)ROWS_P * D;
        if (PEN(1) && IN(pb + 0)) { if (l > 0) phase_rstd(F, 0, WSP(float, WS_SSQX), WSP(float, WS_RSTD), nullptr, nullptr, nullptr, nullptr); } SEAM(pb + 0);
        if (PEN(2) && IN(pb + 1)) { REP(2) { pg8::Gemm g{WSP(bf16_t, WS_H), WSP(bf16_t, WS_WIN) + (size_t)l * ZC * D, T, ZC, D}; pg8::StaticOrder S; S.init(T, ZC, F.G, F.bid); pg8::EpiStoreBf16N E{WSP(bf16_t, WS_Z), ZC, WSP(float, WS_RSTD), WSP(float, WS_BIN) + (size_t)l * NB * ZC};
            pg8::gemm_phase(ring, g, S, E, pg8::IdentMap{}, F.wave); } } SEAM(pb + 1);
        if (IN(pb + 2)) {
            if (PEN(3)) REP(3) phase_attn(F, WSP(bf16_t, WS_Z), karg_in(10) + l * 128, karg_in(11) + l * 128, karg_in(12) + l * 8, karg_in(4), WSP(bf16_t, WS_MRG), WSP(float, WS_SSQA));
            if (PEN(4)) REP(4) phase_lru1(F, WSP(bf16_t, WS_Z), WSP(bf16_t, WS_LW) + (size_t)l * 512 * 1024, karg_in(13) + (size_t)l * 4096, karg_in(14) + l * 1024, karg_in(16) + l * 2048, karg_in(18) + l * 2048, WSP(float, WS_LSP) + l * 2048, WSP(float, WS_SUM), (f16x8*)karg_out()); } SEAM(pb + 2);
        if (IN(pb + 3)) { if (PEN(5)) REP(5) phase_lru_carry(F, WSP(float, WS_SUM), WSP(float, WS_CAR)); } SEAM(pb + 3);
        if (IN(pb + 4)) { if (PEN(6)) REP(6) phase_lru2(F, WSP(bf16_t, WS_Z), (const f16x8*)karg_out(), WSP(float, WS_CAR), WSP(bf16_t, WS_MRG), WSP(float, WS_SSQL)); } SEAM(pb + 4);
        if (PEN(7) && IN(pb + 5)) { phase_rstd(F, 1, nullptr, nullptr, WSP(float, WS_SSQA), WSP(float, WS_SSQL), WSP(float, WS_RATIO), WSP(float, WS_S2)); } SEAM(pb + 5);
        if (PEN(8) && IN(pb + 6)) for (int rep_ = 0; rep_ < 1 + ((l == 0) ? ((DBLMASK >> 8) & 1) : 0); ++rep_) { const float* modl = WSP(float, WS_MOD) + (size_t)l * NB * MODSTRIDE; pg8::Gemm g{WSP(bf16_t, WS_MRG), WSP(bf16_t, WS_WOUT) + (size_t)l * D * D, T, D, D}; pg8::StaticOrder S; S.init(T, D, F.G, F.bid);
            pg8::EpiResid2<true> E{WSP(_Float16, WS_XR), nullptr, modl + 2 * D, modl + 4 * D, WSP(bf16_t, WS_H), WSP(float, WS_SSQX), WSP(float, WS_RATIO), WSP(float, WS_S2)}; pg8::gemm_phase(ring, g, S, E, pg8::IdentMap{}, F.wave); } SEAM(pb + 6);
        if (PEN(1) && IN(pb + 7)) { phase_rstd(F, 0, WSP(float, WS_SSQX), WSP(float, WS_RSTD), nullptr, nullptr, nullptr, nullptr); } SEAM(pb + 7);
        if (IN(pb + 8)) { if (PEN(9)) REP(9) { pg8::Gemm g{WSP(bf16_t, WS_H), WSP(bf16_t, WS_WGU) + (size_t)l * 2 * DFF * D, T, 2 * DFF, D}; pg8::StaticOrder S; S.init(T, 2 * DFF, F.G, F.bid);
            pg8::EpiGLU2 E{WSP(bf16_t, WS_ACT), karg_in(25) + (size_t)l * 3 * DFF, karg_in(26) + l * DFF, WSP(float, WS_RSTD), WSP(float, WS_BGU) + (size_t)l * NB * 2 * DFF, WSP(float, WS_HALO), (PG8_LAS float*)(ring + pg8::STAGE_BYTES)};
            pg8::gemm_phase(ring, g, S, E, pg8::IdentMap{}, F.wave); } } SEAM(pb + 8);
        if (IN(pb + 9)) { if (PEN(9)) phase_glu_fix(F, WSP(float, WS_HALO), karg_in(25) + (size_t)l * 3 * DFF, karg_in(26) + l * DFF, WSP(bf16_t, WS_ACT)); } SEAM(pb + 9);
        if (IN(pb + 10)) { if (PEN(10)) { const float* modl = WSP(float, WS_MOD) + (size_t)l * NB * MODSTRIDE; pg8::Gemm g{WSP(bf16_t, WS_ACT), WSP(bf16_t, WS_WDN) + (size_t)l * D * DFF, T, D, DFF}; pg8::StaticOrder S; S.init(T, D, F.G, F.bid);
            pg8::EpiResid2<false> E{WSP(_Float16, WS_XR), l + 1 < DEPTH ? nullptr : karg_out(), modl + 5 * D, l + 1 < DEPTH ? modl + (size_t)NB * MODSTRIDE + D : nullptr, WSP(bf16_t, WS_H), WSP(float, WS_SSQX), nullptr, nullptr};
            pg8::gemm_phase(ring, g, S, E, pg8::IdentMap{}, F.wave); } } SEAM(pb + 10);
    }
#undef IN
#undef SEAM
}
#ifndef HYB
#define HYB 0
#endif
extern "C" void kernel_launch(void* const* d_in, const int* in_sizes, int n_in, void* d_out, int out_size, void* d_ws, size_t ws_size, hipStream_t stream) {
    static int grid = 0;
    if (grid == 0) {
        if (n_in != 28 || ws_size < WS_END || out_size != T * D) { fprintf(stderr, "kernel_launch: unexpected sizes (n_in %d, ws %zu, out %d)\n", n_in, ws_size, out_size); grid = -1; return; }
        int dev = 0, cus = 0, per_cu = 0;
        if (hipGetDevice(&dev) != hipSuccess || hipDeviceGetAttribute(&cus, hipDeviceAttributeMultiprocessorCount, dev) != hipSuccess) { grid = -1; return; }
        if (hipFuncSetAttribute((const void*)mega_fwd, hipFuncAttributeMaxDynamicSharedMemorySize, LDS_BYTES) != hipSuccess) { fprintf(stderr, "kernel_launch: hipFuncSetAttribute failed\n"); grid = -1; return; }
        if (hipOccupancyMaxActiveBlocksPerMultiprocessor(&per_cu, (const void*)mega_fwd, NWAVES * 64, LDS_BYTES) != hipSuccess || per_cu < 1) { fprintf(stderr, "kernel_launch: occupancy query says %d blocks per CU\n", per_cu); grid = -1; (void)hipGetLastError(); return; }
        grid = cus & ~7;
    }
    if (grid < 0) return;
    (void)hipMemsetAsync((char*)d_ws + WS_CTL, 0, CTL_ZERO_BYTES, stream);
    Args a{};
    for (int i = 0; i < 28; ++i) a.in[i] = (const float*)d_in[i];
    a.out = (float*)d_out; a.ws = (unsigned char*)d_ws; a.flags = 0; a.pad = 0;
#if HYB & 8
    for (int p = 0; p < N_PHASES; ++p) { a.ph_lo = p; a.ph_hi = p + 1; hipLaunchKernelGGL(mega_fwd, dim3(grid), dim3(NWAVES * 64), LDS_BYTES, stream, a); }
#else
    a.ph_lo = 0; a.ph_hi = N_PHASES; hipLaunchKernelGGL(mega_fwd, dim3(grid), dim3(NWAVES * 64), LDS_BYTES, stream, a);
#endif
}
```

```cpp
#include <hip/hip_runtime.h>
#include <cstdio>
#include <cstdint>
#define HYB 0
#define DBLMASK 0

namespace pg8 {
#define PG8_LAS __attribute__((address_space(3)))
typedef unsigned short bf16_t;
typedef short bf16x8 __attribute__((ext_vector_type(8)));
typedef float f32x4 __attribute__((ext_vector_type(4)));
typedef unsigned u32x4 __attribute__((ext_vector_type(4)));
constexpr int BM = 256, BK = 64, HALF = 128, HTB = HALF * BK * 2  , STAGE_BYTES = 8 * HTB, NXCD = 8, WGM = 4;

__host__ __device__ __forceinline__ int lds_byte(int r, int c) { const int st = (r >> 4) * 2 + (c >> 5), rr = r & 15, cc = c & 31, ob = rr * 64 + cc * 2; return st * 1024 + (ob ^ (((ob >> 9) & 1) << 5)); }
__host__ __device__ __forceinline__ void stage_rc(int b, int& R, int& C) { const int st = b / 1024, sb = b % 1024, swz = sb ^ (((sb >> 9) & 1) << 5); R = (st >> 1) * 16 + swz / 64; C = (st & 1) * 32 + (swz % 64) / 2; }
__host__ __device__ __forceinline__ int perm32(int rho) { const int n = rho >> 4, i = rho & 15; return 8 * (i >> 2) + 4 * n + (i & 3); }

struct Unit { int pm, pn; };
struct Gemm { const bf16_t* A; const bf16_t* Bt; int M, N, K; };

struct StaticOrder {
    int nM, nN, nwg, G, c;
    __host__ __device__ void init(int M, int N, int G_, int c_) { nM = M / BM; nN = N / BM; nwg = nM * nN; G = G_; c = c_; }
    __host__ __device__ bool next(int i, Unit& u) const {
        const long L = (long)i * G + c; if (L >= nwg) return false;
        int wgid = (int)L; { const int q = nwg / NXCD, r = nwg % NXCD, xcd = wgid % NXCD, off = wgid / NXCD; wgid = (xcd < r ? xcd * (q + 1) : r * (q + 1) + (xcd - r) * q) + off; }
        const int nig = WGM * nN, gid = wgid / nig, fm = gid * WGM, gsz = (nM - fm) < WGM ? (nM - fm) : WGM;
        u.pm = fm + ((wgid % nig) % gsz); u.pn = (wgid % nig) / gsz; return true;
    }
    __device__ __forceinline__ void a_ready(const Unit&) const {}
    __device__ __forceinline__ void done(const Unit&) const {}
};

__device__ __forceinline__ unsigned cvt_pk_bf16(float lo, float hi) { unsigned r; asm volatile("v_cvt_pk_bf16_f32 %0, %1, %2" : "=v"(r) : "v"(lo), "v"(hi)); return r; }
typedef float f32x2 __attribute__((ext_vector_type(2)));
typedef unsigned u32x2 __attribute__((ext_vector_type(2)));
constexpr int ROWS_P = 16384;
constexpr int MODSTRIDE = 12288;
__device__ __forceinline__ int batch_of_row(int row) { return row < ROWS_P ? (row >> 13) : 2 + ((row - ROWS_P) >> 12); }

struct EpiStoreBf16 {
    static constexpr bool PERM = true, PERMA = false, AFTER_DRAIN = false, HAS_MID = false;
    bf16_t* O; int ldc;
    __device__ __forceinline__ void operator()(const f32x4 (&acc)[2][2][4][2], const Unit& u, int wr, int wc, int fr_, int fq_) const {
        int fr = fr_, fq = fq_; asm volatile("" : "+v"(fr), "+v"(fq));
        const int row0 = u.pm * BM + wr * 64 + fr, col0 = u.pn * BM + wc * 32 + 8 * fq;
#pragma unroll
        for (int ai = 0; ai < 2; ++ai)
#pragma unroll
            for (int m = 0; m < 4; ++m) { bf16_t* rowp = O + (size_t)(row0 + ai * HALF + m * 16) * ldc + col0;
#pragma unroll
                for (int bj = 0; bj < 2; ++bj) { const f32x4 v0 = acc[ai][bj][m][0], v1 = acc[ai][bj][m][1];
                    u32x4 w; w.x = cvt_pk_bf16(v0[0], v0[1]); w.y = cvt_pk_bf16(v0[2], v0[3]); w.z = cvt_pk_bf16(v1[0], v1[1]); w.w = cvt_pk_bf16(v1[2], v1[3]);
                    *(u32x4*)(rowp + bj * HALF) = w; } }
    }
};
struct EpiResid {
    static constexpr bool PERM = false, PERMA = false, AFTER_DRAIN = false, HAS_MID = false;
    const float* base_p; const float* base_s; float* out; const float* gate; int row_off;
    __device__ __forceinline__ void operator()(const f32x4 (&acc)[2][2][4][2], const Unit& u, int wr, int wc, int fr_, int fq_) const {
        int fr = fr_, fq = fq_; asm volatile("" : "+v"(fr), "+v"(fq));
        const int grow0 = row_off + u.pm * BM; const int b = batch_of_row(grow0);
        const float* g = gate + (size_t)b * MODSTRIDE;
        const float* bt = grow0 < ROWS_P ? base_p + (size_t)grow0 * 2048 : base_s + (size_t)(grow0 - ROWS_P) * 2048;
        float* ot = out + (size_t)grow0 * 2048;
        const int col0 = u.pn * BM + wc * 32 + 4 * fq;
        f32x4 gv[2][2];
#pragma unroll
        for (int bj = 0; bj < 2; ++bj)
#pragma unroll
            for (int n = 0; n < 2; ++n) gv[bj][n] = *(const f32x4*)(g + col0 + bj * HALF + n * 16);
#pragma unroll
        for (int ai = 0; ai < 2; ++ai)
#pragma unroll
            for (int m = 0; m < 4; ++m) { const size_t off = (size_t)(wr * 64 + fr + ai * HALF + m * 16) * 2048 + col0;
#pragma unroll
                for (int bj = 0; bj < 2; ++bj)
#pragma unroll
                    for (int n = 0; n < 2; ++n) { const f32x4 bs = *(const f32x4*)(bt + off + bj * HALF + n * 16);
                        *(f32x4*)(ot + off + bj * HALF + n * 16) = bs + gv[bj][n] * acc[ai][bj][m][n]; }
                asm volatile("" ::: "memory"); }
    }
};
struct EpiStoreBf16N {
    static constexpr bool PERM = true, PERMA = false, AFTER_DRAIN = false, HAS_MID = false;
    bf16_t* O; int ldc; const float* rstd; const float* bias;
    __device__ __forceinline__ void operator()(const f32x4 (&acc)[2][2][4][2], const Unit& u, int wr, int wc, int fr_, int fq_) const {
        int fr = fr_, fq = fq_; asm volatile("" : "+v"(fr), "+v"(fq));
        const int row0 = u.pm * BM + wr * 64 + fr, col0 = u.pn * BM + wc * 32 + 8 * fq;
        const float* bp = bias + (size_t)batch_of_row(u.pm * BM) * ldc + col0;
        f32x4 bv[2][2];
#pragma unroll
        for (int bj = 0; bj < 2; ++bj)
#pragma unroll
            for (int n = 0; n < 2; ++n) bv[bj][n] = *(const f32x4*)(bp + bj * HALF + 4 * n);
#pragma unroll
        for (int ai = 0; ai < 2; ++ai)
#pragma unroll
            for (int m = 0; m < 4; ++m) { const int r = row0 + ai * HALF + m * 16; const float rs = rstd[r]; bf16_t* rowp = O + (size_t)r * ldc + col0;
#pragma unroll
                for (int bj = 0; bj < 2; ++bj) { const f32x4 v0 = acc[ai][bj][m][0] * rs + bv[bj][0], v1 = acc[ai][bj][m][1] * rs + bv[bj][1];
                    u32x4 w; w.x = cvt_pk_bf16(v0[0], v0[1]); w.y = cvt_pk_bf16(v0[2], v0[3]); w.z = cvt_pk_bf16(v1[0], v1[1]); w.w = cvt_pk_bf16(v1[2], v1[3]);
                    *(u32x4*)(rowp + bj * HALF) = w; } }
    }
};
template <bool MID> struct EpiResid2 {
    static constexpr bool PERM = true, PERMA = false, AFTER_DRAIN = false, HAS_MID = MID;
    _Float16* XR; float* out32; const float* gate; const float* gm; bf16_t* XG; float* SSQ; const float* ratio; const float* s2;
    __device__ __forceinline__ void mid(f32x4 (&acc)[2][2][4][2], const Unit& u, int wr, int fr) const {
        unsigned z_ = 0u; asm volatile("" : "+v"(z_)); const int fq = (int)__builtin_amdgcn_mbcnt_hi(~0u, __builtin_amdgcn_mbcnt_lo(~0u, z_)) >> 4, base = u.pm * BM + wr * 64 + fr + (fq >> 1) * HALF + (fq & 1) * 32;
        const float v0 = ratio[base], v1 = ratio[base + 16];
#pragma unroll
        for (int ai = 0; ai < 2; ++ai)
#pragma unroll
            for (int m = 0; m < 4; ++m) { const float r = __shfl((m & 1) ? v1 : v0, fr + 16 * (ai * 2 + (m >> 1)));
#pragma unroll
                for (int bj = 0; bj < 2; ++bj)
#pragma unroll
                    for (int n = 0; n < 2; ++n) acc[ai][bj][m][n] = acc[ai][bj][m][n] * r; }
    }
    __device__ __forceinline__ void operator()(const f32x4 (&acc)[2][2][4][2], const Unit& u, int wr, int wc, int fr_, int fq_) const {
        int fr = fr_, fq = fq_; asm volatile("" : "+v"(fr), "+v"(fq));
        typedef __attribute__((address_space(1))) const f32x4 gcf4; typedef __attribute__((address_space(1))) f32x4 gf4; typedef __attribute__((address_space(1))) u32x4 gu4; typedef _Float16 h16x8 __attribute__((ext_vector_type(8))); typedef __attribute__((address_space(1))) h16x8 gh8; typedef __attribute__((address_space(1))) const h16x8 gch8; typedef __attribute__((address_space(1))) float gf1;
        const int grow0 = u.pm * BM; const int b = batch_of_row(grow0);
        const float* g = gate + (size_t)b * MODSTRIDE;
        const size_t t0 = (size_t)grow0 * 2048;
        const int col0 = u.pn * BM + wc * 32 + 8 * fq;
        float ss[2][4], rs[2][4];
#pragma unroll
        for (int ai = 0; ai < 2; ++ai)
#pragma unroll
            for (int m = 0; m < 4; ++m) { ss[ai][m] = 0.f; rs[ai][m] = MID ? s2[grow0 + wr * 64 + fr + ai * HALF + m * 16] : 1.0f; }
#pragma unroll
        for (int bj = 0; bj < 2; ++bj) { const int co = col0 + bj * HALF;
            const f32x4 gv0 = *(gcf4*)(g + co), gv1 = *(gcf4*)(g + co + 4); f32x4 gm0 = (f32x4){0.f, 0.f, 0.f, 0.f}, gm1 = gm0; if (gm) { gm0 = *(gcf4*)(gm + (size_t)b * MODSTRIDE + co); gm1 = *(gcf4*)(gm + (size_t)b * MODSTRIDE + co + 4); }
#pragma unroll
            for (int ai = 0; ai < 2; ++ai) { h16x8 raw[4];
#pragma unroll
                for (int m = 0; m < 4; ++m) raw[m] = *(gch8*)(XR + t0 + (size_t)(wr * 64 + fr + ai * HALF + m * 16) * 2048 + co);
#pragma unroll
                for (int m = 0; m < 4; ++m) { const size_t off = t0 + (size_t)(wr * 64 + fr + ai * HALF + m * 16) * 2048 + co;
                    const f32x4 b0 = (f32x4){(float)raw[m][0], (float)raw[m][1], (float)raw[m][2], (float)raw[m][3]}, b1 = (f32x4){(float)raw[m][4], (float)raw[m][5], (float)raw[m][6], (float)raw[m][7]};
                    const f32x4 o0 = b0 + gv0 * (acc[ai][bj][m][0] * rs[ai][m]), o1 = b1 + gv1 * (acc[ai][bj][m][1] * rs[ai][m]);
                    if (out32) { *(gf4*)(out32 + off) = o0; *(gf4*)(out32 + off + 4) = o1; }
                    else { h16x8 w; w[0] = (_Float16)o0[0]; w[1] = (_Float16)o0[1]; w[2] = (_Float16)o0[2]; w[3] = (_Float16)o0[3]; w[4] = (_Float16)o1[0]; w[5] = (_Float16)o1[1]; w[6] = (_Float16)o1[2]; w[7] = (_Float16)o1[3]; *(gh8*)(XR + off) = w; }
                    if (gm) { const f32x4 x0 = o0 * gm0, x1 = o1 * gm1; ss[ai][m] += ((o0[0] * o0[0] + o0[1] * o0[1]) + (o0[2] * o0[2] + o0[3] * o0[3])) + ((o1[0] * o1[0] + o1[1] * o1[1]) + (o1[2] * o1[2] + o1[3] * o1[3]));
                        u32x4 w; w.x = cvt_pk_bf16(x0[0], x0[1]); w.y = cvt_pk_bf16(x0[2], x0[3]); w.z = cvt_pk_bf16(x1[0], x1[1]); w.w = cvt_pk_bf16(x1[2], x1[3]); *(gu4*)(XG + off) = w; } }
                asm volatile("" ::: "memory"); } }
        if (gm) {
#pragma unroll
            for (int ai = 0; ai < 2; ++ai)
#pragma unroll
                for (int m = 0; m < 4; ++m) { float s = ss[ai][m]; s += __shfl_xor(s, 16); s += __shfl_xor(s, 32); if (fq == 0) *(gf1*)(SSQ + (size_t)(grow0 + wr * 64 + fr + ai * HALF + m * 16) * 32 + u.pn * 4 + wc) = s; } }
    }
};
constexpr int GLU_BLOCKS = 802, GLU_TILES = 201;
struct GluMap {
    static constexpr bool UNIFORM = false;
    static __device__ __forceinline__ void block(int gb, int& base, int& t0, int& S) {
        if (gb < 266) { const int s = gb >= 133 ? 1 : 0; const int j = gb - 133 * s; base = s * 8192; t0 = 62 * j - 1; S = 8192; }
        else if (gb < GLU_BLOCKS) { const int g2 = gb - 266; const int s = g2 / 67, j = g2 - 67 * s; base = ROWS_P + s * 4096; t0 = 62 * j - 1; S = 4096; }
        else { base = 0; t0 = 0; S = 0; }
    }
    __device__ __forceinline__ unsigned rowq(int pm, int q, int r) const { int base, t0, S; block(4 * pm + q, base, t0, S); int t = t0 + r; t = t >= S ? S - 1 : t; t = t < 0 ? 0 : t; return (unsigned)(base + t); }
    __device__ __forceinline__ unsigned row(int pm, int R) const { int base, t0, S; block(4 * pm + (R >> 6), base, t0, S); int t = t0 + (R & 63); t = t >= S ? S - 1 : t; t = t < 0 ? 0 : t; return (unsigned)(base + t); }
};
template <int CTRL> __device__ __forceinline__ float dppf(float x) { return __builtin_bit_cast(float, __builtin_amdgcn_update_dpp(0, __builtin_bit_cast(int, x), CTRL, 0xf, 0xf, false)); }
template <int CTRL> __device__ __forceinline__ float dpp_any(float x) { return __builtin_bit_cast(float, __builtin_amdgcn_mov_dpp(__builtin_bit_cast(int, x), CTRL, 0xf, 0xf, false)); }
template <int CTRL> __device__ __forceinline__ float dpp_keep(float old, float x) { return __builtin_bit_cast(float, __builtin_amdgcn_update_dpp(__builtin_bit_cast(int, old), __builtin_bit_cast(int, x), CTRL, 0xf, 0xf, false)); }
struct GeluK { float c0, c1, one;
    __device__ __forceinline__ GeluK() { c0 = -2.302208198f * 0.044715f; c1 = -2.302208198f; one = 1.0f; asm volatile("" : "+v"(c0), "+v"(c1), "+v"(one)); } };
__device__ __forceinline__ f32x4 gelu_tanh_4(f32x4 x, const GeluK& k) {
    const f32x4 p = (x * x) * k.c0 + k.c1; const f32x4 a = x * p; f32x4 e;
#pragma unroll
    for (int i = 0; i < 4; ++i) e[i] = __builtin_amdgcn_exp2f(a[i]);
    const f32x4 d = e + k.one; f32x4 r;
#pragma unroll
    for (int i = 0; i < 4; ++i) r[i] = __builtin_amdgcn_rcpf(d[i]);
    return x * r;
}
__device__ __forceinline__ float gelu_tanh_f(float x) {
    const float u = x * (1.0f + 0.044715f * x * x); const float e = __builtin_amdgcn_exp2f(-2.302208198f * u);
    return x * __builtin_amdgcn_rcpf(1.0f + e);
}
struct EpiGLU {
    static constexpr bool PERM = true, PERMA = false, AFTER_DRAIN = false, HAS_MID = false;
    bf16_t* act; const float* cw; const float* cb;
    const float* rstd; const float* bias;
    __device__ __forceinline__ void operator()(const f32x4 (&acc)[2][2][4][2], const Unit& u, int wr, int wc, int fr_, int fq_) const {
        int fr = fr_, fq = fq_; asm volatile("" : "+v"(fr), "+v"(fq));
        const int c0 = u.pn * HALF + wc * 32 + 8 * fq;
        f32x4 w0[2], w1[2], w2[2], bb[2];
#pragma unroll
        for (int n = 0; n < 2; ++n) { w0[n] = *(const f32x4*)(cw + c0 + 4 * n); w1[n] = *(const f32x4*)(cw + 6144 + c0 + 4 * n); w2[n] = *(const f32x4*)(cw + 2 * 6144 + c0 + 4 * n); bb[n] = *(const f32x4*)(cb + c0 + 4 * n); }
#pragma unroll
        for (int ai = 0; ai < 2; ++ai) {
            int base, t0, S; GluMap::block(4 * u.pm + 2 * ai + wr, base, t0, S);
            f32x4 gt[4][2], bg[2], bu[2]; float rs[4];
            { const float* bp = bias + (size_t)batch_of_row(base) * 12288 + u.pn * BM + wc * 32 + 8 * fq;
#pragma unroll
              for (int n = 0; n < 2; ++n) { bg[n] = *(const f32x4*)(bp + 4 * n); bu[n] = *(const f32x4*)(bp + HALF + 4 * n); } }
#pragma unroll
            for (int m = 0; m < 4; ++m) { const int tok = t0 + 16 * m + fr; const bool in = tok >= 0 && tok < S; int tc = tok >= S ? S - 1 : tok; tc = tc < 0 ? 0 : tc; rs[m] = rstd[base + tc];
#pragma unroll
                for (int n = 0; n < 2; ++n) gt[m][n] = in ? acc[ai][0][m][n] * rs[m] + bg[n] : (f32x4){0.f, 0.f, 0.f, 0.f}; }
#pragma unroll
            for (int m = 0; m < 4; ++m) { const int i = 16 * m + fr, tok = t0 + i; u32x4 w;
                unsigned pk[4];
#pragma unroll
                for (int n = 0; n < 2; ++n) { f32x4 pv, nx;
#pragma unroll
                    for (int e = 0; e < 4; ++e) {
                        const float rcur = dppf<0x121>(gt[m][n][e]), rprv = dppf<0x121>(gt[m > 0 ? m - 1 : 0][n][e]);
                        const float lcur = dppf<0x12F>(gt[m][n][e]), lnxt = dppf<0x12F>(gt[m < 3 ? m + 1 : 3][n][e]);
                        pv[e] = fr == 0 ? rprv : rcur; nx[e] = fr == 15 ? lnxt : lcur; }
                    const f32x4 g = w0[n] * pv + w1[n] * gt[m][n] + w2[n] * nx + bb[n];
                    const f32x4 up = acc[ai][1][m][n] * rs[m] + bu[n];
                    const float a0 = gelu_tanh_f(g[0]) * up[0], a1 = gelu_tanh_f(g[1]) * up[1], a2 = gelu_tanh_f(g[2]) * up[2], a3 = gelu_tanh_f(g[3]) * up[3];
                    pk[2 * n] = cvt_pk_bf16(a0, a1); pk[2 * n + 1] = cvt_pk_bf16(a2, a3); }
                w.x = pk[0]; w.y = pk[1]; w.z = pk[2]; w.w = pk[3];
                if (i >= 1 && i <= 62 && tok < S) *(u32x4*)(act + (size_t)(base + tok) * 6144 + c0) = w; }
        }
    }
};

struct EpiGLU2 {
    static constexpr bool PERM = true, PERMA = true, AFTER_DRAIN = false, HAS_MID = false;
    bf16_t* act; const float* cw; const float* cb; const float* rstd; const float* bias; float* halo; PG8_LAS float* xch;
    __device__ __forceinline__ void operator()(const f32x4 (&acc)[2][2][4][2], const Unit& u, int wr, int wc, int fr_, int fq_) const {
        int fr = fr_, fq = fq_; asm volatile("" : "+v"(fr), "+v"(fq));
        const int lc = wc * 32 + 8 * fq, c0 = u.pn * HALF + lc;
        f32x4 w0[2], w1[2], w2[2], bb[2], bg[2], bu[2];
        { const float* bp = bias + (size_t)batch_of_row(u.pm * BM) * 12288 + u.pn * BM + lc;
#pragma unroll
          for (int n = 0; n < 2; ++n) { w0[n] = *(const f32x4*)(cw + c0 + 4 * n); w1[n] = *(const f32x4*)(cw + 6144 + c0 + 4 * n); w2[n] = *(const f32x4*)(cw + 2 * 6144 + c0 + 4 * n); bb[n] = *(const f32x4*)(cb + c0 + 4 * n);
              bg[n] = *(const f32x4*)(bp + 4 * n); bu[n] = *(const f32x4*)(bp + HALF + 4 * n); } }
        const GeluK GK;
        f32x4 gt[2][4][2]; float rs[2][4];
#pragma unroll
        for (int ai = 0; ai < 2; ++ai)
#pragma unroll
            for (int m = 0; m < 4; ++m) { rs[ai][m] = rstd[u.pm * BM + ai * HALF + wr * 64 + 4 * fr + m];
#pragma unroll
                for (int n = 0; n < 2; ++n) gt[ai][m][n] = acc[ai][0][m][n] * rs[ai][m] + bg[n]; }
#pragma unroll
        for (int ai = 0; ai < 2; ++ai) { const int blk = 2 * ai + wr;
#pragma unroll
            for (int n = 0; n < 2; ++n) { if (fr == 0) *(PG8_LAS f32x4*)(xch + (blk * 2 + 0) * HALF + lc + 4 * n) = gt[ai][0][n]; if (fr == 15) *(PG8_LAS f32x4*)(xch + (blk * 2 + 1) * HALF + lc + 4 * n) = gt[ai][3][n]; } }
        asm volatile("s_waitcnt lgkmcnt(0)" ::: "memory"); __builtin_amdgcn_s_barrier(); asm volatile("" ::: "memory");
#pragma unroll
        for (int ai = 0; ai < 2; ++ai) { const int blk = 2 * ai + wr; f32x4 pvb[2], nxb[2];
#pragma unroll
            for (int n = 0; n < 2; ++n) { pvb[n] = *(const PG8_LAS f32x4*)(xch + ((blk > 0 ? blk - 1 : 0) * 2 + 1) * HALF + lc + 4 * n); nxb[n] = *(const PG8_LAS f32x4*)(xch + ((blk < 3 ? blk + 1 : 3) * 2 + 0) * HALF + lc + 4 * n); }
#pragma unroll
            for (int m = 0; m < 4; ++m) { const int i = 4 * fr + m; u32x4 w; unsigned pk[4]; f32x4 upv[2];
#pragma unroll
                for (int n = 0; n < 2; ++n) { f32x4 pv, nx;
#pragma unroll
                    for (int e = 0; e < 4; ++e) {
                        pv[e] = m > 0 ? gt[ai][m > 0 ? m - 1 : 0][n][e] : dpp_keep<0x111>(pvb[n][e], gt[ai][3][n][e]);
                        nx[e] = m < 3 ? gt[ai][m < 3 ? m + 1 : 3][n][e] : dpp_keep<0x101>(nxb[n][e], gt[ai][0][n][e]); }
                    const f32x4 g = w2[n] * nx + (w1[n] * gt[ai][m][n] + (w0[n] * pv + bb[n]));
                    upv[n] = acc[ai][1][m][n] * rs[ai][m] + bu[n];
                    const f32x4 av = gelu_tanh_4(g, GK) * upv[n];
                    pk[2 * n] = cvt_pk_bf16(av[0], av[1]); pk[2 * n + 1] = cvt_pk_bf16(av[2], av[3]); }
                w.x = pk[0]; w.y = pk[1]; w.z = pk[2]; w.w = pk[3];
                const int trow = 64 * blk + i;
                if (trow != 0 && trow != 255) __builtin_nontemporal_store(w, (u32x4*)(act + (size_t)(u.pm * BM + trow) * 6144 + c0));
                int slot = -1; if (trow == 0) slot = 0; else if (trow == 1) slot = 1; else if (trow == 254) slot = 2; else if (trow == 255) slot = 3;
                if (slot >= 0) { float* hp = halo + ((size_t)u.pm * 6 + slot) * 6144 + c0; *(f32x4*)hp = gt[ai][m][0]; *(f32x4*)(hp + 4) = gt[ai][m][1];
                    if (slot == 0 || slot == 3) { float* hu = halo + ((size_t)u.pm * 6 + (slot == 0 ? 4 : 5)) * 6144 + c0; *(f32x4*)hu = upv[0]; *(f32x4*)(hu + 4) = upv[1]; } } }
        }
    }
};
struct IdentMap { static constexpr bool UNIFORM = true; __device__ __forceinline__ unsigned row(int pm, int R) const { return (unsigned)(pm * BM + R); } __device__ __forceinline__ unsigned rowq(int pm, int q, int r) const { return (unsigned)(pm * BM + 64 * q + r); } };
template <class Epi, class Sched, class AMap>
__device__ __forceinline__ void gemm_phase(PG8_LAS unsigned char* lds, const Gemm g, const Sched& S, const Epi& E, const AMap& AM, int wave) {
    unsigned z_ = 0u; asm volatile("" : "+v"(z_)); const int ln_ = (int)__builtin_amdgcn_mbcnt_hi(~0u, __builtin_amdgcn_mbcnt_lo(~0u, z_)); const int tid_ = wave * 64 + ln_;
    const int tid = tid_, wid = wave, lane = ln_, wr = wid >> 2, wc = wid & 3, fr = lane & 15, fq = lane >> 4;
    const int K = g.K, nt = K / BK;
    int RA[2], CA[2]; unsigned voffB[2], voffA[2];
#pragma unroll
    for (int i = 0; i < 2; ++i) { int R, C; stage_rc(tid * 16 + i * 8192, R, C); const int Rb = Epi::PERM ? ((R & ~31) + perm32(R & 31)) : R; const int Ra = Epi::PERMA ? ((R & ~63) + 4 * (R & 15) + ((R & 63) >> 4)) : R; RA[i] = R; CA[i] = C; voffA[i] = (unsigned)(Ra * K + C) * 2u; voffB[i] = (unsigned)(Rb * K + C) * 2u; }
    const size_t kstep = (size_t)(BK * 2);
    const size_t qstep = (size_t)64 * K * 2;
    const size_t hstep = (size_t)HALF * K * 2;
    const size_t tstep = 2 * hstep;
    const unsigned ldsw = (unsigned)wid * 1024u;
    const int aoff = lds_byte(wr * 64 + fr, fq * 8), boff = lds_byte(wc * 32 + fr, fq * 8);
#define PG8_SA(b, h) (((b) * 2 + (h)) * HTB)
#define PG8_SB(b, h) ((4 + (b) * 2 + (h)) * HTB)
#define PG8_STAGE(bufoff, gbase, voff) do { _Pragma("unroll") for (int _i = 0; _i < 2; ++_i) \
        __builtin_amdgcn_global_load_lds((const unsigned*)((const char*)(gbase) + (size_t)_i * qstep + (voff)[0]), (PG8_LAS unsigned*)(lds + (bufoff) + ldsw + _i * 8192), 16, 0, 0); } while (0)
#define PG8_LDA(dst, b, h) do { _Pragma("unroll") for (int m = 0; m < 4; ++m) _Pragma("unroll") for (int k = 0; k < 2; ++k) dst[m][k] = *(const PG8_LAS bf16x8*)(lds + PG8_SA(b, h) + aoff + m * 2048 + k * 1024); } while (0)
#define PG8_LDB(dst, b, h) do { _Pragma("unroll") for (int n = 0; n < 2; ++n) _Pragma("unroll") for (int k = 0; k < 2; ++k) dst[n][k] = *(const PG8_LAS bf16x8*)(lds + PG8_SB(b, h) + boff + n * 2048 + k * 1024); } while (0)
#define PG8_MMA(ai, bj, At, Bt) do { __builtin_amdgcn_s_setprio(1); _Pragma("unroll") for (int m = 0; m < 4; ++m) _Pragma("unroll") for (int n = 0; n < 2; ++n) _Pragma("unroll") for (int k = 0; k < 2; ++k) \
        acc[ai][bj][m][n] = __builtin_amdgcn_mfma_f32_16x16x32_bf16(Bt[n][k], At[m][k], acc[ai][bj][m][n], 0, 0, 0); __builtin_amdgcn_s_setprio(0); } while (0)
#define PG8_WAIT_V(n) asm volatile("s_waitcnt vmcnt(" #n ")" ::: "memory")
#define PG8_WAIT_L(n) asm volatile("s_waitcnt lgkmcnt(" #n ")" ::: "memory")
#define PG8_BAR __builtin_amdgcn_s_barrier()
#define PG8_SCHED __builtin_amdgcn_sched_barrier(0)
#define PG8_STAGE_A(bufoff, kb, h, NX) do { if constexpr (AMap::UNIFORM) { const char* _b = ((NX) ? nA : cA) + (kb) + (h) * hstep; PG8_STAGE(bufoff, _b, voffA); } \
        else { unsigned _o[2]; _o[0] = (NX) ? offN[h][0] : offC[h][0]; _o[1] = (NX) ? offN[h][1] : offC[h][1]; PG8_STAGE(bufoff, Ab + (kb), _o); } } while (0)
#define PG8_OFFS(dst, pm) do { _Pragma("unroll") for (int _h = 0; _h < 2; ++_h) _Pragma("unroll") for (int _i = 0; _i < 2; ++_i) dst[_h][_i] = (AM.rowq((pm), 2 * _h + _i, RA[_i] & 63) * (unsigned)K + (unsigned)CA[_i]) * 2u; } while (0)
    Unit cur, nxt; int ui = 0;
    if (!S.next(0, cur)) return;
    f32x4 acc[2][2][4][2];
#pragma unroll
    for (int a = 0; a < 2; ++a)
#pragma unroll
        for (int b = 0; b < 2; ++b)
#pragma unroll
            for (int m = 0; m < 4; ++m)
#pragma unroll
                for (int n = 0; n < 2; ++n) acc[a][b][m][n] = (f32x4){0.f, 0.f, 0.f, 0.f};
    bf16x8 At[4][2], B0[2][2], B1[2][2];
    unsigned offC[2][2], offN[2][2];
    if constexpr (!AMap::UNIFORM) { PG8_OFFS(offC, cur.pm); }
    const char* const Ab = (const char*)g.A;
    const char* cA = (const char*)g.A + (size_t)cur.pm * tstep; const char* nA = cA;
    const char* cB = (const char*)g.Bt + (size_t)cur.pn * tstep;
    S.a_ready(cur);
    PG8_STAGE(PG8_SB(0, 0), cB, voffB); PG8_STAGE(PG8_SB(0, 1), cB + hstep, voffB); PG8_STAGE_A(PG8_SA(0, 0), 0, 0, false); PG8_STAGE_A(PG8_SA(0, 1), 0, 1, false);
    if (wr == 1) PG8_BAR;
    PG8_WAIT_V(2); PG8_BAR;
    PG8_STAGE(PG8_SB(1, 0), cB + kstep, voffB); PG8_STAGE_A(PG8_SA(1, 0), kstep, 0, false); PG8_STAGE(PG8_SB(1, 1), cB + hstep + kstep, voffB);
    PG8_WAIT_V(6); PG8_BAR;
    for (;;) {
        const bool has_next = S.next(ui + 1, nxt);
        const char* nB = has_next ? (const char*)g.Bt + (size_t)nxt.pn * tstep : cB;
        if constexpr (AMap::UNIFORM) { nA = has_next ? (const char*)g.A + (size_t)nxt.pm * tstep : cA; }
        else { if (has_next) { PG8_OFFS(offN, nxt.pm); } else {
#pragma unroll
            for (int _h = 0; _h < 2; ++_h)
#pragma unroll
                for (int _i = 0; _i < 2; ++_i) offN[_h][_i] = offC[_h][_i]; } }
        for (int t = 0; t < nt; t += 2) {
            const bool last = (t == nt - 2);
            const size_t k1 = (size_t)(t + 1) * kstep, k2 = last ? (size_t)0 : (size_t)(t + 2) * kstep, k3 = k2 + kstep;
            const char* b2 = last ? nB : cB + (size_t)(t + 2) * kstep; const char* b3 = b2 + kstep;
            if (last && has_next) S.a_ready(nxt);
            if constexpr (Epi::HAS_MID) { if (t == nt / 2) E.mid(acc, cur, wr, fr); }
            PG8_LDB(B0, 0, 0); PG8_LDB(B1, 0, 1); PG8_SCHED; PG8_LDA(At, 0, 0); PG8_STAGE_A(PG8_SA(1, 1), k1, 1, false);
            PG8_WAIT_V(8); PG8_WAIT_L(0); PG8_BAR; PG8_MMA(0, 0, At, B0); PG8_MMA(0, 1, At, B1); PG8_BAR; PG8_SCHED;
            PG8_LDA(At, 0, 1); PG8_STAGE(PG8_SB(0, 0), b2, voffB); PG8_STAGE(PG8_SB(0, 1), b2 + hstep, voffB); PG8_STAGE_A(PG8_SA(0, 0), k2, 0, last);
            PG8_WAIT_V(8); PG8_WAIT_L(0); PG8_BAR; PG8_MMA(1, 0, At, B0); PG8_MMA(1, 1, At, B1); PG8_BAR; PG8_SCHED;
            PG8_LDB(B0, 1, 0); PG8_LDB(B1, 1, 1); PG8_SCHED; PG8_LDA(At, 1, 0); PG8_STAGE_A(PG8_SA(0, 1), k2, 1, last);
            PG8_WAIT_V(8); PG8_WAIT_L(0); PG8_BAR; PG8_MMA(0, 0, At, B0); PG8_MMA(0, 1, At, B1); PG8_BAR; PG8_SCHED;
            PG8_LDA(At, 1, 1); PG8_STAGE(PG8_SB(1, 0), b3, voffB); PG8_STAGE(PG8_SB(1, 1), b3 + hstep, voffB); PG8_STAGE_A(PG8_SA(1, 0), k3, 0, last);
            PG8_WAIT_V(8); PG8_WAIT_L(0); PG8_BAR; PG8_MMA(1, 0, At, B0); PG8_MMA(1, 1, At, B1); PG8_BAR; PG8_SCHED;
        }
        if (wr == 0) PG8_BAR;
        E(acc, cur, wr, wc, fr, fq); S.done(cur);
        if (!has_next) break;
#pragma unroll
        for (int a = 0; a < 2; ++a)
#pragma unroll
            for (int b = 0; b < 2; ++b)
#pragma unroll
                for (int m = 0; m < 4; ++m)
#pragma unroll
                    for (int n = 0; n < 2; ++n) acc[a][b][m][n] = (f32x4){0.f, 0.f, 0.f, 0.f};
        cur = nxt; cB = nB; cA = nA; ++ui;
        if constexpr (!AMap::UNIFORM) {
#pragma unroll
        for (int _h = 0; _h < 2; ++_h)
#pragma unroll
            for (int _i = 0; _i < 2; ++_i) offC[_h][_i] = offN[_h][_i]; }
        if (wr == 1) PG8_BAR;
    }
    PG8_WAIT_V(0);
    PG8_BAR;
#undef PG8_SA
#undef PG8_SB
#undef PG8_STAGE
#undef PG8_LDA
#undef PG8_LDB
#undef PG8_MMA
#undef PG8_WAIT_V
#undef PG8_WAIT_L
#undef PG8_BAR
#undef PG8_SCHED
#undef PG8_OFFS
#undef PG8_STAGE_A
}
}

#define LAS __attribute__((address_space(3)))
typedef unsigned short bf16_t;
typedef float f32x4 __attribute__((ext_vector_type(4)));
typedef float f32x2 __attribute__((ext_vector_type(2)));
typedef unsigned u32x4 __attribute__((ext_vector_type(4)));
typedef unsigned u32x2 __attribute__((ext_vector_type(2)));
typedef short bf16x8 __attribute__((ext_vector_type(8)));
typedef short s16x4 __attribute__((ext_vector_type(4)));
constexpr int D = 2048, T = 49152, ROWS_P = 16384, NB = 10, DEPTH = 4;
constexpr int ZC = 3584, ZQ = 0, ZK = 1024, ZV = 1280, ZX = 1536, ZY = 2560;
constexpr int DFF = 6144, MODSTRIDE = 12288;
constexpr float EPS = 1e-6f;
constexpr size_t MiB = 1u << 20;
constexpr size_t WS_CTL = 0, CTL_ZERO_BYTES = 64 * 1024, WS_MOD = 1 * MiB, WS_SUM = 3 * MiB  , WS_CAR = 9 * MiB  , WS_LW = 12 * MiB  ,
                 WS_WIN = 16 * MiB, WS_WOUT = 72 * MiB, WS_WGU = 104 * MiB, WS_WDN = 296 * MiB, WS_H = 392 * MiB, WS_Z = 584 * MiB,
                 WS_ATT = 920 * MiB, WS_LRU = 1016 * MiB, WS_AB = 1112 * MiB, WS_LC = 1112 * MiB  ,
                 WS_SSQX = 1496 * MiB  , WS_SSQA = 1502 * MiB  , WS_SSQL = 1503 * MiB + 512 * 1024, WS_RSTD = 1505 * MiB, WS_RATIO = 1505 * MiB + 256 * 1024, WS_S2 = 1505 * MiB + 512 * 1024,
                 WS_BIN = 1506 * MiB  , WS_BGU = 1507 * MiB  , WS_END = 1510 * MiB;
constexpr size_t WS_XR = 1160 * MiB;
constexpr size_t WS_HALO = 1352 * MiB;
constexpr size_t WS_MRG = WS_ATT;
constexpr size_t WS_LSP = 3 * MiB - 65536;
constexpr size_t WS_ACT = WS_Z;
constexpr size_t WS_GUC = WS_Z, WS_ACTC = WS_Z + 192 * MiB;
static_assert(WS_ACT + (size_t)T * DFF * 2 <= WS_XR && WS_XR + (size_t)T * D * 2 <= WS_HALO && WS_HALO + (size_t)192 * 6 * DFF * 4 <= WS_SSQX, "act overlay / residual stream / halo");
constexpr int LDS_BYTES = 147456, LDS_CTL = LDS_BYTES - 256;
constexpr int NWAVES = 8;
constexpr int CW_BAR = 1024;

__device__ __forceinline__ void rowinfo(int row, int& b, int& t, int& S) { if (row < ROWS_P) { b = row >> 13; t = row & 8191; S = 8192; } else { const int r = row - ROWS_P; b = 2 + (r >> 12); t = r & 4095; S = 4096; } }
__device__ __forceinline__ float bf2f(unsigned short u) { return __uint_as_float(((unsigned)u) << 16); }
__device__ __forceinline__ float bflo(unsigned w) { return __uint_as_float(w << 16); }
__device__ __forceinline__ float bfhi(unsigned w) { return __uint_as_float(w & 0xffff0000u); }
__device__ __forceinline__ unsigned f2bf(float f) { unsigned u = __float_as_uint(f); return (u + 0x7fffu + ((u >> 16) & 1u)) >> 16; }
__device__ __forceinline__ unsigned pk2(float lo, float hi) { return f2bf(lo) | (f2bf(hi) << 16); }
__device__ __forceinline__ float wave_sum(float v) {
#pragma unroll
    for (int o = 1; o < 64; o <<= 1) v += __shfl_xor(v, o);
    return v; }
__device__ __forceinline__ float wave_max(float v) {
#pragma unroll
    for (int o = 1; o < 64; o <<= 1) v = fmaxf(v, __shfl_xor(v, o));
    return v; }
__device__ __forceinline__ float gelu_tanh(float x) { const float u = 0.7978845608028654f * (x + 0.044715f * x * x * x); return x / (1.0f + __expf(-2.0f * u)); }
__device__ __forceinline__ float sigmoidf(float x) { return 1.0f / (1.0f + __expf(-x)); }
#define LDS_WAIT() asm volatile("s_waitcnt lgkmcnt(0)" ::: "memory")
#define VM_WAIT() asm volatile("s_waitcnt vmcnt(0)" ::: "memory")
#define WG_BAR() do { asm volatile("s_waitcnt vmcnt(0) lgkmcnt(0)" ::: "memory"); __builtin_amdgcn_s_barrier(); asm volatile("" ::: "memory"); } while (0)

__device__ __forceinline__ unsigned char* ws_now(unsigned char* p) { asm volatile("" : "+s"(p)); return p; }
__device__ __forceinline__ int lane_id() { unsigned z = 0u; asm volatile("" : "+v"(z)); return (int)__builtin_amdgcn_mbcnt_hi(~0u, __builtin_amdgcn_mbcnt_lo(~0u, z)); }
#define XB_TMO      128
#define XB_XCNT(j)  (256  + 64 * (j))
#define XB_XSUB(j)  (1280 + 64 * (j))
#define XB_XGEN(j)  (2304 + 64 * (j))
#define XB_TOP      3328
#define XB_TOPGEN   3392
#define XCD_BAR_WORDS 3456
#define XB_SPIN_CAP (1u << 18)

__device__ __forceinline__ unsigned xb_ld(unsigned* p)              { return __hip_atomic_load(p, __ATOMIC_RELAXED, __HIP_MEMORY_SCOPE_AGENT); }
__device__ __forceinline__ unsigned xb_add(unsigned* p, unsigned v) { return __hip_atomic_fetch_add(p, v, __ATOMIC_RELAXED, __HIP_MEMORY_SCOPE_AGENT); }
__device__ __forceinline__ unsigned xb_xcc_id() { return (unsigned)__builtin_amdgcn_s_getreg((3 << 11) | 20) & 0xFu; }
#define XB_SPIN(cond, bar) do { unsigned _sp = 0; while (cond) { __builtin_amdgcn_s_sleep(1); \
    if ((++_sp & 255u) == 0u) { if (xb_ld(&(bar)[XB_TMO])) break; if (_sp > XB_SPIN_CAP) { atomicAdd(&(bar)[XB_TMO], 1u); break; } } } } while (0)

struct XcdBarrier {
    unsigned* bar; unsigned x; int wv;
    volatile LAS unsigned* st;
};

__device__ __forceinline__ XcdBarrier xcd_barrier_post(unsigned* bar, volatile LAS unsigned* st, int wv) {
    XcdBarrier b; b.bar = bar; b.x = xb_xcc_id(); b.st = st; b.wv = wv;
    if (wv == 0 && lane_id() == 0) (void)xb_add(&bar[XB_XCNT(b.x)], 1u);
    return b;
}
__device__ __forceinline__ void xcd_barrier_complete(unsigned* bar, unsigned x, unsigned& nloc, unsigned& nx) {
    const unsigned G = gridDim.x * gridDim.y * gridDim.z;
    unsigned sum, cnt, mine, sp = 0u;
    for (;;) {
        sum = 0u; cnt = 0u; mine = 0u;
#pragma unroll
        for (unsigned j = 0; j < 16; ++j) { const unsigned c = xb_ld(&bar[XB_XCNT(j)]); sum += c; cnt += (c > 0u) ? 1u : 0u; mine = (j == x) ? c : mine; }
        if (sum == G) break;
        __builtin_amdgcn_s_sleep(1);
        if ((++sp & 255u) == 0u) { if (xb_ld(&bar[XB_TMO])) break; if (sp > XB_SPIN_CAP) { atomicAdd(&bar[XB_TMO], 1u); break; } }
    }
    nloc = mine > 0u ? mine : 1u; nx = cnt > 0u ? cnt : 1u;
}

__device__ __forceinline__ void xcd_barrier(const XcdBarrier& b) {
    asm volatile("s_waitcnt vmcnt(0)" ::: "memory");
    __syncthreads();
    if (b.wv == 0 && lane_id() == 0) {
        unsigned* bar = b.bar; asm volatile("" : "+s"(bar));
        __builtin_amdgcn_s_waitcnt(0);
        unsigned nloc = b.st[0], nx = b.st[1];
        if (nloc == 0u) { xcd_barrier_complete(bar, b.x, nloc, nx); b.st[0] = nloc; b.st[1] = nx; }
        const unsigned old = xb_add(&bar[XB_XSUB(b.x)], 1u);
        const unsigned gen = old / nloc;
        if (old + 1u == (gen + 1u) * nloc) {
            __builtin_amdgcn_fence(__ATOMIC_RELEASE, "agent");
            asm volatile("s_waitcnt vmcnt(0)" ::: "memory");
            const unsigned og = xb_add(&bar[XB_TOP], 1u);
            const unsigned tg = og / nx;
            if (og + 1u == (tg + 1u) * nx) xb_add(&bar[XB_TOPGEN], 1u);
            else XB_SPIN(xb_ld(&bar[XB_TOPGEN]) == tg, bar);
            __builtin_amdgcn_fence(__ATOMIC_ACQUIRE, "agent");
            xb_add(&bar[XB_XGEN(b.x)], 1u);
            asm volatile("s_waitcnt vmcnt(0)" ::: "memory");
        } else {
            XB_SPIN(xb_ld(&bar[XB_XGEN(b.x)]) == gen, bar);
            __builtin_amdgcn_fence(__ATOMIC_ACQUIRE, "agent");
            asm volatile("s_waitcnt vmcnt(0)" ::: "memory");
        }
    }
    __syncthreads();
}

struct Args { const float* in[28]; float* out; unsigned char* ws; int ph_lo, ph_hi, flags, pad; };
struct Frame {
    LAS unsigned char* lds; int tid, lane, wave, G, bid;
};
#define KAS __attribute__((address_space(4)))
__device__ __forceinline__ const KAS unsigned char* karg_base() { const KAS unsigned char* p = (const KAS unsigned char*)__builtin_amdgcn_kernarg_segment_ptr(); asm volatile("" : "+s"(p)); return p; }
__device__ __forceinline__ const float* karg_in(int k) { return *(const float* const KAS*)(karg_base() + 8 * k); }
__device__ __forceinline__ float* karg_out() { return *(float* const KAS*)(karg_base() + 8 * 28); }
__device__ __forceinline__ unsigned char* karg_ws() { return *(unsigned char* const KAS*)(karg_base() + 8 * 29); }
#define INP(k) (karg_in(k))
__device__ __forceinline__ Frame fresh(const Frame& F0) { Frame F = F0; int ln = lane_id(); asm volatile("" : "+v"(ln)); F.lane = ln; F.tid = F0.wave * 64 + ln; return F; }

__device__ __forceinline__ void p0_transpose_item(const float* W, int K, int N, bf16_t* WT, int mode, LAS float* scr, int item, int lane, const float* ks0 = nullptr, const float* ks1 = nullptr) {
    const int nblk = N / 64, kb = item / nblk, nb = item % nblk, k0 = 64 * kb, n0 = 64 * nb;
    const int drow0 = mode == 0 ? n0 : ((n0 >> 7) * 256 + (n0 & 127) + (mode == 2 ? 128 : 0));
    f32x4 v[16];
#pragma unroll
    for (int i = 0; i < 16; ++i) v[i] = *(const f32x4*)(W + (size_t)(k0 + 4 * i + (lane >> 4)) * N + n0 + 4 * (lane & 15));
#pragma unroll
    for (int i = 0; i < 16; ++i) { const int kk = 4 * i + (lane >> 4); float sc = 1.0f; if (ks0) sc = (k0 + kk < 1024 ? ks0[k0 + kk] : ks1[k0 + kk - 1024]);
        LAS float* d = scr + kk * 65 + 4 * (lane & 15); d[0] = v[i].x * sc; d[1] = v[i].y * sc; d[2] = v[i].z * sc; d[3] = v[i].w * sc; }
    LDS_WAIT(); asm volatile("" ::: "memory");
    const int c = lane & 7;
#pragma unroll
    for (int j = 0; j < 8; ++j) { const int n = (lane >> 3) + 8 * j; const LAS float* s = scr + (8 * c) * 65 + n;
        u32x4 o; o.x = pk2(s[0 * 65], s[1 * 65]); o.y = pk2(s[2 * 65], s[3 * 65]); o.z = pk2(s[4 * 65], s[5 * 65]); o.w = pk2(s[6 * 65], s[7 * 65]);
        *(u32x4*)(WT + (size_t)(drow0 + n) * K + k0 + 8 * c) = o; }
    LDS_WAIT(); asm volatile("" ::: "memory");
}
__device__ __forceinline__ void phase_prologue(const Frame& F0, const Args& a) { const Frame F = fresh(F0);
    unsigned char* ws = karg_ws();
    bf16_t* WIN = (bf16_t*)(ws + WS_WIN); bf16_t* WOUT = (bf16_t*)(ws + WS_WOUT); bf16_t* WGU = (bf16_t*)(ws + WS_WGU); bf16_t* WDN = (bf16_t*)(ws + WS_WDN);
    LAS float* scr = (LAS float*)(F.lds + F.wave * 16640);
    const int gw = F.bid * NWAVES + F.wave, NGW = F.G * NWAVES;
    constexpr int I_IN = (D / 64) * (ZC / 64), I_OUT = (D / 64) * (D / 64), I_G = (D / 64) * (DFF / 64), I_D = (DFF / 64) * (D / 64), I_L = I_IN + I_OUT + 2 * I_G + I_D;
    for (int it = gw; it < DEPTH * I_L; it += NGW) { const int l = it / I_L; int r = it - l * I_L;
        if (r < I_IN) { p0_transpose_item(INP(9) + (size_t)l * D * ZC, D, ZC, WIN + (size_t)l * ZC * D, 0, scr, r, F.lane); continue; } r -= I_IN;
        if (r < I_OUT) { p0_transpose_item(INP(22) + (size_t)l * D * D, D, D, WOUT + (size_t)l * D * D, 0, scr, r, F.lane, INP(20) + l * 1024, INP(21) + l * 1024); continue; } r -= I_OUT;
        if (r < I_G) { p0_transpose_item(INP(23) + (size_t)l * D * DFF, D, DFF, WGU + (size_t)l * 2 * DFF * D, 1, scr, r, F.lane); continue; } r -= I_G;
        if (r < I_G) { p0_transpose_item(INP(24) + (size_t)l * D * DFF, D, DFF, WGU + (size_t)l * 2 * DFF * D, 2, scr, r, F.lane); continue; } r -= I_G;
        p0_transpose_item(INP(27) + (size_t)l * DFF * D, DFF, D, WDN + (size_t)l * D * DFF, 0, scr, r, F.lane); }
    { bf16_t* LW = (bf16_t*)(ws + WS_LW);
      for (int it = gw; it < DEPTH * 8 * 8 * 16; it += NGW) { const int ks = it & 3, gs = (it >> 2) & 3, w = (it >> 4) & 7, n = (it >> 7) & 7, l = it >> 10;
          const float* src = (gs < 2 ? INP(15) : INP(17)) + ((size_t)((l * 2 + (gs & 1)) * 8 + n) * 128) * 128;
          const int c0 = 32 * ks + 8 * (F.lane >> 4), jc = 16 * w + (F.lane & 15); float v[8];
#pragma unroll
          for (int j = 0; j < 8; ++j) v[j] = src[(size_t)(c0 + j) * 128 + jc];
          u32x4 o; o.x = pk2(v[0], v[1]); o.y = pk2(v[2], v[3]); o.z = pk2(v[4], v[5]); o.w = pk2(v[6], v[7]);
          *(u32x4*)(LW + ((size_t)it * 64 + F.lane) * 8) = o; } }
    { float* LSP = (float*)(ws + WS_LSP); for (int i = F.bid * 512 + F.tid; i < DEPTH * 2048; i += F.G * 512) LSP[i] = log1pf(expf(-INP(19)[i])); }
    WG_BAR();
    { LAS float* cs = (LAS float*)F.lds; LAS float* red = (LAS float*)(F.lds + 81920); float* MOD = (float*)(ws + WS_MOD);
      const float* c_p = INP(2); const float* c_s = INP(3); const float* w_mod = INP(5); const float* b_mod = INP(6); const float* n1g = INP(7); const float* n2g = INP(8);
      for (int i = F.tid; i < NB * D; i += 512) { const int b = i >> 11, k = i & 2047; const float c = b < 2 ? c_p[b * D + k] : c_s[(b - 2) * D + k]; cs[i] = c / (1.0f + __expf(-c)); }
      WG_BAR();
      for (int item = F.bid; item < DEPTH * 192; item += F.G) { const int l = item / 192, col0 = (item % 192) * 64, w = F.wave, lane = F.lane;
          float acc[NB];
#pragma unroll
          for (int b = 0; b < NB; ++b) acc[b] = 0.f;
          const float* W = w_mod + (size_t)l * D * MODSTRIDE + col0 + lane;
          for (int k0 = 256 * w; k0 < 256 * w + 256; k0 += 16) { float wv[16];
#pragma unroll
              for (int j = 0; j < 16; ++j) wv[j] = W[(size_t)(k0 + j) * MODSTRIDE];
#pragma unroll
              for (int j4 = 0; j4 < 4; ++j4)
#pragma unroll
                  for (int b = 0; b < NB; ++b) { const f32x4 c4 = *(const LAS f32x4*)(cs + b * D + k0 + 4 * j4); acc[b] += (c4.x * wv[4 * j4] + c4.y * wv[4 * j4 + 1]) + (c4.z * wv[4 * j4 + 2] + c4.w * wv[4 * j4 + 3]); } }
#pragma unroll
          for (int b = 0; b < NB; ++b) red[(w * NB + b) * 64 + lane] = acc[b];
          WG_BAR();
          for (int i = F.tid; i < NB * 64; i += 512) { const int b = i >> 6, cc = i & 63, col = col0 + cc; float s = b_mod[l * MODSTRIDE + col];
#pragma unroll
              for (int ww = 0; ww < 8; ++ww) s += red[(ww * NB + b) * 64 + cc];
              const int slot = col >> 11, c = col & 2047;
              if (slot == 1) s = n1g[l * D + c] * (1.0f + s); else if (slot == 4) s = n2g[l * D + c] * (1.0f + s);
              MOD[((size_t)l * NB + b) * MODSTRIDE + col] = s; }
          WG_BAR(); } }
}

__device__ __forceinline__ void phase_norm0(const Frame& F0, const float* x_p, const float* x_s, const float* mod0, bf16_t* XG, float* RSTD, _Float16* XR) { const Frame F = fresh(F0);
    const int gw = F.bid * NWAVES + F.wave, NGW = F.G * NWAVES, lane = F.lane;
    for (int row = gw; row < T; row += NGW) { const int b = row < ROWS_P ? (row >> 13) : 2 + ((row - ROWS_P) >> 12);
        const float* xr = row < ROWS_P ? x_p + (size_t)row * D : x_s + (size_t)(row - ROWS_P) * D; const float* gm = mod0 + (size_t)b * MODSTRIDE + D;
        f32x4 v[8]; float ss = 0.f;
#pragma unroll
        for (int j = 0; j < 8; ++j) { v[j] = ((const f32x4*)xr)[lane + 64 * j]; ss += (v[j].x * v[j].x + v[j].y * v[j].y) + (v[j].z * v[j].z + v[j].w * v[j].w); }
        ss = wave_sum(ss); if (lane == 0) RSTD[row] = rsqrtf(ss * (1.0f / D) + EPS);
#pragma unroll
        for (int j = 0; j < 8; ++j) { const f32x4 g = ((const f32x4*)gm)[lane + 64 * j]; const f32x4 o = v[j] * g; u32x2 p; p.x = pk2(o.x, o.y); p.y = pk2(o.z, o.w); ((u32x2*)(XG + (size_t)row * D))[lane + 64 * j] = p;
            typedef _Float16 h16x4 __attribute__((ext_vector_type(4))); h16x4 q; q[0] = (_Float16)v[j].x; q[1] = (_Float16)v[j].y; q[2] = (_Float16)v[j].z; q[3] = (_Float16)v[j].w; ((h16x4*)(XR + (size_t)row * D))[lane + 64 * j] = q; } }
}
__device__ __forceinline__ void phase_rstd(const Frame& F0, int mode, const float* SSQX, float* RSTD, const float* SSQA, const float* SSQL, float* RATIO, float* S2) { const Frame F = fresh(F0);
    for (int row = F.bid * 512 + F.tid; row < T; row += F.G * 512) {
        if (mode == 0) { const f32x4* p = (const f32x4*)(SSQX + (size_t)row * 32); f32x4 s = p[0];
#pragma unroll
            for (int j = 1; j < 8; ++j) s += p[j];
            RSTD[row] = rsqrtf(((s.x + s.y) + (s.z + s.w)) * (1.0f / D) + EPS); }
        else { const f32x4* pa = (const f32x4*)(SSQA + (size_t)row * 8); const f32x4* pl = (const f32x4*)(SSQL + (size_t)row * 8); const f32x4 a = pa[0] + pa[1], l = pl[0] + pl[1];
            const float s1 = rsqrtf(((a.x + a.y) + (a.z + a.w)) * (1.0f / 1024.0f) + EPS), s2 = rsqrtf(((l.x + l.y) + (l.z + l.w)) * (1.0f / 1024.0f) + EPS);
            RATIO[row] = s1 / s2; S2[row] = s2; } }
}
__device__ __forceinline__ void phase_bias(const Frame& F0, const float* MOD, const bf16_t* WIN, const bf16_t* WGU, float* BIN, float* BGU) { const Frame F = fresh(F0);
    const int fr = F.lane & 15, fq = F.lane >> 4;
    constexpr int T_IN = ZC / 16, T_GU = 2 * DFF / 16, T_L = T_IN + T_GU;
    for (int tile = F.bid * NWAVES + F.wave; tile < DEPTH * T_L; tile += F.G * NWAVES) { const int l = tile / T_L; int r = tile - l * T_L; const int which = r >= T_IN ? 1 : 0; if (which) r -= T_IN;
        const int N = which ? 2 * DFF : ZC, n0 = 16 * r;
        const bf16_t* wp = (which ? WGU + (size_t)l * 2 * DFF * D : WIN + (size_t)l * ZC * D) + (size_t)(n0 + fr) * D + 8 * fq;
        const float* sp = MOD + ((size_t)l * NB + (fr < NB ? fr : 0)) * MODSTRIDE + (which ? 3 : 0) * D + 8 * fq;
        f32x4 acc = (f32x4){0.f, 0.f, 0.f, 0.f};
#pragma unroll 4
        for (int ks = 0; ks < D / 32; ++ks) { const bf16x8 af = *(const bf16x8*)(wp + 32 * ks); f32x4 s0 = *(const f32x4*)(sp + 32 * ks), s1 = *(const f32x4*)(sp + 32 * ks + 4);
            if (fr >= NB) { s0 = (f32x4){0.f, 0.f, 0.f, 0.f}; s1 = s0; }
            unsigned hi[4], lo[4]; const float sv[8] = {s0.x, s0.y, s0.z, s0.w, s1.x, s1.y, s1.z, s1.w};
#pragma unroll
            for (int j = 0; j < 4; ++j) { const unsigned h0 = f2bf(sv[2 * j]), h1 = f2bf(sv[2 * j + 1]); hi[j] = h0 | (h1 << 16); lo[j] = pk2(sv[2 * j] - __uint_as_float(h0 << 16), sv[2 * j + 1] - __uint_as_float(h1 << 16)); }
            const u32x4 hv = (u32x4){hi[0], hi[1], hi[2], hi[3]}, lv = (u32x4){lo[0], lo[1], lo[2], lo[3]};
            acc = __builtin_amdgcn_mfma_f32_16x16x32_bf16(af, __builtin_bit_cast(bf16x8, hv), acc, 0, 0, 0); acc = __builtin_amdgcn_mfma_f32_16x16x32_bf16(af, __builtin_bit_cast(bf16x8, lv), acc, 0, 0, 0); }
        if (fr < NB) { float* bp = (which ? BGU + (size_t)l * NB * 2 * DFF : BIN + (size_t)l * NB * ZC) + (size_t)fr * N + n0 + 4 * fq; *(f32x4*)bp = acc; }
    }
}

constexpr int AT_ROW = 272, AT_BUF = 2 * 64 * AT_ROW + 256  , AT_KS = 0, AT_VS = 64 * AT_ROW, AT_RSK = 2 * 64 * AT_ROW, AT_BIAS = 2 * AT_BUF, AT_GQ = AT_BIAS + 8 * 384 * 4;
static_assert(AT_GQ + 512 <= LDS_CTL, "attention LDS map");
constexpr float LOG2E = 1.4426950408889634f;
__device__ __forceinline__ int t5_bucket(int rel) { const int n = rel < 0 ? -rel : rel; int v; if (n < 8) v = n; else { v = (31 - __clz(n * n)) + 2; v = v > 15 ? 15 : v; } return (rel > 0 ? 16 : 0) + v; }
__device__ __forceinline__ s16x4 lds_tr16(LAS unsigned char* p) { typedef short v4i16_t __attribute__((ext_vector_type(4))); return __builtin_bit_cast(s16x4, __builtin_amdgcn_ds_read_tr16_b64_v4i16((LAS v4i16_t*)p)); }
__device__ __forceinline__ void phase_attn(const Frame& F0, const bf16_t* Z, const float* qg, const float* kg, const float* sink, const float* relb, bf16_t* MRG, float* SSQA) { const Frame F = fresh(F0);
    LAS unsigned char* lds = F.lds; const int tid = F.tid, lane = F.lane, w = F.wave, fr = lane & 15, fq = lane >> 4, g = w & 3, hq = w >> 2;
    LAS float* bias = (LAS float*)(lds + AT_BIAS);
    for (int i = tid; i < 8 * 384; i += 512) { const int h = i / 384, rel = i - 384 * h - 192; bias[i] = (rel >= -128 && rel <= 128) ? relb[t5_bucket(rel) * 8 + h] * LOG2E - 12.0f : -1e30f; }
    LAS float* gqt = (LAS float*)(lds + AT_GQ);
    if (tid < 128) gqt[tid] = qg[tid] * kg[tid];
    WG_BAR();
    const int p0 = tid, p1 = tid + 512;
    const int per_x = ((T / 64) * 2 + 7) / 8, slots = F.G / 8;
    for (int it_ = F.bid >> 3; it_ < per_x; it_ += slots) { const int item = (F.bid & 7) * per_x + it_; if (item >= (T / 64) * 2) break;
        const int qb = item >> 1, kvh = item & 1, q0 = qb * 64, h = kvh * 4 + g; int b_, t0, S; rowinfo(q0, b_, t0, S); const int seq0 = q0 - t0;
        bf16x8 Qf[2][4];
#pragma unroll
        for (int qt = 0; qt < 2; ++qt) { const bf16_t* qp = Z + (size_t)(q0 + 32 * hq + 16 * qt + fr) * ZC + ZQ + h * 128 + 8 * fq; u32x4 raw[4]; float ss = 0.f;
#pragma unroll
            for (int ks = 0; ks < 4; ++ks) { raw[ks] = *(const u32x4*)(qp + 32 * ks); const unsigned rw[4] = {raw[ks].x, raw[ks].y, raw[ks].z, raw[ks].w};
#pragma unroll
                for (int e = 0; e < 4; ++e) { const float a0 = bflo(rw[e]), a1 = bfhi(rw[e]); ss += a0 * a0 + a1 * a1; } }
            ss += __shfl_xor(ss, 16); ss += __shfl_xor(ss, 32);
            const float rs = rsqrtf(ss * (1.0f / 128.0f) + EPS) * (0.08838834764831845f * LOG2E);
#pragma unroll
            for (int ks = 0; ks < 4; ++ks) { const unsigned rw[4] = {raw[ks].x, raw[ks].y, raw[ks].z, raw[ks].w}; u32x4 o;
                const f32x4 g0 = *(const LAS f32x4*)(gqt + 32 * ks + 8 * fq), g1 = *(const LAS f32x4*)(gqt + 32 * ks + 8 * fq + 4);
                o.x = pg8::cvt_pk_bf16(bflo(rw[0]) * rs * g0[0], bfhi(rw[0]) * rs * g0[1]); o.y = pg8::cvt_pk_bf16(bflo(rw[1]) * rs * g0[2], bfhi(rw[1]) * rs * g0[3]);
                o.z = pg8::cvt_pk_bf16(bflo(rw[2]) * rs * g1[0], bfhi(rw[2]) * rs * g1[1]); o.w = pg8::cvt_pk_bf16(bflo(rw[3]) * rs * g1[2], bfhi(rw[3]) * rs * g1[3]);
                Qf[qt][ks] = __builtin_bit_cast(bf16x8, o); } }
        f32x4 O[8][2];
#pragma unroll
        for (int dt = 0; dt < 8; ++dt) { O[dt][0] = (f32x4){0.f, 0.f, 0.f, 0.f}; O[dt][1] = (f32x4){0.f, 0.f, 0.f, 0.f}; }
        float lsum[2] = {0.f, 0.f};
        const int c_lo = t0 >= 128 ? 0 : (128 - t0) / 64, c_hi = (t0 + 192 <= S) ? 4 : 4 - (t0 + 192 - S) / 64;
        u32x4 kr[2], vr[2];
#define AT_FETCH(c) do { const size_t rb = (size_t)(seq0 + t0 - 128 + 64 * (c)); \
          kr[0] = *(const u32x4*)(Z + (rb + (p0 >> 4)) * ZC + ZK + kvh * 128 + 8 * (p0 & 15)); kr[1] = *(const u32x4*)(Z + (rb + (p1 >> 4)) * ZC + ZK + kvh * 128 + 8 * (p1 & 15)); \
          vr[0] = *(const u32x4*)(Z + (rb + (p0 >> 4)) * ZC + ZV + kvh * 128 + 8 * (p0 & 15)); vr[1] = *(const u32x4*)(Z + (rb + (p1 >> 4)) * ZC + ZV + kvh * 128 + 8 * (p1 & 15)); } while (0)
#define AT_PARK(buf) do { LAS unsigned char* bb = lds + (buf) * AT_BUF; _Pragma("unroll") for (int i = 0; i < 2; ++i) { const int p = i ? p1 : p0, key = p >> 4, part = p & 15; \
                *(LAS u32x4*)(bb + AT_KS + key * AT_ROW + part * 16) = kr[i]; *(LAS u32x4*)(bb + AT_VS + key * AT_ROW + part * 16) = vr[i]; \
                const unsigned kw[4] = {kr[i].x, kr[i].y, kr[i].z, kr[i].w}; float ss = 0.f; \
                _Pragma("unroll") for (int e = 0; e < 4; ++e) { const float a0 = bflo(kw[e]), a1 = bfhi(kw[e]); ss += a0 * a0 + a1 * a1; } \
                ss += __shfl_xor(ss, 1); ss += __shfl_xor(ss, 2); ss += __shfl_xor(ss, 4); ss += __shfl_xor(ss, 8); \
                if (part == 0) ((LAS float*)(bb + AT_RSK))[key] = rsqrtf(ss * (1.0f / 128.0f) + EPS); } } while (0)
        AT_FETCH(c_lo);
        WG_BAR();
        AT_PARK(0);
        WG_BAR();
        for (int c = c_lo; c <= c_hi; ++c) { LAS unsigned char* bb = lds + ((c - c_lo) & 1) * AT_BUF;
            if (c < c_hi) AT_FETCH(c + 1);
            f32x4 Sx[4][2];
#pragma unroll
            for (int kt = 0; kt < 4; ++kt) { Sx[kt][0] = (f32x4){0.f, 0.f, 0.f, 0.f}; Sx[kt][1] = (f32x4){0.f, 0.f, 0.f, 0.f};
#pragma unroll
                for (int ks = 0; ks < 4; ++ks) { const bf16x8 kf = *(const LAS bf16x8*)(bb + AT_KS + (16 * kt + fr) * AT_ROW + (32 * ks + 8 * fq) * 2);
                    Sx[kt][0] = __builtin_amdgcn_mfma_f32_16x16x32_bf16(kf, Qf[0][ks], Sx[kt][0], 0, 0, 0); Sx[kt][1] = __builtin_amdgcn_mfma_f32_16x16x32_bf16(kf, Qf[1][ks], Sx[kt][1], 0, 0, 0); } }
            bf16x8 Pf[2][2];
            f32x4 rk[4];
#pragma unroll
            for (int kt = 0; kt < 4; ++kt) rk[kt] = *(const LAS f32x4*)(bb + AT_RSK + (16 * kt + 4 * fq) * 4);
#pragma unroll
            for (int qt = 0; qt < 2; ++qt) { float pv[4][4]; const LAS float* bp = bias + h * 384 + 64 * c + 64 + 4 * fq - (32 * hq + 16 * qt + fr);
#pragma unroll
                for (int kt = 0; kt < 4; ++kt)
#pragma unroll
                    for (int i = 0; i < 4; ++i) { const float p = __builtin_amdgcn_exp2f(Sx[kt][qt][i] * rk[kt][i] + bp[16 * kt + i]); pv[kt][i] = p; lsum[qt] += p; }
#pragma unroll
                for (int s = 0; s < 2; ++s) { u32x4 o; o.x = pg8::cvt_pk_bf16(pv[2 * s][0], pv[2 * s][1]); o.y = pg8::cvt_pk_bf16(pv[2 * s][2], pv[2 * s][3]); o.z = pg8::cvt_pk_bf16(pv[2 * s + 1][0], pv[2 * s + 1][1]); o.w = pg8::cvt_pk_bf16(pv[2 * s + 1][2], pv[2 * s + 1][3]);
                    Pf[qt][s] = __builtin_bit_cast(bf16x8, o); } }
#pragma unroll
            for (int dt = 0; dt < 8; ++dt)
#pragma unroll
                for (int s = 0; s < 2; ++s) { LAS unsigned char* vb = bb + AT_VS + (32 * s + 4 * fq + (fr >> 2)) * AT_ROW + (16 * dt + 4 * (fr & 3)) * 2;
                    const s16x4 lo = lds_tr16(vb), hi = lds_tr16(vb + 16 * AT_ROW);
                    const bf16x8 vf = (bf16x8){lo[0], lo[1], lo[2], lo[3], hi[0], hi[1], hi[2], hi[3]};
                    O[dt][0] = __builtin_amdgcn_mfma_f32_16x16x32_bf16(vf, Pf[0][s], O[dt][0], 0, 0, 0); O[dt][1] = __builtin_amdgcn_mfma_f32_16x16x32_bf16(vf, Pf[1][s], O[dt][1], 0, 0, 0); }
            if (c < c_hi) { AT_PARK(((c - c_lo) & 1) ^ 1); WG_BAR(); }
        }
#undef AT_FETCH
#undef AT_PARK
        const float sk = __builtin_amdgcn_exp2f(sink[h] * LOG2E - 12.0f);
#pragma unroll
        for (int qt = 0; qt < 2; ++qt) { float l = lsum[qt]; l += __shfl_xor(l, 16); l += __shfl_xor(l, 32); const float inv = 1.0f / (l + sk);
            const int row = q0 + 32 * hq + 16 * qt + fr; bf16_t* op = MRG + (size_t)row * D + h * 128 + 4 * fq; float ss = 0.f;
#pragma unroll
            for (int dt = 0; dt < 8; ++dt) { u32x2 o; o.x = pg8::cvt_pk_bf16(O[dt][qt][0] * inv, O[dt][qt][1] * inv); o.y = pg8::cvt_pk_bf16(O[dt][qt][2] * inv, O[dt][qt][3] * inv); *(u32x2*)(op + 16 * dt) = o;
                const float e0 = bflo(o.x), e1 = bfhi(o.x), e2 = bflo(o.y), e3 = bfhi(o.y); ss += (e0 * e0 + e1 * e1) + (e2 * e2 + e3 * e3); }
            ss += __shfl_xor(ss, 16); ss += __shfl_xor(ss, 32); if (fq == 0) SSQA[(size_t)row * 8 + h] = ss; }
    }
    WG_BAR();
}

constexpr int LR_HF = 0, LR_HF_ROW = 528, LR_XCB = 67584, LR_YG = 102656, LR_YG_ROW = 272, LR_END = 137472;
static_assert(LR_END <= LDS_CTL, "LRU LDS map");
__device__ __forceinline__ int xcb_off(int tok) { return tok * 272 + (tok >> 5) * 64; }
struct LruConsts { float ba_f, ba_b, bx_f, bx_b, sp_f, sp_b; };
__device__ __forceinline__ void lru_fetch_xr(const Frame& F, const bf16_t* Z, int row0, int n, unsigned (&xr)[19]) {
    const int cp = F.tid & 63, tg = F.tid >> 6, ch = 128 * n + 2 * cp; int b_, t0, S; rowinfo(row0, b_, t0, S);
#pragma unroll
    for (int i = 0; i < 19; ++i) { const int tt = t0 + 16 * tg - 2 + i; unsigned v = 0u; if (tt >= 0 && tt < S) v = *(const unsigned*)(Z + (size_t)(row0 + 16 * tg - 2 + i) * ZC + ZX + ch); xr[i] = v; }
}
__device__ __forceinline__ void lru_park_xc(const Frame& F, const float* cw, const float* cb, int n, const unsigned (&xr)[19]) {
    const int cp = F.tid & 63, tg = F.tid >> 6, ch = 128 * n + 2 * cp;
    const float w00 = cw[ch], w01 = cw[ch + 1], w10 = cw[1024 + ch], w11 = cw[1024 + ch + 1], w20 = cw[2048 + ch], w21 = cw[2048 + ch + 1], w30 = cw[3072 + ch], w31 = cw[3072 + ch + 1], b0 = cb[ch], b1 = cb[ch + 1];
#pragma unroll
    for (int i = 0; i < 16; ++i) { const float y0 = b0 + w00 * bflo(xr[i]) + w10 * bflo(xr[i + 1]) + w20 * bflo(xr[i + 2]) + w30 * bflo(xr[i + 3]), y1 = b1 + w01 * bfhi(xr[i]) + w11 * bfhi(xr[i + 1]) + w21 * bfhi(xr[i + 2]) + w31 * bfhi(xr[i + 3]);
        const int tk = 16 * tg + i; *(LAS unsigned*)(F.lds + LR_XCB + xcb_off(tk) + 4 * cp) = pk2(y0, y1); }
}
typedef _Float16 f16x8 __attribute__((ext_vector_type(8)));
__device__ __forceinline__ void lru_ab2(f32x2 ga, f32x2 gx, f32x2 xc, float ba, float bx, float sp, f32x2& la, f32x2& a, f32x2& b) {
    const f32x2 ta = (ga + ba) * (-LOG2E), tx = (gx + bx) * (-LOG2E);
    f32x2 da, dx; da.x = 1.0f + __builtin_amdgcn_exp2f(ta.x); da.y = 1.0f + __builtin_amdgcn_exp2f(ta.y); dx.x = 1.0f + __builtin_amdgcn_exp2f(tx.x); dx.y = 1.0f + __builtin_amdgcn_exp2f(tx.y);
    const f32x2 dd = da * dx; f32x2 rc; rc.x = __builtin_amdgcn_rcpf(dd.x); rc.y = __builtin_amdgcn_rcpf(dd.y);
    const f32x2 r = dx * rc, ig = da * rc;
    la = r * (-8.0f * sp);
    const f32x2 tl = la * LOG2E; a.x = __builtin_amdgcn_exp2f(tl.x); a.y = __builtin_amdgcn_exp2f(tl.y);
    const f32x2 x2 = la * 2.0f;
    const f32x2 ser = -x2 * (1.0f + x2 * (0.5f + x2 * 0.16666667f)), alt = (1.0f - a) * (1.0f + a);
    f32x2 om; om.x = x2.x > -0.25f ? ser.x : alt.x; om.y = x2.y > -0.25f ? ser.y : alt.y;
    f32x2 sq; sq.x = __builtin_amdgcn_sqrtf(om.x); sq.y = __builtin_amdgcn_sqrtf(om.y);
    b = sq * ig * xc;
}
__device__ __forceinline__ void lru_load_w(const bf16_t* LWl, int n, int w, int lane, int gs, bf16x8 (&Wf)[4]) {
    int lo = lane * 8; asm volatile("" : "+v"(lo));
#pragma unroll
    for (int ks = 0; ks < 4; ++ks) Wf[ks] = *(const bf16x8*)(LWl + (size_t)(((n * 8 + w) * 4 + gs) * 4 + ks) * 512 + lo);
}
__device__ __forceinline__ LruConsts lru_consts(const float* b_a, const float* b_x, const float* lam, int ch) {
    LruConsts c; c.ba_f = b_a[ch]; c.ba_b = b_a[1024 + ch]; c.bx_f = b_x[ch]; c.bx_b = b_x[1024 + ch]; c.sp_f = lam[ch]; c.sp_b = lam[1024 + ch]; return c;
}
__device__ __forceinline__ void phase_lru1(const Frame& F0, const bf16_t* Z, const bf16_t* LWl, const float* cw, const float* cb, const float* b_a, const float* b_x, const float* lam, float* SUM, f16x8* LC) { const Frame F = fresh(F0);
    const int lane = F.lane, w = F.wave, fr = lane & 15, fq = lane >> 4, n = F.bid & 7, ch = 128 * n + 16 * w + fr;
    bf16x8 Waf[4], Wab[4], Wxf[4], Wxb[4]; lru_load_w(LWl, n, w, lane, 0, Waf); lru_load_w(LWl, n, w, lane, 1, Wab); lru_load_w(LWl, n, w, lane, 2, Wxf); lru_load_w(LWl, n, w, lane, 3, Wxb);
    const LruConsts C = lru_consts(b_a, b_x, lam, ch);
    const int arow = 32 * (fr >> 2) + (fr & 3);
    unsigned xr[19];
    if (F.bid < (T / 128) * 8) lru_fetch_xr(F, Z, (F.bid >> 3) * 128, n, xr);
    for (int item = F.bid; item < (T / 128) * 8; item += F.G) { const int chunk = item >> 3;
        WG_BAR(); lru_park_xc(F, cw, cb, n, xr);
        if (item + F.G < (T / 128) * 8) lru_fetch_xr(F, Z, ((item + F.G) >> 3) * 128, n, xr);
        asm volatile("s_waitcnt lgkmcnt(0)" ::: "memory"); __builtin_amdgcn_s_barrier(); asm volatile("" ::: "memory");
        float RAf = 1.f, RBf = 0.f, RAb = 1.f, RBb = 0.f;
#pragma unroll 2
        for (int tau = 0; tau < 8; ++tau) {
            f32x4 gaf = (f32x4){0.f, 0.f, 0.f, 0.f}, gab = gaf, gxf = gaf, gxb = gaf;
#pragma unroll
            for (int ks = 0; ks < 4; ++ks) { const bf16x8 af = *(const LAS bf16x8*)(F.lds + LR_XCB + xcb_off(arow + 4 * tau) + (32 * ks + 8 * fq) * 2);
                gaf = __builtin_amdgcn_mfma_f32_16x16x32_bf16(af, Waf[ks], gaf, 0, 0, 0); gab = __builtin_amdgcn_mfma_f32_16x16x32_bf16(af, Wab[ks], gab, 0, 0, 0);
                gxf = __builtin_amdgcn_mfma_f32_16x16x32_bf16(af, Wxf[ks], gxf, 0, 0, 0); gxb = __builtin_amdgcn_mfma_f32_16x16x32_bf16(af, Wxb[ks], gxb, 0, 0, 0); }
            float xc[4];
#pragma unroll
            for (int i = 0; i < 4; ++i) xc[i] = bf2f(*(const LAS bf16_t*)(F.lds + LR_XCB + xcb_off(32 * fq + 4 * tau + i) + (16 * w + fr) * 2));
            f16x8 cf, cbk;
#pragma unroll
            for (int p = 0; p < 2; ++p) { f32x2 la, a, b; const f32x2 x = (f32x2){xc[2 * p], xc[2 * p + 1]};
                lru_ab2((f32x2){gaf[2 * p], gaf[2 * p + 1]}, (f32x2){gxf[2 * p], gxf[2 * p + 1]}, x, C.ba_f, C.bx_f, C.sp_f, la, a, b);
                RBf = a.x * RBf + b.x; RAf = a.x * RAf; RBf = a.y * RBf + b.y; RAf = a.y * RAf;
                cf[4 * p] = (_Float16)la.x; cf[4 * p + 1] = (_Float16)b.x; cf[4 * p + 2] = (_Float16)la.y; cf[4 * p + 3] = (_Float16)b.y;
                lru_ab2((f32x2){gab[2 * p], gab[2 * p + 1]}, (f32x2){gxb[2 * p], gxb[2 * p + 1]}, x, C.ba_b, C.bx_b, C.sp_b, la, a, b);
                RBb = RAb * b.x + RBb; RAb = RAb * a.x; RBb = RAb * b.y + RBb; RAb = RAb * a.y;
                cbk[4 * p] = (_Float16)la.x; cbk[4 * p + 1] = (_Float16)b.x; cbk[4 * p + 2] = (_Float16)la.y; cbk[4 * p + 3] = (_Float16)b.y; }
            f16x8* cp = LC + ((size_t)(item * 8 + w) * 16 + tau) * 64 + lane;
            __builtin_nontemporal_store(cf, cp); __builtin_nontemporal_store(cbk, cp + 8 * 64); }
#pragma unroll
        for (int st = 0; st < 2; ++st) { const int o = 16 << st; const bool early = ((fq >> st) & 1) == 0;
            const float pAf = __shfl_xor(RAf, o), pBf = __shfl_xor(RBf, o), pAb = __shfl_xor(RAb, o), pBb = __shfl_xor(RBb, o);
            const float XAf = early ? RAf : pAf, XBf = early ? RBf : pBf, YAf = early ? pAf : RAf, YBf = early ? pBf : RBf;
            const float XAb = early ? RAb : pAb, XBb = early ? RBb : pBb, YAb = early ? pAb : RAb, YBb = early ? pBb : RBb;
            RAf = YAf * XAf; RBf = YAf * XBf + YBf; RAb = XAb * YAb; RBb = XAb * YBb + XBb; }
        if (fq == 0) { float* s = SUM + (size_t)chunk * 4096 + ch; s[0] = RAf; s[1024] = RBf; s[2048] = RAb; s[3072] = RBb; }
    }
    WG_BAR();
}
__device__ __forceinline__ void phase_lru_carry(const Frame& F0, const float* SUM, float* CAR) { const Frame F = fresh(F0);
    for (int id = F.bid * 512 + F.tid; id < NB * 2048; id += F.G * 512) { const int s = id >> 11, dir = (id >> 10) & 1, ch = id & 1023;
        const int c0 = s < 2 ? 64 * s : 128 + 32 * (s - 2), nc = s < 2 ? 64 : 32; float h = 0.f;
        for (int j0 = 0; j0 < nc; j0 += 8) { float A[8], B[8];
#pragma unroll
            for (int k = 0; k < 8; ++k) { const int j = dir == 0 ? j0 + k : nc - 1 - (j0 + k); const size_t o = (size_t)(c0 + j) * 4096 + (dir ? 2048 : 0) + ch; A[k] = SUM[o]; B[k] = SUM[o + 1024]; }
#pragma unroll
            for (int k = 0; k < 8; ++k) { const int j = dir == 0 ? j0 + k : nc - 1 - (j0 + k); CAR[(size_t)(c0 + j) * 2048 + (dir ? 1024 : 0) + ch] = h; h = A[k] * h + B[k]; } } }
}
__device__ __forceinline__ void lru_unpack_ab(const f16x8 (&c)[8], float (&a)[32], float (&b)[32]) {
#pragma unroll
    for (int tau = 0; tau < 8; ++tau)
#pragma unroll
        for (int i = 0; i < 4; ++i) { a[4 * tau + i] = __builtin_amdgcn_exp2f((float)c[tau][2 * i] * LOG2E); b[4 * tau + i] = (float)c[tau][2 * i + 1]; }
}
__device__ __forceinline__ void phase_lru2(const Frame& F0, const bf16_t* Z, const f16x8* LC, const float* CAR, bf16_t* MRG, float* SSQL) { const Frame F = fresh(F0);
    const int lane = F.lane, w = F.wave, fr = lane & 15, fq = lane >> 4, n = F.bid & 7, ch = 128 * n + 16 * w + fr;
    constexpr int NITEM = (T / 128) * 8;
    f16x8 cf_[8], cb_[8]; float cf = 0.f, cbk = 0.f; u32x4 yv[4];
#define LR2_FETCH(it) do { const int chunk_ = (it) >> 3; const f16x8* cp_ = LC + (size_t)((it) * 8 + w) * 16 * 64 + lane; \
        _Pragma("unroll") for (int tau = 0; tau < 8; ++tau) { cf_[tau] = __builtin_nontemporal_load(cp_ + tau * 64); cb_[tau] = __builtin_nontemporal_load(cp_ + (8 + tau) * 64); } \
        cf = CAR[(size_t)chunk_ * 2048 + ch]; cbk = CAR[(size_t)chunk_ * 2048 + 1024 + ch]; \
        _Pragma("unroll") for (int i = 0; i < 4; ++i) { const int p = F.tid + 512 * i, tk = p >> 4, part = p & 15; yv[i] = *(const u32x4*)(Z + (size_t)(chunk_ * 128 + tk) * ZC + ZY + 128 * n + 8 * part); } } while (0)
    if (F.bid < NITEM) LR2_FETCH(F.bid);
    for (int item = F.bid; item < NITEM; item += F.G) { const int chunk = item >> 3, row0 = chunk * 128;
        WG_BAR();
#pragma unroll
        for (int i = 0; i < 4; ++i) { const int p = F.tid + 512 * i, tk = p >> 4, part = p & 15; *(LAS u32x4*)(F.lds + LR_YG + tk * LR_YG_ROW + part * 16) = yv[i]; }
        float a[32], b[32], hf[32]; const float cfw = cf, cbw = cbk;
        lru_unpack_ab(cf_, a, b);
        { float IA = 1.f, IB = 0.f;
#pragma unroll
          for (int t = 0; t < 32; ++t) { IB = a[t] * IB + b[t]; IA = a[t] * IA; }
          { const float xA = __shfl_up(IA, 16), xB = __shfl_up(IB, 16); if (fq >= 1) { IB = IA * xB + IB; IA = IA * xA; } }
          { const float xA = __shfl_up(IA, 32), xB = __shfl_up(IB, 32); if (fq >= 2) { IB = IA * xB + IB; IA = IA * xA; } }
          float EA = __shfl_up(IA, 16), EB = __shfl_up(IB, 16); if (fq == 0) { EA = 1.f; EB = 0.f; }
          float h = EA * cfw + EB;
#pragma unroll
          for (int t = 0; t < 32; ++t) { h = a[t] * h + b[t]; hf[t] = h; } }
        lru_unpack_ab(cb_, a, b);
        if (item + F.G < NITEM) LR2_FETCH(item + F.G);
        asm volatile("s_waitcnt lgkmcnt(0)" ::: "memory"); __builtin_amdgcn_s_barrier(); asm volatile("" ::: "memory");
        { float IA = 1.f, IB = 0.f;
#pragma unroll
          for (int t = 31; t >= 0; --t) { IB = a[t] * IB + b[t]; IA = a[t] * IA; }
          { const float xA = __shfl_down(IA, 16), xB = __shfl_down(IB, 16); if (fq <= 2) { IB = IA * xB + IB; IA = IA * xA; } }
          { const float xA = __shfl_down(IA, 32), xB = __shfl_down(IB, 32); if (fq <= 1) { IB = IA * xB + IB; IA = IA * xA; } }
          float EA = __shfl_down(IA, 16), EB = __shfl_down(IB, 16); if (fq == 3) { EA = 1.f; EB = 0.f; }
          float h = EA * cbw + EB;
#pragma unroll
          for (int t = 31; t >= 0; --t) { h = a[t] * h + b[t]; LAS bf16_t* yp = (LAS bf16_t*)(F.lds + LR_YG + (32 * fq + t) * LR_YG_ROW + (16 * w + fr) * 2);
              *yp = (bf16_t)f2bf((hf[t] + h) * pg8::gelu_tanh_f(bf2f(*yp))); if ((t & 7) == 0) __builtin_amdgcn_sched_barrier(0); } }
        asm volatile("s_waitcnt lgkmcnt(0)" ::: "memory"); __builtin_amdgcn_s_barrier(); asm volatile("" ::: "memory");
#pragma unroll
        for (int i = 0; i < 4; ++i) { const int p = F.tid + 512 * i, tk = p >> 4, part = p & 15; const u32x4 v = *(const LAS u32x4*)(F.lds + LR_YG + tk * LR_YG_ROW + part * 16);
            *(u32x4*)(MRG + (size_t)(row0 + tk) * D + 1024 + 128 * n + 8 * part) = v;
            float ss = (bflo(v.x) * bflo(v.x) + bfhi(v.x) * bfhi(v.x)) + (bflo(v.y) * bflo(v.y) + bfhi(v.y) * bfhi(v.y)) + (bflo(v.z) * bflo(v.z) + bfhi(v.z) * bfhi(v.z)) + (bflo(v.w) * bflo(v.w) + bfhi(v.w) * bfhi(v.w));
            ss += __shfl_xor(ss, 1); ss += __shfl_xor(ss, 2); ss += __shfl_xor(ss, 4); ss += __shfl_xor(ss, 8); if (part == 0) SSQL[(size_t)(row0 + tk) * 8 + n] = ss; }
    }
#undef LR2_FETCH
    WG_BAR();
}

__device__ __forceinline__ void phase_glu_fix(const Frame& F0, const float* HALO, const float* cw, const float* cb, bf16_t* ACT) { const Frame F = fresh(F0);
    for (int id = F.bid * 512 + F.tid; id < 384 * (DFF / 4); id += F.G * 512) { const int e = id / (DFF / 4), c = (id - e * (DFF / 4)) * 4, pm = e >> 1, side = e & 1, row = 256 * pm + (side ? 255 : 0);
        int b_, t, S; rowinfo(row, b_, t, S);
        const float* hp = HALO + (size_t)pm * 6 * DFF + c; const f32x4 z = (f32x4){0.f, 0.f, 0.f, 0.f};
        f32x4 gp, gc, gn, up;
        if (side == 0) { gp = t == 0 ? z : *(const f32x4*)(hp - 6 * DFF + 3 * DFF); gc = *(const f32x4*)(hp); gn = *(const f32x4*)(hp + DFF); up = *(const f32x4*)(hp + 4 * DFF); }
        else { gp = *(const f32x4*)(hp + 2 * DFF); gc = *(const f32x4*)(hp + 3 * DFF); gn = t == S - 1 ? z : *(const f32x4*)(hp + 6 * DFF); up = *(const f32x4*)(hp + 5 * DFF); }
        const f32x4 g = *(const f32x4*)(cw + c) * gp + *(const f32x4*)(cw + DFF + c) * gc + *(const f32x4*)(cw + 2 * DFF + c) * gn + *(const f32x4*)(cb + c);
        u32x2 o; o.x = pg8::cvt_pk_bf16(pg8::gelu_tanh_f(g[0]) * up[0], pg8::gelu_tanh_f(g[1]) * up[1]); o.y = pg8::cvt_pk_bf16(pg8::gelu_tanh_f(g[2]) * up[2], pg8::gelu_tanh_f(g[3]) * up[3]);
        *(u32x2*)(ACT + (size_t)row * DFF + c) = o; }
}

constexpr int PH_PER_LAYER = 11, PH0 = 2, N_PHASES = PH0 + DEPTH * PH_PER_LAYER;
#ifndef PHMASK
#define PHMASK 0xfff
#endif
#define PEN(k) ((PHMASK >> (k)) & 1)
#ifndef DBLMASK
#define DBLMASK 0
#endif
#define REP(k) for (int rep_ = 0; rep_ < 1 + ((DBLMASK >> (k)) & 1); ++rep_)
__global__ void __launch_bounds__(NWAVES * 64, 2) mega_fwd(Args a) {
    extern __shared__ __attribute__((aligned(16))) unsigned char lds_raw[];
    Frame F; F.lds = (LAS unsigned char*)lds_raw; F.tid = threadIdx.x; F.lane = F.tid & 63; F.wave = __builtin_amdgcn_readfirstlane(F.tid >> 6); F.G = gridDim.x; F.bid = blockIdx.x;
    unsigned char* ws = karg_ws();
    volatile LAS unsigned* MISC = (volatile LAS unsigned*)(F.lds + LDS_CTL);
    if (F.tid < 64) MISC[F.tid] = 0u;
    __syncthreads();
    const int lo = a.ph_lo, hi = a.ph_hi;
    XcdBarrier bar; bar.bar = (unsigned*)(ws + WS_CTL) + CW_BAR; bar.x = 0; bar.st = MISC; bar.wv = F.wave;
    if (hi - lo > 1) bar = xcd_barrier_post((unsigned*)(ws + WS_CTL) + CW_BAR, MISC, F.wave);
#define IN(k) (lo <= (k) && (k) < hi)
#define SEAM(k) do { if (IN(k) && IN((k) + 1)) xcd_barrier(bar); } while (0)
#define WSP(type, off) ((type*)(karg_ws() + (off)))
    PG8_LAS unsigned char* ring = (PG8_LAS unsigned char*)lds_raw;

    if (PEN(0) && IN(0)) { REP(0) phase_prologue(F, a); } SEAM(0);
    if (PEN(11) && IN(1)) { phase_bias(F, WSP(float, WS_MOD), WSP(bf16_t, WS_WIN), WSP(bf16_t, WS_WGU), WSP(float, WS_BIN), WSP(float, WS_BGU)); phase_norm0(F, karg_in(0), karg_in(1), WSP(float, WS_MOD), WSP(bf16_t, WS_H), WSP(float, WS_RSTD), WSP(_Float16, WS_XR)); } SEAM(1);
    for (int l = 0; l < DEPTH; ++l) {
        const int pb = PH0 + PH_PER_LAYER * l;
        const float* bp = l == 0 ? karg_in(0) : karg_out(); const float* bs = l == 0 ? karg_in(1) : karg_out() + (size_t)ROWS_P * D;
        if (PEN(1) && IN(pb + 0)) { if (l > 0) phase_rstd(F, 0, WSP(float, WS_SSQX), WSP(float, WS_RSTD), nullptr, nullptr, nullptr, nullptr); } SEAM(pb + 0);
        if (PEN(2) && IN(pb + 1)) { REP(2) { pg8::Gemm g{WSP(bf16_t, WS_H), WSP(bf16_t, WS_WIN) + (size_t)l * ZC * D, T, ZC, D}; pg8::StaticOrder S; S.init(T, ZC, F.G, F.bid); pg8::EpiStoreBf16N E{WSP(bf16_t, WS_Z), ZC, WSP(float, WS_RSTD), WSP(float, WS_BIN) + (size_t)l * NB * ZC};
            pg8::gemm_phase(ring, g, S, E, pg8::IdentMap{}, F.wave); } } SEAM(pb + 1);
        if (IN(pb + 2)) {
            if (PEN(3)) REP(3) phase_attn(F, WSP(bf16_t, WS_Z), karg_in(10) + l * 128, karg_in(11) + l * 128, karg_in(12) + l * 8, karg_in(4), WSP(bf16_t, WS_MRG), WSP(float, WS_SSQA));
            if (PEN(4)) REP(4) phase_lru1(F, WSP(bf16_t, WS_Z), WSP(bf16_t, WS_LW) + (size_t)l * 512 * 1024, karg_in(13) + (size_t)l * 4096, karg_in(14) + l * 1024, karg_in(16) + l * 2048, karg_in(18) + l * 2048, WSP(float, WS_LSP) + l * 2048, WSP(float, WS_SUM), (f16x8*)karg_out()); } SEAM(pb + 2);
        if (IN(pb + 3)) { if (PEN(5)) REP(5) phase_lru_carry(F, WSP(float, WS_SUM), WSP(float, WS_CAR)); } SEAM(pb + 3);
        if (IN(pb + 4)) { if (PEN(6)) REP(6) phase_lru2(F, WSP(bf16_t, WS_Z), (const f16x8*)karg_out(), WSP(float, WS_CAR), WSP(bf16_t, WS_MRG), WSP(float, WS_SSQL)); } SEAM(pb + 4);
        if (PEN(7) && IN(pb + 5)) { phase_rstd(F, 1, nullptr, nullptr, WSP(float, WS_SSQA), WSP(float, WS_SSQL), WSP(float, WS_RATIO), WSP(float, WS_S2)); } SEAM(pb + 5);
        if (PEN(8) && IN(pb + 6)) for (int rep_ = 0; rep_ < 1 + ((l == 0) ? ((DBLMASK >> 8) & 1) : 0); ++rep_) { const float* modl = WSP(float, WS_MOD) + (size_t)l * NB * MODSTRIDE; pg8::Gemm g{WSP(bf16_t, WS_MRG), WSP(bf16_t, WS_WOUT) + (size_t)l * D * D, T, D, D}; pg8::StaticOrder S; S.init(T, D, F.G, F.bid);
            pg8::EpiResid2<true> E{WSP(_Float16, WS_XR), nullptr, modl + 2 * D, modl + 4 * D, WSP(bf16_t, WS_H), WSP(float, WS_SSQX), WSP(float, WS_RATIO), WSP(float, WS_S2)}; pg8::gemm_phase(ring, g, S, E, pg8::IdentMap{}, F.wave); } SEAM(pb + 6);
        if (PEN(1) && IN(pb + 7)) { phase_rstd(F, 0, WSP(float, WS_SSQX), WSP(float, WS_RSTD), nullptr, nullptr, nullptr, nullptr); } SEAM(pb + 7);
        if (IN(pb + 8)) { if (PEN(9)) REP(9) { pg8::Gemm g{WSP(bf16_t, WS_H), WSP(bf16_t, WS_WGU) + (size_t)l * 2 * DFF * D, T, 2 * DFF, D}; pg8::StaticOrder S; S.init(T, 2 * DFF, F.G, F.bid);
            pg8::EpiGLU2 E{WSP(bf16_t, WS_ACT), karg_in(25) + (size_t)l * 3 * DFF, karg_in(26) + l * DFF, WSP(float, WS_RSTD), WSP(float, WS_BGU) + (size_t)l * NB * 2 * DFF, WSP(float, WS_HALO), (PG8_LAS float*)(ring + pg8::STAGE_BYTES)};
            pg8::gemm_phase(ring, g, S, E, pg8::IdentMap{}, F.wave); } } SEAM(pb + 8);
        if (IN(pb + 9)) { if (PEN(9)) phase_glu_fix(F, WSP(float, WS_HALO), karg_in(25) + (size_t)l * 3 * DFF, karg_in(26) + l * DFF, WSP(bf16_t, WS_ACT)); } SEAM(pb + 9);
        if (IN(pb + 10)) { if (PEN(10)) { const float* modl = WSP(float, WS_MOD) + (size_t)l * NB * MODSTRIDE; pg8::Gemm g{WSP(bf16_t, WS_ACT), WSP(bf16_t, WS_WDN) + (size_t)l * D * DFF, T, D, DFF}; pg8::StaticOrder S; S.init(T, D, F.G, F.bid);
            pg8::EpiResid2<false> E{WSP(_Float16, WS_XR), l + 1 < DEPTH ? nullptr : karg_out(), modl + 5 * D, l + 1 < DEPTH ? modl + (size_t)NB * MODSTRIDE + D : nullptr, WSP(bf16_t, WS_H), WSP(float, WS_SSQX), nullptr, nullptr};
            pg8::gemm_phase(ring, g, S, E, pg8::IdentMap{}, F.wave); } } SEAM(pb + 10);
    }
#undef IN
#undef SEAM
}
#ifndef HYB
#define HYB 0
#endif
extern "C" void kernel_launch(void* const* d_in, const int* in_sizes, int n_in, void* d_out, int out_size, void* d_ws, size_t ws_size, hipStream_t stream) {
    static int grid = 0;
    if (grid == 0) {
        if (n_in != 28 || ws_size < WS_END || out_size != T * D) { fprintf(stderr, "kernel_launch: unexpected sizes (n_in %d, ws %zu, out %d)\n", n_in, ws_size, out_size); grid = -1; return; }
        int dev = 0, cus = 0, per_cu = 0;
        if (hipGetDevice(&dev) != hipSuccess || hipDeviceGetAttribute(&cus, hipDeviceAttributeMultiprocessorCount, dev) != hipSuccess) { grid = -1; return; }
        if (hipFuncSetAttribute((const void*)mega_fwd, hipFuncAttributeMaxDynamicSharedMemorySize, LDS_BYTES) != hipSuccess) { fprintf(stderr, "kernel_launch: hipFuncSetAttribute failed\n"); grid = -1; return; }
        if (hipOccupancyMaxActiveBlocksPerMultiprocessor(&per_cu, (const void*)mega_fwd, NWAVES * 64, LDS_BYTES) != hipSuccess || per_cu < 1) { fprintf(stderr, "kernel_launch: occupancy query says %d blocks per CU\n", per_cu); grid = -1; (void)hipGetLastError(); return; }
        grid = cus & ~7;
    }
    if (grid < 0) return;
    (void)hipMemsetAsync((char*)d_ws + WS_CTL, 0, CTL_ZERO_BYTES, stream);
    Args a{};
    for (int i = 0; i < 28; ++i) a.in[i] = (const float*)d_in[i];
    a.out = (float*)d_out; a.ws = (unsigned char*)d_ws; a.flags = 0; a.pad = 0;
#if HYB & 8
    for (int p = 0; p < N_PHASES; ++p) { a.ph_lo = p; a.ph_hi = p + 1; hipLaunchKernelGGL(mega_fwd, dim3(grid), dim3(NWAVES * 64), LDS_BYTES, stream, a); }
#else
    a.ph_lo = 0; a.ph_hi = N_PHASES; hipLaunchKernelGGL(mega_fwd, dim3(grid), dim3(NWAVES * 64), LDS_BYTES, stream, a);
#endif
}
```

```cpp
#include <hip/hip_runtime.h>
#include <cstdio>
#include <cstdint>
#define HYB 0
#define DBLMASK 0

namespace pg8 {
#define PG8_LAS __attribute__((address_space(3)))
typedef unsigned short bf16_t;
typedef short bf16x8 __attribute__((ext_vector_type(8)));
typedef float f32x4 __attribute__((ext_vector_type(4)));
typedef unsigned u32x4 __attribute__((ext_vector_type(4)));
constexpr int BM = 256, BK = 64, HALF = 128, HTB = HALF * BK * 2  , STAGE_BYTES = 8 * HTB, NXCD = 8, WGM = 4;

__host__ __device__ __forceinline__ int lds_byte(int r, int c) { const int st = (r >> 4) * 2 + (c >> 5), rr = r & 15, cc = c & 31, ob = rr * 64 + cc * 2; return st * 1024 + (ob ^ (((ob >> 9) & 1) << 5)); }
__host__ __device__ __forceinline__ void stage_rc(int b, int& R, int& C) { const int st = b / 1024, sb = b % 1024, swz = sb ^ (((sb >> 9) & 1) << 5); R = (st >> 1) * 16 + swz / 64; C = (st & 1) * 32 + (swz % 64) / 2; }
__host__ __device__ __forceinline__ int perm32(int rho) { const int n = rho >> 4, i = rho & 15; return 8 * (i >> 2) + 4 * n + (i & 3); }

struct Unit { int pm, pn; };
struct Gemm { const bf16_t* A; const bf16_t* Bt; int M, N, K; };

struct StaticOrder {
    int nM, nN, nwg, G, c;
    __host__ __device__ void init(int M, int N, int G_, int c_) { nM = M / BM; nN = N / BM; nwg = nM * nN; G = G_; c = c_; }
    __host__ __device__ bool next(int i, Unit& u) const {
        const long L = (long)i * G + c; if (L >= nwg) return false;
        int wgid = (int)L; { const int q = nwg / NXCD, r = nwg % NXCD, xcd = wgid % NXCD, off = wgid / NXCD; wgid = (xcd < r ? xcd * (q + 1) : r * (q + 1) + (xcd - r) * q) + off; }
        const int nig = WGM * nN, gid = wgid / nig, fm = gid * WGM, gsz = (nM - fm) < WGM ? (nM - fm) : WGM;
        u.pm = fm + ((wgid % nig) % gsz); u.pn = (wgid % nig) / gsz; return true;
    }
    __device__ __forceinline__ void a_ready(const Unit&) const {}
    __device__ __forceinline__ void done(const Unit&) const {}
};

__device__ __forceinline__ unsigned cvt_pk_bf16(float lo, float hi) { unsigned r; asm volatile("v_cvt_pk_bf16_f32 %0, %1, %2" : "=v"(r) : "v"(lo), "v"(hi)); return r; }
typedef float f32x2 __attribute__((ext_vector_type(2)));
typedef unsigned u32x2 __attribute__((ext_vector_type(2)));
constexpr int ROWS_P = 16384;
constexpr int MODSTRIDE = 12288;
__device__ __forceinline__ int batch_of_row(int row) { return row < ROWS_P ? (row >> 13) : 2 + ((row - ROWS_P) >> 12); }

struct EpiStoreBf16 {
    static constexpr bool PERM = true, PERMA = false, AFTER_DRAIN = false, HAS_MID = false;
    bf16_t* O; int ldc;
    __device__ __forceinline__ void operator()(const f32x4 (&acc)[2][2][4][2], const Unit& u, int wr, int wc, int fr_, int fq_) const {
        int fr = fr_, fq = fq_; asm volatile("" : "+v"(fr), "+v"(fq));
        const int row0 = u.pm * BM + wr * 64 + fr, col0 = u.pn * BM + wc * 32 + 8 * fq;
#pragma unroll
        for (int ai = 0; ai < 2; ++ai)
#pragma unroll
            for (int m = 0; m < 4; ++m) { bf16_t* rowp = O + (size_t)(row0 + ai * HALF + m * 16) * ldc + col0;
#pragma unroll
                for (int bj = 0; bj < 2; ++bj) { const f32x4 v0 = acc[ai][bj][m][0], v1 = acc[ai][bj][m][1];
                    u32x4 w; w.x = cvt_pk_bf16(v0[0], v0[1]); w.y = cvt_pk_bf16(v0[2], v0[3]); w.z = cvt_pk_bf16(v1[0], v1[1]); w.w = cvt_pk_bf16(v1[2], v1[3]);
                    *(u32x4*)(rowp + bj * HALF) = w; } }
    }
};
struct EpiResid {
    static constexpr bool PERM = false, PERMA = false, AFTER_DRAIN = false, HAS_MID = false;
    const float* base_p; const float* base_s; float* out; const float* gate; int row_off;
    __device__ __forceinline__ void operator()(const f32x4 (&acc)[2][2][4][2], const Unit& u, int wr, int wc, int fr_, int fq_) const {
        int fr = fr_, fq = fq_; asm volatile("" : "+v"(fr), "+v"(fq));
        const int grow0 = row_off + u.pm * BM; const int b = batch_of_row(grow0);
        const float* g = gate + (size_t)b * MODSTRIDE;
        const float* bt = grow0 < ROWS_P ? base_p + (size_t)grow0 * 2048 : base_s + (size_t)(grow0 - ROWS_P) * 2048;
        float* ot = out + (size_t)grow0 * 2048;
        const int col0 = u.pn * BM + wc * 32 + 4 * fq;
        f32x4 gv[2][2];
#pragma unroll
        for (int bj = 0; bj < 2; ++bj)
#pragma unroll
            for (int n = 0; n < 2; ++n) gv[bj][n] = *(const f32x4*)(g + col0 + bj * HALF + n * 16);
#pragma unroll
        for (int ai = 0; ai < 2; ++ai)
#pragma unroll
            for (int m = 0; m < 4; ++m) { const size_t off = (size_t)(wr * 64 + fr + ai * HALF + m * 16) * 2048 + col0;
#pragma unroll
                for (int bj = 0; bj < 2; ++bj)
#pragma unroll
                    for (int n = 0; n < 2; ++n) { const f32x4 bs = *(const f32x4*)(bt + off + bj * HALF + n * 16);
                        *(f32x4*)(ot + off + bj * HALF + n * 16) = bs + gv[bj][n] * acc[ai][bj][m][n]; }
                asm volatile("" ::: "memory"); }
    }
};
struct EpiStoreBf16N {
    static constexpr bool PERM = true, PERMA = false, AFTER_DRAIN = false, HAS_MID = false;
    bf16_t* O; int ldc; const float* rstd; const float* bias;
    __device__ __forceinline__ void operator()(const f32x4 (&acc)[2][2][4][2], const Unit& u, int wr, int wc, int fr_, int fq_) const {
        int fr = fr_, fq = fq_; asm volatile("" : "+v"(fr), "+v"(fq));
        const int row0 = u.pm * BM + wr * 64 + fr, col0 = u.pn * BM + wc * 32 + 8 * fq;
        const float* bp = bias + (size_t)batch_of_row(u.pm * BM) * ldc + col0;
        f32x4 bv[2][2];
#pragma unroll
        for (int bj = 0; bj < 2; ++bj)
#pragma unroll
            for (int n = 0; n < 2; ++n) bv[bj][n] = *(const f32x4*)(bp + bj * HALF + 4 * n);
#pragma unroll
        for (int ai = 0; ai < 2; ++ai)
#pragma unroll
            for (int m = 0; m < 4; ++m) { const int r = row0 + ai * HALF + m * 16; const float rs = rstd[r]; bf16_t* rowp = O + (size_t)r * ldc + col0;
#pragma unroll
                for (int bj = 0; bj < 2; ++bj) { const f32x4 v0 = acc[ai][bj][m][0] * rs + bv[bj][0], v1 = acc[ai][bj][m][1] * rs + bv[bj][1];
                    u32x4 w; w.x = cvt_pk_bf16(v0[0], v0[1]); w.y = cvt_pk_bf16(v0[2], v0[3]); w.z = cvt_pk_bf16(v1[0], v1[1]); w.w = cvt_pk_bf16(v1[2], v1[3]);
                    *(u32x4*)(rowp + bj * HALF) = w; } }
    }
};
template <bool MID> struct EpiResid2 {
    static constexpr bool PERM = true, PERMA = false, AFTER_DRAIN = false, HAS_MID = MID;
    _Float16* XR; float* out32; const float* gate; const float* gm; bf16_t* XG; float* SSQ; const float* ratio; const float* s2;
    __device__ __forceinline__ void mid(f32x4 (&acc)[2][2][4][2], const Unit& u, int wr, int fr) const {
        unsigned z_ = 0u; asm volatile("" : "+v"(z_)); const int fq = (int)__builtin_amdgcn_mbcnt_hi(~0u, __builtin_amdgcn_mbcnt_lo(~0u, z_)) >> 4, base = u.pm * BM + wr * 64 + fr + (fq >> 1) * HALF + (fq & 1) * 32;
        const float v0 = ratio[base], v1 = ratio[base + 16];
#pragma unroll
        for (int ai = 0; ai < 2; ++ai)
#pragma unroll
            for (int m = 0; m < 4; ++m) { const float r = __shfl((m & 1) ? v1 : v0, fr + 16 * (ai * 2 + (m >> 1)));
#pragma unroll
                for (int bj = 0; bj < 2; ++bj)
#pragma unroll
                    for (int n = 0; n < 2; ++n) acc[ai][bj][m][n] = acc[ai][bj][m][n] * r; }
    }
    __device__ __forceinline__ void operator()(const f32x4 (&acc)[2][2][4][2], const Unit& u, int wr, int wc, int fr_, int fq_) const {
        int fr = fr_, fq = fq_; asm volatile("" : "+v"(fr), "+v"(fq));
        typedef __attribute__((address_space(1))) const f32x4 gcf4; typedef __attribute__((address_space(1))) f32x4 gf4; typedef __attribute__((address_space(1))) u32x4 gu4; typedef _Float16 h16x8 __attribute__((ext_vector_type(8))); typedef __attribute__((address_space(1))) h16x8 gh8; typedef __attribute__((address_space(1))) const h16x8 gch8; typedef __attribute__((address_space(1))) float gf1;
        const int grow0 = u.pm * BM; const int b = batch_of_row(grow0);
        const float* g = gate + (size_t)b * MODSTRIDE;
        const size_t t0 = (size_t)grow0 * 2048;
        const int col0 = u.pn * BM + wc * 32 + 8 * fq;
        float ss[2][4], rs[2][4];
#pragma unroll
        for (int ai = 0; ai < 2; ++ai)
#pragma unroll
            for (int m = 0; m < 4; ++m) { ss[ai][m] = 0.f; rs[ai][m] = MID ? s2[grow0 + wr * 64 + fr + ai * HALF + m * 16] : 1.0f; }
#pragma unroll
        for (int bj = 0; bj < 2; ++bj) { const int co = col0 + bj * HALF;
            const f32x4 gv0 = *(gcf4*)(g + co), gv1 = *(gcf4*)(g + co + 4); f32x4 gm0 = (f32x4){0.f, 0.f, 0.f, 0.f}, gm1 = gm0; if (gm) { gm0 = *(gcf4*)(gm + (size_t)b * MODSTRIDE + co); gm1 = *(gcf4*)(gm + (size_t)b * MODSTRIDE + co + 4); }
#pragma unroll
            for (int ai = 0; ai < 2; ++ai) { h16x8 raw[4];
#pragma unroll
                for (int m = 0; m < 4; ++m) raw[m] = *(gch8*)(XR + t0 + (size_t)(wr * 64 + fr + ai * HALF + m * 16) * 2048 + co);
#pragma unroll
                for (int m = 0; m < 4; ++m) { const size_t off = t0 + (size_t)(wr * 64 + fr + ai * HALF + m * 16) * 2048 + co;
                    const f32x4 b0 = (f32x4){(float)raw[m][0], (float)raw[m][1], (float)raw[m][2], (float)raw[m][3]}, b1 = (f32x4){(float)raw[m][4], (float)raw[m][5], (float)raw[m][6], (float)raw[m][7]};
                    const f32x4 o0 = b0 + gv0 * (acc[ai][bj][m][0] * rs[ai][m]), o1 = b1 + gv1 * (acc[ai][bj][m][1] * rs[ai][m]);
                    if (out32) { *(gf4*)(out32 + off) = o0; *(gf4*)(out32 + off + 4) = o1; }
                    else { h16x8 w; w[0] = (_Float16)o0[0]; w[1] = (_Float16)o0[1]; w[2] = (_Float16)o0[2]; w[3] = (_Float16)o0[3]; w[4] = (_Float16)o1[0]; w[5] = (_Float16)o1[1]; w[6] = (_Float16)o1[2]; w[7] = (_Float16)o1[3]; *(gh8*)(XR + off) = w; }
                    if (gm) { const f32x4 x0 = o0 * gm0, x1 = o1 * gm1; ss[ai][m] += ((o0[0] * o0[0] + o0[1] * o0[1]) + (o0[2] * o0[2] + o0[3] * o0[3])) + ((o1[0] * o1[0] + o1[1] * o1[1]) + (o1[2] * o1[2] + o1[3] * o1[3]));
                        u32x4 w; w.x = cvt_pk_bf16(x0[0], x0[1]); w.y = cvt_pk_bf16(x0[2], x0[3]); w.z = cvt_pk_bf16(x1[0], x1[1]); w.w = cvt_pk_bf16(x1[2], x1[3]); *(gu4*)(XG + off) = w; } }
                asm volatile("" ::: "memory"); } }
        if (gm) {
#pragma unroll
            for (int ai = 0; ai < 2; ++ai)
#pragma unroll
                for (int m = 0; m < 4; ++m) { float s = ss[ai][m]; s += __shfl_xor(s, 16); s += __shfl_xor(s, 32); if (fq == 0) *(gf1*)(SSQ + (size_t)(grow0 + wr * 64 + fr + ai * HALF + m * 16) * 32 + u.pn * 4 + wc) = s; } }
    }
};
constexpr int GLU_BLOCKS = 802, GLU_TILES = 201;
struct GluMap {
    static constexpr bool UNIFORM = false;
    static __device__ __forceinline__ void block(int gb, int& base, int& t0, int& S) {
        if (gb < 266) { const int s = gb >= 133 ? 1 : 0; const int j = gb - 133 * s; base = s * 8192; t0 = 62 * j - 1; S = 8192; }
        else if (gb < GLU_BLOCKS) { const int g2 = gb - 266; const int s = g2 / 67, j = g2 - 67 * s; base = ROWS_P + s * 4096; t0 = 62 * j - 1; S = 4096; }
        else { base = 0; t0 = 0; S = 0; }
    }
    __device__ __forceinline__ unsigned rowq(int pm, int q, int r) const { int base, t0, S; block(4 * pm + q, base, t0, S); int t = t0 + r; t = t >= S ? S - 1 : t; t = t < 0 ? 0 : t; return (unsigned)(base + t); }
    __device__ __forceinline__ unsigned row(int pm, int R) const { int base, t0, S; block(4 * pm + (R >> 6), base, t0, S); int t = t0 + (R & 63); t = t >= S ? S - 1 : t; t = t < 0 ? 0 : t; return (unsigned)(base + t); }
};
template <int CTRL> __device__ __forceinline__ float dppf(float x) { return __builtin_bit_cast(float, __builtin_amdgcn_update_dpp(0, __builtin_bit_cast(int, x), CTRL, 0xf, 0xf, false)); }
template <int CTRL> __device__ __forceinline__ float dpp_any(float x) { return __builtin_bit_cast(float, __builtin_amdgcn_mov_dpp(__builtin_bit_cast(int, x), CTRL, 0xf, 0xf, false)); }
template <int CTRL> __device__ __forceinline__ float dpp_keep(float old, float x) { return __builtin_bit_cast(float, __builtin_amdgcn_update_dpp(__builtin_bit_cast(int, old), __builtin_bit_cast(int, x), CTRL, 0xf, 0xf, false)); }
typedef float f32x2 __attribute__((ext_vector_type(2)));
struct GeluK { f32x2 c0, c1, one;
    __device__ __forceinline__ GeluK() { c0 = (f32x2){-2.302208198f * 0.044715f, -2.302208198f * 0.044715f}; c1 = (f32x2){-2.302208198f, -2.302208198f}; one = (f32x2){1.0f, 1.0f}; asm volatile("" : "+v"(c0), "+v"(c1), "+v"(one)); } };
__device__ __forceinline__ f32x2 gelu_tanh_2(f32x2 x, const GeluK& k) {
    const f32x2 p = (x * x) * k.c0 + k.c1; const f32x2 a = x * p; f32x2 e; e.x = __builtin_amdgcn_exp2f(a.x); e.y = __builtin_amdgcn_exp2f(a.y);
    const f32x2 d = e + k.one; f32x2 r; r.x = __builtin_amdgcn_rcpf(d.x); r.y = __builtin_amdgcn_rcpf(d.y);
    return x * r;
}
__device__ __forceinline__ f32x4 gelu_tanh_4(f32x4 x, const GeluK& k) { const f32x2 lo = gelu_tanh_2((f32x2){x[0], x[1]}, k), hi = gelu_tanh_2((f32x2){x[2], x[3]}, k); return (f32x4){lo.x, lo.y, hi.x, hi.y}; }
__device__ __forceinline__ float gelu_tanh_f(float x) {
    const float u = x * (1.0f + 0.044715f * x * x); const float e = __builtin_amdgcn_exp2f(-2.302208198f * u);
    return x * __builtin_amdgcn_rcpf(1.0f + e);
}
struct EpiGLU {
    static constexpr bool PERM = true, PERMA = false, AFTER_DRAIN = false, HAS_MID = false;
    bf16_t* act; const float* cw; const float* cb;
    const float* rstd; const float* bias;
    __device__ __forceinline__ void operator()(const f32x4 (&acc)[2][2][4][2], const Unit& u, int wr, int wc, int fr_, int fq_) const {
        int fr = fr_, fq = fq_; asm volatile("" : "+v"(fr), "+v"(fq));
        const int c0 = u.pn * HALF + wc * 32 + 8 * fq;
        f32x4 w0[2], w1[2], w2[2], bb[2];
#pragma unroll
        for (int n = 0; n < 2; ++n) { w0[n] = *(const f32x4*)(cw + c0 + 4 * n); w1[n] = *(const f32x4*)(cw + 6144 + c0 + 4 * n); w2[n] = *(const f32x4*)(cw + 2 * 6144 + c0 + 4 * n); bb[n] = *(const f32x4*)(cb + c0 + 4 * n); }
#pragma unroll
        for (int ai = 0; ai < 2; ++ai) {
            int base, t0, S; GluMap::block(4 * u.pm + 2 * ai + wr, base, t0, S);
            f32x4 gt[4][2], bg[2], bu[2]; float rs[4];
            { const float* bp = bias + (size_t)batch_of_row(base) * 12288 + u.pn * BM + wc * 32 + 8 * fq;
#pragma unroll
              for (int n = 0; n < 2; ++n) { bg[n] = *(const f32x4*)(bp + 4 * n); bu[n] = *(const f32x4*)(bp + HALF + 4 * n); } }
#pragma unroll
            for (int m = 0; m < 4; ++m) { const int tok = t0 + 16 * m + fr; const bool in = tok >= 0 && tok < S; int tc = tok >= S ? S - 1 : tok; tc = tc < 0 ? 0 : tc; rs[m] = rstd[base + tc];
#pragma unroll
                for (int n = 0; n < 2; ++n) gt[m][n] = in ? acc[ai][0][m][n] * rs[m] + bg[n] : (f32x4){0.f, 0.f, 0.f, 0.f}; }
#pragma unroll
            for (int m = 0; m < 4; ++m) { const int i = 16 * m + fr, tok = t0 + i; u32x4 w;
                unsigned pk[4];
#pragma unroll
                for (int n = 0; n < 2; ++n) { f32x4 pv, nx;
#pragma unroll
                    for (int e = 0; e < 4; ++e) {
                        const float rcur = dppf<0x121>(gt[m][n][e]), rprv = dppf<0x121>(gt[m > 0 ? m - 1 : 0][n][e]);
                        const float lcur = dppf<0x12F>(gt[m][n][e]), lnxt = dppf<0x12F>(gt[m < 3 ? m + 1 : 3][n][e]);
                        pv[e] = fr == 0 ? rprv : rcur; nx[e] = fr == 15 ? lnxt : lcur; }
                    const f32x4 g = w0[n] * pv + w1[n] * gt[m][n] + w2[n] * nx + bb[n];
                    const f32x4 up = acc[ai][1][m][n] * rs[m] + bu[n];
                    const float a0 = gelu_tanh_f(g[0]) * up[0], a1 = gelu_tanh_f(g[1]) * up[1], a2 = gelu_tanh_f(g[2]) * up[2], a3 = gelu_tanh_f(g[3]) * up[3];
                    pk[2 * n] = cvt_pk_bf16(a0, a1); pk[2 * n + 1] = cvt_pk_bf16(a2, a3); }
                w.x = pk[0]; w.y = pk[1]; w.z = pk[2]; w.w = pk[3];
                if (i >= 1 && i <= 62 && tok < S) *(u32x4*)(act + (size_t)(base + tok) * 6144 + c0) = w; }
        }
    }
};

struct EpiGLU2 {
    static constexpr bool PERM = true, PERMA = true, AFTER_DRAIN = false, HAS_MID = false;
    bf16_t* act; const float* cw; const float* cb; const float* rstd; const float* bias; float* halo; PG8_LAS float* xch;
    __device__ __forceinline__ void operator()(const f32x4 (&acc)[2][2][4][2], const Unit& u, int wr, int wc, int fr_, int fq_) const {
        int fr = fr_, fq = fq_; asm volatile("" : "+v"(fr), "+v"(fq));
        const int lc = wc * 32 + 8 * fq, c0 = u.pn * HALF + lc;
        f32x4 w0[2], w1[2], w2[2], bb[2], bg[2], bu[2];
        { const float* bp = bias + (size_t)batch_of_row(u.pm * BM) * 12288 + u.pn * BM + lc;
#pragma unroll
          for (int n = 0; n < 2; ++n) { w0[n] = *(const f32x4*)(cw + c0 + 4 * n); w1[n] = *(const f32x4*)(cw + 6144 + c0 + 4 * n); w2[n] = *(const f32x4*)(cw + 2 * 6144 + c0 + 4 * n); bb[n] = *(const f32x4*)(cb + c0 + 4 * n);
              bg[n] = *(const f32x4*)(bp + 4 * n); bu[n] = *(const f32x4*)(bp + HALF + 4 * n); } }
        const GeluK GK;
        f32x4 gt[2][4][2]; float rs[2][4];
#pragma unroll
        for (int ai = 0; ai < 2; ++ai)
#pragma unroll
            for (int m = 0; m < 4; ++m) { rs[ai][m] = rstd[u.pm * BM + ai * HALF + wr * 64 + 4 * fr + m];
#pragma unroll
                for (int n = 0; n < 2; ++n) gt[ai][m][n] = acc[ai][0][m][n] * rs[ai][m] + bg[n]; }
#pragma unroll
        for (int ai = 0; ai < 2; ++ai) { const int blk = 2 * ai + wr;
#pragma unroll
            for (int n = 0; n < 2; ++n) { if (fr == 0) *(PG8_LAS f32x4*)(xch + (blk * 2 + 0) * HALF + lc + 4 * n) = gt[ai][0][n]; if (fr == 15) *(PG8_LAS f32x4*)(xch + (blk * 2 + 1) * HALF + lc + 4 * n) = gt[ai][3][n]; } }
        asm volatile("s_waitcnt lgkmcnt(0)" ::: "memory"); __builtin_amdgcn_s_barrier(); asm volatile("" ::: "memory");
#pragma unroll
        for (int ai = 0; ai < 2; ++ai) { const int blk = 2 * ai + wr; f32x4 pvb[2], nxb[2];
#pragma unroll
            for (int n = 0; n < 2; ++n) { pvb[n] = *(const PG8_LAS f32x4*)(xch + ((blk > 0 ? blk - 1 : 0) * 2 + 1) * HALF + lc + 4 * n); nxb[n] = *(const PG8_LAS f32x4*)(xch + ((blk < 3 ? blk + 1 : 3) * 2 + 0) * HALF + lc + 4 * n); }
#pragma unroll
            for (int m = 0; m < 4; ++m) { const int i = 4 * fr + m; u32x4 w; unsigned pk[4]; f32x4 upv[2];
#pragma unroll
                for (int n = 0; n < 2; ++n) { f32x4 pv, nx;
#pragma unroll
                    for (int e = 0; e < 4; ++e) {
                        pv[e] = m > 0 ? gt[ai][m > 0 ? m - 1 : 0][n][e] : dpp_keep<0x111>(pvb[n][e], gt[ai][3][n][e]);
                        nx[e] = m < 3 ? gt[ai][m < 3 ? m + 1 : 3][n][e] : dpp_keep<0x101>(nxb[n][e], gt[ai][0][n][e]); }
                    const f32x4 g = w2[n] * nx + (w1[n] * gt[ai][m][n] + (w0[n] * pv + bb[n]));
                    upv[n] = acc[ai][1][m][n] * rs[ai][m] + bu[n];
                    const f32x4 av = gelu_tanh_4(g, GK) * upv[n];
                    pk[2 * n] = cvt_pk_bf16(av[0], av[1]); pk[2 * n + 1] = cvt_pk_bf16(av[2], av[3]); }
                w.x = pk[0]; w.y = pk[1]; w.z = pk[2]; w.w = pk[3];
                const int trow = 64 * blk + i;
                __builtin_nontemporal_store(w, (u32x4*)(act + (size_t)(u.pm * BM + trow) * 6144 + c0));
                if ((ai == 0 && m < 2) || (ai == 1 && m >= 2)) {
                    if (ai == 0 ? (wr == 0 && fr == 0) : (wr == 1 && fr == 15)) { float* hp = halo + ((size_t)u.pm * 6 + m) * 6144 + c0; *(f32x4*)hp = gt[ai][m][0]; *(f32x4*)(hp + 4) = gt[ai][m][1];
                        if (m == 0 || m == 3) { float* hu = halo + ((size_t)u.pm * 6 + (m == 0 ? 4 : 5)) * 6144 + c0; *(f32x4*)hu = upv[0]; *(f32x4*)(hu + 4) = upv[1]; } } } }
        }
    }
};
struct IdentMap { static constexpr bool UNIFORM = true; __device__ __forceinline__ unsigned row(int pm, int R) const { return (unsigned)(pm * BM + R); } __device__ __forceinline__ unsigned rowq(int pm, int q, int r) const { return (unsigned)(pm * BM + 64 * q + r); } };
template <class Epi, class Sched, class AMap>
__device__ __forceinline__ void gemm_phase(PG8_LAS unsigned char* lds, const Gemm g, const Sched& S, const Epi& E, const AMap& AM, int wave) {
    unsigned z_ = 0u; asm volatile("" : "+v"(z_)); const int ln_ = (int)__builtin_amdgcn_mbcnt_hi(~0u, __builtin_amdgcn_mbcnt_lo(~0u, z_)); const int tid_ = wave * 64 + ln_;
    const int tid = tid_, wid = wave, lane = ln_, wr = wid >> 2, wc = wid & 3, fr = lane & 15, fq = lane >> 4;
    const int K = g.K, nt = K / BK;
    int RA[2], CA[2]; unsigned voffB[2], voffA[2];
#pragma unroll
    for (int i = 0; i < 2; ++i) { int R, C; stage_rc(tid * 16 + i * 8192, R, C); const int Rb = Epi::PERM ? ((R & ~31) + perm32(R & 31)) : R; const int Ra = Epi::PERMA ? ((R & ~63) + 4 * (R & 15) + ((R & 63) >> 4)) : R; RA[i] = R; CA[i] = C; voffA[i] = (unsigned)(Ra * K + C) * 2u; voffB[i] = (unsigned)(Rb * K + C) * 2u; }
    const size_t kstep = (size_t)(BK * 2);
    const size_t qstep = (size_t)64 * K * 2;
    const size_t hstep = (size_t)HALF * K * 2;
    const size_t tstep = 2 * hstep;
    const unsigned ldsw = (unsigned)wid * 1024u;
    const int aoff = lds_byte(wr * 64 + fr, fq * 8), boff = lds_byte(wc * 32 + fr, fq * 8);
#define PG8_SA(b, h) (((b) * 2 + (h)) * HTB)
#define PG8_SB(b, h) ((4 + (b) * 2 + (h)) * HTB)
#define PG8_STAGE(bufoff, gbase, voff) do { _Pragma("unroll") for (int _i = 0; _i < 2; ++_i) \
        __builtin_amdgcn_global_load_lds((const unsigned*)((const char*)(gbase) + (size_t)_i * qstep + (voff)[0]), (PG8_LAS unsigned*)(lds + (bufoff) + ldsw + _i * 8192), 16, 0, 0); } while (0)
#define PG8_LDA(dst, b, h) do { _Pragma("unroll") for (int m = 0; m < 4; ++m) _Pragma("unroll") for (int k = 0; k < 2; ++k) dst[m][k] = *(const PG8_LAS bf16x8*)(lds + PG8_SA(b, h) + aoff + m * 2048 + k * 1024); } while (0)
#define PG8_LDB(dst, b, h) do { _Pragma("unroll") for (int n = 0; n < 2; ++n) _Pragma("unroll") for (int k = 0; k < 2; ++k) dst[n][k] = *(const PG8_LAS bf16x8*)(lds + PG8_SB(b, h) + boff + n * 2048 + k * 1024); } while (0)
#define PG8_MMA(ai, bj, At, Bt) do { __builtin_amdgcn_s_setprio(1); _Pragma("unroll") for (int m = 0; m < 4; ++m) _Pragma("unroll") for (int n = 0; n < 2; ++n) _Pragma("unroll") for (int k = 0; k < 2; ++k) \
        acc[ai][bj][m][n] = __builtin_amdgcn_mfma_f32_16x16x32_bf16(Bt[n][k], At[m][k], acc[ai][bj][m][n], 0, 0, 0); __builtin_amdgcn_s_setprio(0); } while (0)
#define PG8_WAIT_V(n) asm volatile("s_waitcnt vmcnt(" #n ")" ::: "memory")
#define PG8_WAIT_L(n) asm volatile("s_waitcnt lgkmcnt(" #n ")" ::: "memory")
#define PG8_BAR __builtin_amdgcn_s_barrier()
#define PG8_SCHED __builtin_amdgcn_sched_barrier(0)
#define PG8_STAGE_A(bufoff, kb, h, NX) do { if constexpr (AMap::UNIFORM) { const char* _b = ((NX) ? nA : cA) + (kb) + (h) * hstep; PG8_STAGE(bufoff, _b, voffA); } \
        else { unsigned _o[2]; _o[0] = (NX) ? offN[h][0] : offC[h][0]; _o[1] = (NX) ? offN[h][1] : offC[h][1]; PG8_STAGE(bufoff, Ab + (kb), _o); } } while (0)
#define PG8_OFFS(dst, pm) do { _Pragma("unroll") for (int _h = 0; _h < 2; ++_h) _Pragma("unroll") for (int _i = 0; _i < 2; ++_i) dst[_h][_i] = (AM.rowq((pm), 2 * _h + _i, RA[_i] & 63) * (unsigned)K + (unsigned)CA[_i]) * 2u; } while (0)
    Unit cur, nxt; int ui = 0;
    if (!S.next(0, cur)) return;
    f32x4 acc[2][2][4][2];
#pragma unroll
    for (int a = 0; a < 2; ++a)
#pragma unroll
        for (int b = 0; b < 2; ++b)
#pragma unroll
            for (int m = 0; m < 4; ++m)
#pragma unroll
                for (int n = 0; n < 2; ++n) acc[a][b][m][n] = (f32x4){0.f, 0.f, 0.f, 0.f};
    bf16x8 At[4][2], B0[2][2], B1[2][2];
    unsigned offC[2][2], offN[2][2];
    if constexpr (!AMap::UNIFORM) { PG8_OFFS(offC, cur.pm); }
    const char* const Ab = (const char*)g.A;
    const char* cA = (const char*)g.A + (size_t)cur.pm * tstep; const char* nA = cA;
    const char* cB = (const char*)g.Bt + (size_t)cur.pn * tstep;
    S.a_ready(cur);
    PG8_STAGE(PG8_SB(0, 0), cB, voffB); PG8_STAGE(PG8_SB(0, 1), cB + hstep, voffB); PG8_STAGE_A(PG8_SA(0, 0), 0, 0, false); PG8_STAGE_A(PG8_SA(0, 1), 0, 1, false);
    if (wr == 1) PG8_BAR;
    PG8_WAIT_V(2); PG8_BAR;
    PG8_STAGE(PG8_SB(1, 0), cB + kstep, voffB); PG8_STAGE_A(PG8_SA(1, 0), kstep, 0, false); PG8_STAGE(PG8_SB(1, 1), cB + hstep + kstep, voffB);
    PG8_WAIT_V(6); PG8_BAR;
    for (;;) {
        const bool has_next = S.next(ui + 1, nxt);
        const char* nB = has_next ? (const char*)g.Bt + (size_t)nxt.pn * tstep : cB;
        if constexpr (AMap::UNIFORM) { nA = has_next ? (const char*)g.A + (size_t)nxt.pm * tstep : cA; }
        else { if (has_next) { PG8_OFFS(offN, nxt.pm); } else {
#pragma unroll
            for (int _h = 0; _h < 2; ++_h)
#pragma unroll
                for (int _i = 0; _i < 2; ++_i) offN[_h][_i] = offC[_h][_i]; } }
        for (int t = 0; t < nt; t += 2) {
            const bool last = (t == nt - 2);
            const size_t k1 = (size_t)(t + 1) * kstep, k2 = last ? (size_t)0 : (size_t)(t + 2) * kstep, k3 = k2 + kstep;
            const char* b2 = last ? nB : cB + (size_t)(t + 2) * kstep; const char* b3 = b2 + kstep;
            if (last && has_next) S.a_ready(nxt);
            if constexpr (Epi::HAS_MID) { if (t == nt / 2) E.mid(acc, cur, wr, fr); }
            PG8_LDB(B0, 0, 0); PG8_LDB(B1, 0, 1); PG8_SCHED; PG8_LDA(At, 0, 0); PG8_STAGE_A(PG8_SA(1, 1), k1, 1, false);
            PG8_WAIT_V(8); PG8_WAIT_L(0); PG8_BAR; PG8_MMA(0, 0, At, B0); PG8_MMA(0, 1, At, B1); PG8_BAR; PG8_SCHED;
            PG8_LDA(At, 0, 1); PG8_STAGE(PG8_SB(0, 0), b2, voffB); PG8_STAGE(PG8_SB(0, 1), b2 + hstep, voffB); PG8_STAGE_A(PG8_SA(0, 0), k2, 0, last);
            PG8_WAIT_V(8); PG8_WAIT_L(0); PG8_BAR; PG8_MMA(1, 0, At, B0); PG8_MMA(1, 1, At, B1); PG8_BAR; PG8_SCHED;
            PG8_LDB(B0, 1, 0); PG8_LDB(B1, 1, 1); PG8_SCHED; PG8_LDA(At, 1, 0); PG8_STAGE_A(PG8_SA(0, 1), k2, 1, last);
            PG8_WAIT_V(8); PG8_WAIT_L(0); PG8_BAR; PG8_MMA(0, 0, At, B0); PG8_MMA(0, 1, At, B1); PG8_BAR; PG8_SCHED;
            PG8_LDA(At, 1, 1); PG8_STAGE(PG8_SB(1, 0), b3, voffB); PG8_STAGE(PG8_SB(1, 1), b3 + hstep, voffB); PG8_STAGE_A(PG8_SA(1, 0), k3, 0, last);
            PG8_WAIT_V(8); PG8_WAIT_L(0); PG8_BAR; PG8_MMA(1, 0, At, B0); PG8_MMA(1, 1, At, B1); PG8_BAR; PG8_SCHED;
        }
        if (wr == 0) PG8_BAR;
        E(acc, cur, wr, wc, fr, fq); S.done(cur);
        if (!has_next) break;
#pragma unroll
        for (int a = 0; a < 2; ++a)
#pragma unroll
            for (int b = 0; b < 2; ++b)
#pragma unroll
                for (int m = 0; m < 4; ++m)
#pragma unroll
                    for (int n = 0; n < 2; ++n) acc[a][b][m][n] = (f32x4){0.f, 0.f, 0.f, 0.f};
        cur = nxt; cB = nB; cA = nA; ++ui;
        if constexpr (!AMap::UNIFORM) {
#pragma unroll
        for (int _h = 0; _h < 2; ++_h)
#pragma unroll
            for (int _i = 0; _i < 2; ++_i) offC[_h][_i] = offN[_h][_i]; }
        if (wr == 1) PG8_BAR;
    }
    PG8_WAIT_V(0);
    PG8_BAR;
#undef PG8_SA
#undef PG8_SB
#undef PG8_STAGE
#undef PG8_LDA
#undef PG8_LDB
#undef PG8_MMA
#undef PG8_WAIT_V
#undef PG8_WAIT_L
#undef PG8_BAR
#undef PG8_SCHED
#undef PG8_OFFS
#undef PG8_STAGE_A
}
}

#define LAS __attribute__((address_space(3)))
typedef unsigned short bf16_t;
typedef float f32x4 __attribute__((ext_vector_type(4)));
typedef float f32x2 __attribute__((ext_vector_type(2)));
typedef unsigned u32x4 __attribute__((ext_vector_type(4)));
typedef unsigned u32x2 __attribute__((ext_vector_type(2)));
typedef short bf16x8 __attribute__((ext_vector_type(8)));
typedef short s16x4 __attribute__((ext_vector_type(4)));
constexpr int D = 2048, T = 49152, ROWS_P = 16384, NB = 10, DEPTH = 4;
constexpr int ZC = 3584, ZQ = 0, ZK = 1024, ZV = 1280, ZX = 1536, ZY = 2560;
constexpr int DFF = 6144, MODSTRIDE = 12288;
constexpr float EPS = 1e-6f;
constexpr size_t MiB = 1u << 20;
constexpr size_t WS_CTL = 0, CTL_ZERO_BYTES = 64 * 1024, WS_MOD = 1 * MiB, WS_SUM = 3 * MiB  , WS_CAR = 9 * MiB  , WS_LW = 12 * MiB  ,
                 WS_WIN = 16 * MiB, WS_WOUT = 72 * MiB, WS_WGU = 104 * MiB, WS_WDN = 296 * MiB, WS_H = 392 * MiB, WS_Z = 584 * MiB,
                 WS_ATT = 920 * MiB, WS_LRU = 1016 * MiB, WS_AB = 1112 * MiB, WS_LC = 1112 * MiB  ,
                 WS_SSQX = 1496 * MiB  , WS_SSQA = 1502 * MiB  , WS_SSQL = 1503 * MiB + 512 * 1024, WS_RSTD = 1505 * MiB, WS_RATIO = 1505 * MiB + 256 * 1024, WS_S2 = 1505 * MiB + 512 * 1024,
                 WS_BIN = 1506 * MiB  , WS_BGU = 1507 * MiB  , WS_END = 1510 * MiB;
constexpr size_t WS_XR = 1160 * MiB;
constexpr size_t WS_HALO = 1352 * MiB;
constexpr size_t WS_MRG = WS_ATT;
constexpr size_t WS_LSP = 3 * MiB - 65536;
constexpr size_t WS_ACT = WS_Z;
constexpr size_t WS_GUC = WS_Z, WS_ACTC = WS_Z + 192 * MiB;
static_assert(WS_ACT + (size_t)T * DFF * 2 <= WS_XR && WS_XR + (size_t)T * D * 2 <= WS_HALO && WS_HALO + (size_t)192 * 6 * DFF * 4 <= WS_SSQX, "act overlay / residual stream / halo");
constexpr int LDS_BYTES = 147456, LDS_CTL = LDS_BYTES - 256;
constexpr int NWAVES = 8;
constexpr int CW_BAR = 1024;

__device__ __forceinline__ void rowinfo(int row, int& b, int& t, int& S) { if (row < ROWS_P) { b = row >> 13; t = row & 8191; S = 8192; } else { const int r = row - ROWS_P; b = 2 + (r >> 12); t = r & 4095; S = 4096; } }
__device__ __forceinline__ float bf2f(unsigned short u) { return __uint_as_float(((unsigned)u) << 16); }
__device__ __forceinline__ float bflo(unsigned w) { return __uint_as_float(w << 16); }
__device__ __forceinline__ float bfhi(unsigned w) { return __uint_as_float(w & 0xffff0000u); }
__device__ __forceinline__ unsigned f2bf(float f) { unsigned u = __float_as_uint(f); return (u + 0x7fffu + ((u >> 16) & 1u)) >> 16; }
__device__ __forceinline__ unsigned pk2(float lo, float hi) { return f2bf(lo) | (f2bf(hi) << 16); }
__device__ __forceinline__ float wave_sum(float v) {
#pragma unroll
    for (int o = 1; o < 64; o <<= 1) v += __shfl_xor(v, o);
    return v; }
__device__ __forceinline__ float wave_max(float v) {
#pragma unroll
    for (int o = 1; o < 64; o <<= 1) v = fmaxf(v, __shfl_xor(v, o));
    return v; }
__device__ __forceinline__ float gelu_tanh(float x) { const float u = 0.7978845608028654f * (x + 0.044715f * x * x * x); return x / (1.0f + __expf(-2.0f * u)); }
__device__ __forceinline__ float sigmoidf(float x) { return 1.0f / (1.0f + __expf(-x)); }
#define LDS_WAIT() asm volatile("s_waitcnt lgkmcnt(0)" ::: "memory")
#define VM_WAIT() asm volatile("s_waitcnt vmcnt(0)" ::: "memory")
#define WG_BAR() do { asm volatile("s_waitcnt vmcnt(0) lgkmcnt(0)" ::: "memory"); __builtin_amdgcn_s_barrier(); asm volatile("" ::: "memory"); } while (0)

__device__ __forceinline__ unsigned char* ws_now(unsigned char* p) { asm volatile("" : "+s"(p)); return p; }
__device__ __forceinline__ int lane_id() { unsigned z = 0u; asm volatile("" : "+v"(z)); return (int)__builtin_amdgcn_mbcnt_hi(~0u, __builtin_amdgcn_mbcnt_lo(~0u, z)); }
#define XB_TMO      128
#define XB_XCNT(j)  (256  + 64 * (j))
#define XB_XSUB(j)  (1280 + 64 * (j))
#define XB_XGEN(j)  (2304 + 64 * (j))
#define XB_TOP      3328
#define XB_TOPGEN   3392
#define XCD_BAR_WORDS 3456
#define XB_SPIN_CAP (1u << 18)

__device__ __forceinline__ unsigned xb_ld(unsigned* p)              { return __hip_atomic_load(p, __ATOMIC_RELAXED, __HIP_MEMORY_SCOPE_AGENT); }
__device__ __forceinline__ unsigned xb_add(unsigned* p, unsigned v) { return __hip_atomic_fetch_add(p, v, __ATOMIC_RELAXED, __HIP_MEMORY_SCOPE_AGENT); }
__device__ __forceinline__ unsigned xb_xcc_id() { return (unsigned)__builtin_amdgcn_s_getreg((3 << 11) | 20) & 0xFu; }
#define XB_SPIN(cond, bar) do { unsigned _sp = 0; while (cond) { __builtin_amdgcn_s_sleep(1); \
    if ((++_sp & 255u) == 0u) { if (xb_ld(&(bar)[XB_TMO])) break; if (_sp > XB_SPIN_CAP) { atomicAdd(&(bar)[XB_TMO], 1u); break; } } } } while (0)

struct XcdBarrier {
    unsigned* bar; unsigned x; int wv;
    volatile LAS unsigned* st;
};

__device__ __forceinline__ XcdBarrier xcd_barrier_post(unsigned* bar, volatile LAS unsigned* st, int wv) {
    XcdBarrier b; b.bar = bar; b.x = xb_xcc_id(); b.st = st; b.wv = wv;
    if (wv == 0 && lane_id() == 0) (void)xb_add(&bar[XB_XCNT(b.x)], 1u);
    return b;
}
__device__ __forceinline__ void xcd_barrier_complete(unsigned* bar, unsigned x, unsigned& nloc, unsigned& nx) {
    const unsigned G = gridDim.x * gridDim.y * gridDim.z;
    unsigned sum, cnt, mine, sp = 0u;
    for (;;) {
        sum = 0u; cnt = 0u; mine = 0u;
#pragma unroll
        for (unsigned j = 0; j < 16; ++j) { const unsigned c = xb_ld(&bar[XB_XCNT(j)]); sum += c; cnt += (c > 0u) ? 1u : 0u; mine = (j == x) ? c : mine; }
        if (sum == G) break;
        __builtin_amdgcn_s_sleep(1);
        if ((++sp & 255u) == 0u) { if (xb_ld(&bar[XB_TMO])) break; if (sp > XB_SPIN_CAP) { atomicAdd(&bar[XB_TMO], 1u); break; } }
    }
    nloc = mine > 0u ? mine : 1u; nx = cnt > 0u ? cnt : 1u;
}

__device__ __forceinline__ void xcd_barrier(const XcdBarrier& b) {
    asm volatile("s_waitcnt vmcnt(0)" ::: "memory");
    __syncthreads();
    if (b.wv == 0 && lane_id() == 0) {
        unsigned* bar = b.bar; asm volatile("" : "+s"(bar));
        __builtin_amdgcn_s_waitcnt(0);
        unsigned nloc = b.st[0], nx = b.st[1];
        if (nloc == 0u) { xcd_barrier_complete(bar, b.x, nloc, nx); b.st[0] = nloc; b.st[1] = nx; }
        const unsigned old = xb_add(&bar[XB_XSUB(b.x)], 1u);
        const unsigned gen = old / nloc;
        if (old + 1u == (gen + 1u) * nloc) {
            __builtin_amdgcn_fence(__ATOMIC_RELEASE, "agent");
            asm volatile("s_waitcnt vmcnt(0)" ::: "memory");
            const unsigned og = xb_add(&bar[XB_TOP], 1u);
            const unsigned tg = og / nx;
            if (og + 1u == (tg + 1u) * nx) xb_add(&bar[XB_TOPGEN], 1u);
            else XB_SPIN(xb_ld(&bar[XB_TOPGEN]) == tg, bar);
            __builtin_amdgcn_fence(__ATOMIC_ACQUIRE, "agent");
            xb_add(&bar[XB_XGEN(b.x)], 1u);
            asm volatile("s_waitcnt vmcnt(0)" ::: "memory");
        } else {
            XB_SPIN(xb_ld(&bar[XB_XGEN(b.x)]) == gen, bar);
            __builtin_amdgcn_fence(__ATOMIC_ACQUIRE, "agent");
            asm volatile("s_waitcnt vmcnt(0)" ::: "memory");
        }
    }
    __syncthreads();
}

struct Args { const float* in[28]; float* out; unsigned char* ws; int ph_lo, ph_hi, flags, pad; };
struct Frame {
    LAS unsigned char* lds; int tid, lane, wave, G, bid;
};
#define KAS __attribute__((address_space(4)))
__device__ __forceinline__ const KAS unsigned char* karg_base() { const KAS unsigned char* p = (const KAS unsigned char*)__builtin_amdgcn_kernarg_segment_ptr(); asm volatile("" : "+s"(p)); return p; }
__device__ __forceinline__ const float* karg_in(int k) { return *(const float* const KAS*)(karg_base() + 8 * k); }
__device__ __forceinline__ float* karg_out() { return *(float* const KAS*)(karg_base() + 8 * 28); }
__device__ __forceinline__ unsigned char* karg_ws() { return *(unsigned char* const KAS*)(karg_base() + 8 * 29); }
#define INP(k) (karg_in(k))
__device__ __forceinline__ Frame fresh(const Frame& F0) { Frame F = F0; int ln = lane_id(); asm volatile("" : "+v"(ln)); F.lane = ln; F.tid = F0.wave * 64 + ln; return F; }

__device__ __forceinline__ void p0_transpose_item(const float* W, int K, int N, bf16_t* WT, int mode, LAS float* scr, int item, int lane, const float* ks0 = nullptr, const float* ks1 = nullptr) {
    const int nblk = N / 64, kb = item / nblk, nb = item % nblk, k0 = 64 * kb, n0 = 64 * nb;
    const int drow0 = mode == 0 ? n0 : ((n0 >> 7) * 256 + (n0 & 127) + (mode == 2 ? 128 : 0));
    f32x4 v[16];
#pragma unroll
    for (int i = 0; i < 16; ++i) v[i] = *(const f32x4*)(W + (size_t)(k0 + 4 * i + (lane >> 4)) * N + n0 + 4 * (lane & 15));
#pragma unroll
    for (int i = 0; i < 16; ++i) { const int kk = 4 * i + (lane >> 4); float sc = 1.0f; if (ks0) sc = (k0 + kk < 1024 ? ks0[k0 + kk] : ks1[k0 + kk - 1024]);
        LAS float* d = scr + kk * 65 + 4 * (lane & 15); d[0] = v[i].x * sc; d[1] = v[i].y * sc; d[2] = v[i].z * sc; d[3] = v[i].w * sc; }
    LDS_WAIT(); asm volatile("" ::: "memory");
    const int c = lane & 7;
#pragma unroll
    for (int j = 0; j < 8; ++j) { const int n = (lane >> 3) + 8 * j; const LAS float* s = scr + (8 * c) * 65 + n;
        u32x4 o; o.x = pk2(s[0 * 65], s[1 * 65]); o.y = pk2(s[2 * 65], s[3 * 65]); o.z = pk2(s[4 * 65], s[5 * 65]); o.w = pk2(s[6 * 65], s[7 * 65]);
        *(u32x4*)(WT + (size_t)(drow0 + n) * K + k0 + 8 * c) = o; }
    LDS_WAIT(); asm volatile("" ::: "memory");
}
__device__ __forceinline__ void phase_prologue(const Frame& F0, const Args& a) { const Frame F = fresh(F0);
    unsigned char* ws = karg_ws();
    bf16_t* WIN = (bf16_t*)(ws + WS_WIN); bf16_t* WOUT = (bf16_t*)(ws + WS_WOUT); bf16_t* WGU = (bf16_t*)(ws + WS_WGU); bf16_t* WDN = (bf16_t*)(ws + WS_WDN);
    LAS float* scr = (LAS float*)(F.lds + F.wave * 16640);
    const int gw = F.bid * NWAVES + F.wave, NGW = F.G * NWAVES;
    constexpr int I_IN = (D / 64) * (ZC / 64), I_OUT = (D / 64) * (D / 64), I_G = (D / 64) * (DFF / 64), I_D = (DFF / 64) * (D / 64), I_L = I_IN + I_OUT + 2 * I_G + I_D;
    for (int it = gw; it < DEPTH * I_L; it += NGW) { const int l = it / I_L; int r = it - l * I_L;
        if (r < I_IN) { p0_transpose_item(INP(9) + (size_t)l * D * ZC, D, ZC, WIN + (size_t)l * ZC * D, 0, scr, r, F.lane); continue; } r -= I_IN;
        if (r < I_OUT) { p0_transpose_item(INP(22) + (size_t)l * D * D, D, D, WOUT + (size_t)l * D * D, 0, scr, r, F.lane, INP(20) + l * 1024, INP(21) + l * 1024); continue; } r -= I_OUT;
        if (r < I_G) { p0_transpose_item(INP(23) + (size_t)l * D * DFF, D, DFF, WGU + (size_t)l * 2 * DFF * D, 1, scr, r, F.lane); continue; } r -= I_G;
        if (r < I_G) { p0_transpose_item(INP(24) + (size_t)l * D * DFF, D, DFF, WGU + (size_t)l * 2 * DFF * D, 2, scr, r, F.lane); continue; } r -= I_G;
        p0_transpose_item(INP(27) + (size_t)l * DFF * D, DFF, D, WDN + (size_t)l * D * DFF, 0, scr, r, F.lane); }
    { bf16_t* LW = (bf16_t*)(ws + WS_LW);
      for (int it = gw; it < DEPTH * 8 * 8 * 16; it += NGW) { const int ks = it & 3, gs = (it >> 2) & 3, w = (it >> 4) & 7, n = (it >> 7) & 7, l = it >> 10;
          const float* src = (gs < 2 ? INP(15) : INP(17)) + ((size_t)((l * 2 + (gs & 1)) * 8 + n) * 128) * 128;
          const int c0 = 32 * ks + 8 * (F.lane >> 4), jc = 16 * w + (F.lane & 15); float v[8];
#pragma unroll
          for (int j = 0; j < 8; ++j) v[j] = src[(size_t)(c0 + j) * 128 + jc];
          u32x4 o; o.x = pk2(v[0], v[1]); o.y = pk2(v[2], v[3]); o.z = pk2(v[4], v[5]); o.w = pk2(v[6], v[7]);
          *(u32x4*)(LW + ((size_t)it * 64 + F.lane) * 8) = o; } }
    { float* LSP = (float*)(ws + WS_LSP); for (int i = F.bid * 512 + F.tid; i < DEPTH * 2048; i += F.G * 512) LSP[i] = log1pf(expf(-INP(19)[i])); }
    WG_BAR();
    { LAS float* cs = (LAS float*)F.lds; LAS float* red = (LAS float*)(F.lds + 81920); float* MOD = (float*)(ws + WS_MOD);
      const float* c_p = INP(2); const float* c_s = INP(3); const float* w_mod = INP(5); const float* b_mod = INP(6); const float* n1g = INP(7); const float* n2g = INP(8);
      for (int i = F.tid; i < NB * D; i += 512) { const int b = i >> 11, k = i & 2047; const float c = b < 2 ? c_p[b * D + k] : c_s[(b - 2) * D + k]; cs[i] = c / (1.0f + __expf(-c)); }
      WG_BAR();
      for (int item = F.bid; item < DEPTH * 192; item += F.G) { const int l = item / 192, col0 = (item % 192) * 64, w = F.wave, lane = F.lane;
          float acc[NB];
#pragma unroll
          for (int b = 0; b < NB; ++b) acc[b] = 0.f;
          const float* W = w_mod + (size_t)l * D * MODSTRIDE + col0 + lane;
          for (int k0 = 256 * w; k0 < 256 * w + 256; k0 += 16) { float wv[16];
#pragma unroll
              for (int j = 0; j < 16; ++j) wv[j] = W[(size_t)(k0 + j) * MODSTRIDE];
#pragma unroll
              for (int j4 = 0; j4 < 4; ++j4)
#pragma unroll
                  for (int b = 0; b < NB; ++b) { const f32x4 c4 = *(const LAS f32x4*)(cs + b * D + k0 + 4 * j4); acc[b] += (c4.x * wv[4 * j4] + c4.y * wv[4 * j4 + 1]) + (c4.z * wv[4 * j4 + 2] + c4.w * wv[4 * j4 + 3]); } }
#pragma unroll
          for (int b = 0; b < NB; ++b) red[(w * NB + b) * 64 + lane] = acc[b];
          WG_BAR();
          for (int i = F.tid; i < NB * 64; i += 512) { const int b = i >> 6, cc = i & 63, col = col0 + cc; float s = b_mod[l * MODSTRIDE + col];
#pragma unroll
              for (int ww = 0; ww < 8; ++ww) s += red[(ww * NB + b) * 64 + cc];
              const int slot = col >> 11, c = col & 2047;
              if (slot == 1) s = n1g[l * D + c] * (1.0f + s); else if (slot == 4) s = n2g[l * D + c] * (1.0f + s);
              MOD[((size_t)l * NB + b) * MODSTRIDE + col] = s; }
          WG_BAR(); } }
}

__device__ __forceinline__ void phase_norm0(const Frame& F0, const float* x_p, const float* x_s, const float* mod0, bf16_t* XG, float* RSTD, _Float16* XR) { const Frame F = fresh(F0);
    const int gw = F.bid * NWAVES + F.wave, NGW = F.G * NWAVES, lane = F.lane;
    for (int row = gw; row < T; row += NGW) { const int b = row < ROWS_P ? (row >> 13) : 2 + ((row - ROWS_P) >> 12);
        const float* xr = row < ROWS_P ? x_p + (size_t)row * D : x_s + (size_t)(row - ROWS_P) * D; const float* gm = mod0 + (size_t)b * MODSTRIDE + D;
        f32x4 v[8]; float ss = 0.f;
#pragma unroll
        for (int j = 0; j < 8; ++j) { v[j] = ((const f32x4*)xr)[lane + 64 * j]; ss += (v[j].x * v[j].x + v[j].y * v[j].y) + (v[j].z * v[j].z + v[j].w * v[j].w); }
        ss = wave_sum(ss); if (lane == 0) RSTD[row] = rsqrtf(ss * (1.0f / D) + EPS);
#pragma unroll
        for (int j = 0; j < 8; ++j) { const f32x4 g = ((const f32x4*)gm)[lane + 64 * j]; const f32x4 o = v[j] * g; u32x2 p; p.x = pk2(o.x, o.y); p.y = pk2(o.z, o.w); ((u32x2*)(XG + (size_t)row * D))[lane + 64 * j] = p;
            typedef _Float16 h16x4 __attribute__((ext_vector_type(4))); h16x4 q; q[0] = (_Float16)v[j].x; q[1] = (_Float16)v[j].y; q[2] = (_Float16)v[j].z; q[3] = (_Float16)v[j].w; ((h16x4*)(XR + (size_t)row * D))[lane + 64 * j] = q; } }
}
__device__ __forceinline__ void phase_rstd(const Frame& F0, int mode, const float* SSQX, float* RSTD, const float* SSQA, const float* SSQL, float* RATIO, float* S2) { const Frame F = fresh(F0);
    for (int row = F.bid * 512 + F.tid; row < T; row += F.G * 512) {
        if (mode == 0) { const f32x4* p = (const f32x4*)(SSQX + (size_t)row * 32); f32x4 s = p[0];
#pragma unroll
            for (int j = 1; j < 8; ++j) s += p[j];
            RSTD[row] = rsqrtf(((s.x + s.y) + (s.z + s.w)) * (1.0f / D) + EPS); }
        else { const f32x4* pa = (const f32x4*)(SSQA + (size_t)row * 8); const f32x4* pl = (const f32x4*)(SSQL + (size_t)row * 8); const f32x4 a = pa[0] + pa[1], l = pl[0] + pl[1];
            const float s1 = rsqrtf(((a.x + a.y) + (a.z + a.w)) * (1.0f / 1024.0f) + EPS), s2 = rsqrtf(((l.x + l.y) + (l.z + l.w)) * (1.0f / 1024.0f) + EPS);
            RATIO[row] = s1 / s2; S2[row] = s2; } }
}
__device__ __forceinline__ void phase_bias(const Frame& F0, const float* MOD, const bf16_t* WIN, const bf16_t* WGU, float* BIN, float* BGU) { const Frame F = fresh(F0);
    const int fr = F.lane & 15, fq = F.lane >> 4;
    constexpr int T_IN = ZC / 16, T_GU = 2 * DFF / 16, T_L = T_IN + T_GU;
    for (int tile = F.bid * NWAVES + F.wave; tile < DEPTH * T_L; tile += F.G * NWAVES) { const int l = tile / T_L; int r = tile - l * T_L; const int which = r >= T_IN ? 1 : 0; if (which) r -= T_IN;
        const int N = which ? 2 * DFF : ZC, n0 = 16 * r;
        const bf16_t* wp = (which ? WGU + (size_t)l * 2 * DFF * D : WIN + (size_t)l * ZC * D) + (size_t)(n0 + fr) * D + 8 * fq;
        const float* sp = MOD + ((size_t)l * NB + (fr < NB ? fr : 0)) * MODSTRIDE + (which ? 3 : 0) * D + 8 * fq;
        f32x4 acc = (f32x4){0.f, 0.f, 0.f, 0.f};
#pragma unroll 4
        for (int ks = 0; ks < D / 32; ++ks) { const bf16x8 af = *(const bf16x8*)(wp + 32 * ks); f32x4 s0 = *(const f32x4*)(sp + 32 * ks), s1 = *(const f32x4*)(sp + 32 * ks + 4);
            if (fr >= NB) { s0 = (f32x4){0.f, 0.f, 0.f, 0.f}; s1 = s0; }
            unsigned hi[4], lo[4]; const float sv[8] = {s0.x, s0.y, s0.z, s0.w, s1.x, s1.y, s1.z, s1.w};
#pragma unroll
            for (int j = 0; j < 4; ++j) { const unsigned h0 = f2bf(sv[2 * j]), h1 = f2bf(sv[2 * j + 1]); hi[j] = h0 | (h1 << 16); lo[j] = pk2(sv[2 * j] - __uint_as_float(h0 << 16), sv[2 * j + 1] - __uint_as_float(h1 << 16)); }
            const u32x4 hv = (u32x4){hi[0], hi[1], hi[2], hi[3]}, lv = (u32x4){lo[0], lo[1], lo[2], lo[3]};
            acc = __builtin_amdgcn_mfma_f32_16x16x32_bf16(af, __builtin_bit_cast(bf16x8, hv), acc, 0, 0, 0); acc = __builtin_amdgcn_mfma_f32_16x16x32_bf16(af, __builtin_bit_cast(bf16x8, lv), acc, 0, 0, 0); }
        if (fr < NB) { float* bp = (which ? BGU + (size_t)l * NB * 2 * DFF : BIN + (size_t)l * NB * ZC) + (size_t)fr * N + n0 + 4 * fq; *(f32x4*)bp = acc; }
    }
}

constexpr int AT_ROW = 272, AT_BUF = 2 * 64 * AT_ROW + 256  , AT_KS = 0, AT_VS = 64 * AT_ROW, AT_RSK = 2 * 64 * AT_ROW, AT_BIAS = 2 * AT_BUF, AT_GQ = AT_BIAS + 8 * 384 * 4;
static_assert(AT_GQ + 512 <= LDS_CTL, "attention LDS map");
constexpr float LOG2E = 1.4426950408889634f;
__device__ __forceinline__ int t5_bucket(int rel) { const int n = rel < 0 ? -rel : rel; int v; if (n < 8) v = n; else { v = (31 - __clz(n * n)) + 2; v = v > 15 ? 15 : v; } return (rel > 0 ? 16 : 0) + v; }
__device__ __forceinline__ s16x4 lds_tr16(LAS unsigned char* p) { typedef short v4i16_t __attribute__((ext_vector_type(4))); return __builtin_bit_cast(s16x4, __builtin_amdgcn_ds_read_tr16_b64_v4i16((LAS v4i16_t*)p)); }
__device__ __forceinline__ void phase_attn(const Frame& F0, const bf16_t* Z, const float* qg, const float* kg, const float* sink, const float* relb, bf16_t* MRG, float* SSQA) { const Frame F = fresh(F0);
    LAS unsigned char* lds = F.lds; const int tid = F.tid, lane = F.lane, w = F.wave, fr = lane & 15, fq = lane >> 4, g = w & 3, hq = w >> 2;
    LAS float* bias = (LAS float*)(lds + AT_BIAS);
    for (int i = tid; i < 8 * 384; i += 512) { const int h = i / 384, rel = i - 384 * h - 192; bias[i] = (rel >= -128 && rel <= 128) ? relb[t5_bucket(rel) * 8 + h] * LOG2E - 12.0f : -1e30f; }
    LAS float* gqt = (LAS float*)(lds + AT_GQ);
    if (tid < 128) gqt[tid] = qg[tid] * kg[tid];
    WG_BAR();
    const int p0 = tid, p1 = tid + 512;
    const int per_x = ((T / 64) * 2 + 7) / 8, slots = F.G / 8;
    for (int it_ = F.bid >> 3; it_ < per_x; it_ += slots) { const int item = (F.bid & 7) * per_x + it_; if (item >= (T / 64) * 2) break;
        const int qb = item >> 1, kvh = item & 1, q0 = qb * 64, h = kvh * 4 + g; int b_, t0, S; rowinfo(q0, b_, t0, S); const int seq0 = q0 - t0;
        bf16x8 Qf[2][4];
#pragma unroll
        for (int qt = 0; qt < 2; ++qt) { const bf16_t* qp = Z + (size_t)(q0 + 32 * hq + 16 * qt + fr) * ZC + ZQ + h * 128 + 8 * fq; u32x4 raw[4]; float ss = 0.f;
#pragma unroll
            for (int ks = 0; ks < 4; ++ks) { raw[ks] = *(const u32x4*)(qp + 32 * ks); const unsigned rw[4] = {raw[ks].x, raw[ks].y, raw[ks].z, raw[ks].w};
#pragma unroll
                for (int e = 0; e < 4; ++e) { const float a0 = bflo(rw[e]), a1 = bfhi(rw[e]); ss += a0 * a0 + a1 * a1; } }
            ss += __shfl_xor(ss, 16); ss += __shfl_xor(ss, 32);
            const float rs = rsqrtf(ss * (1.0f / 128.0f) + EPS) * (0.08838834764831845f * LOG2E);
#pragma unroll
            for (int ks = 0; ks < 4; ++ks) { const unsigned rw[4] = {raw[ks].x, raw[ks].y, raw[ks].z, raw[ks].w}; u32x4 o;
                const f32x4 g0 = *(const LAS f32x4*)(gqt + 32 * ks + 8 * fq), g1 = *(const LAS f32x4*)(gqt + 32 * ks + 8 * fq + 4);
                o.x = pg8::cvt_pk_bf16(bflo(rw[0]) * rs * g0[0], bfhi(rw[0]) * rs * g0[1]); o.y = pg8::cvt_pk_bf16(bflo(rw[1]) * rs * g0[2], bfhi(rw[1]) * rs * g0[3]);
                o.z = pg8::cvt_pk_bf16(bflo(rw[2]) * rs * g1[0], bfhi(rw[2]) * rs * g1[1]); o.w = pg8::cvt_pk_bf16(bflo(rw[3]) * rs * g1[2], bfhi(rw[3]) * rs * g1[3]);
                Qf[qt][ks] = __builtin_bit_cast(bf16x8, o); } }
        f32x4 O[8][2];
#pragma unroll
        for (int dt = 0; dt < 8; ++dt) { O[dt][0] = (f32x4){0.f, 0.f, 0.f, 0.f}; O[dt][1] = (f32x4){0.f, 0.f, 0.f, 0.f}; }
        float lsum[2] = {0.f, 0.f};
        const int c_lo = t0 >= 128 ? 0 : (128 - t0) / 64, c_hi = (t0 + 192 <= S) ? 4 : 4 - (t0 + 192 - S) / 64;
        u32x4 kr[2], vr[2];
#define AT_FETCH(c) do { const size_t rb = (size_t)(seq0 + t0 - 128 + 64 * (c)); \
          kr[0] = *(const u32x4*)(Z + (rb + (p0 >> 4)) * ZC + ZK + kvh * 128 + 8 * (p0 & 15)); kr[1] = *(const u32x4*)(Z + (rb + (p1 >> 4)) * ZC + ZK + kvh * 128 + 8 * (p1 & 15)); \
          vr[0] = *(const u32x4*)(Z + (rb + (p0 >> 4)) * ZC + ZV + kvh * 128 + 8 * (p0 & 15)); vr[1] = *(const u32x4*)(Z + (rb + (p1 >> 4)) * ZC + ZV + kvh * 128 + 8 * (p1 & 15)); } while (0)
#define AT_PARK(buf) do { LAS unsigned char* bb = lds + (buf) * AT_BUF; _Pragma("unroll") for (int i = 0; i < 2; ++i) { const int p = i ? p1 : p0, key = p >> 4, part = p & 15; \
                *(LAS u32x4*)(bb + AT_KS + key * AT_ROW + part * 16) = kr[i]; *(LAS u32x4*)(bb + AT_VS + key * AT_ROW + part * 16) = vr[i]; \
                const unsigned kw[4] = {kr[i].x, kr[i].y, kr[i].z, kr[i].w}; float ss = 0.f; \
                _Pragma("unroll") for (int e = 0; e < 4; ++e) { const float a0 = bflo(kw[e]), a1 = bfhi(kw[e]); ss += a0 * a0 + a1 * a1; } \
                ss += __shfl_xor(ss, 1); ss += __shfl_xor(ss, 2); ss += __shfl_xor(ss, 4); ss += __shfl_xor(ss, 8); \
                if (part == 0) ((LAS float*)(bb + AT_RSK))[key] = rsqrtf(ss * (1.0f / 128.0f) + EPS); } } while (0)
        AT_FETCH(c_lo);
        WG_BAR();
        AT_PARK(0);
        WG_BAR();
        for (int c = c_lo; c <= c_hi; ++c) { LAS unsigned char* bb = lds + ((c - c_lo) & 1) * AT_BUF;
            if (c < c_hi) AT_FETCH(c + 1);
            f32x4 Sx[4][2];
#pragma unroll
            for (int kt = 0; kt < 4; ++kt) { Sx[kt][0] = (f32x4){0.f, 0.f, 0.f, 0.f}; Sx[kt][1] = (f32x4){0.f, 0.f, 0.f, 0.f};
#pragma unroll
                for (int ks = 0; ks < 4; ++ks) { const bf16x8 kf = *(const LAS bf16x8*)(bb + AT_KS + (16 * kt + fr) * AT_ROW + (32 * ks + 8 * fq) * 2);
                    Sx[kt][0] = __builtin_amdgcn_mfma_f32_16x16x32_bf16(kf, Qf[0][ks], Sx[kt][0], 0, 0, 0); Sx[kt][1] = __builtin_amdgcn_mfma_f32_16x16x32_bf16(kf, Qf[1][ks], Sx[kt][1], 0, 0, 0); } }
            bf16x8 Pf[2][2];
            f32x4 rk[4];
#pragma unroll
            for (int kt = 0; kt < 4; ++kt) rk[kt] = *(const LAS f32x4*)(bb + AT_RSK + (16 * kt + 4 * fq) * 4);
#pragma unroll
            for (int qt = 0; qt < 2; ++qt) { float pv[4][4]; const LAS float* bp = bias + h * 384 + 64 * c + 64 + 4 * fq - (32 * hq + 16 * qt + fr);
#pragma unroll
                for (int kt = 0; kt < 4; ++kt)
#pragma unroll
                    for (int i = 0; i < 4; ++i) { const float p = __builtin_amdgcn_exp2f(Sx[kt][qt][i] * rk[kt][i] + bp[16 * kt + i]); pv[kt][i] = p; lsum[qt] += p; }
#pragma unroll
                for (int s = 0; s < 2; ++s) { u32x4 o; o.x = pg8::cvt_pk_bf16(pv[2 * s][0], pv[2 * s][1]); o.y = pg8::cvt_pk_bf16(pv[2 * s][2], pv[2 * s][3]); o.z = pg8::cvt_pk_bf16(pv[2 * s + 1][0], pv[2 * s + 1][1]); o.w = pg8::cvt_pk_bf16(pv[2 * s + 1][2], pv[2 * s + 1][3]);
                    Pf[qt][s] = __builtin_bit_cast(bf16x8, o); } }
#pragma unroll
            for (int dt = 0; dt < 8; ++dt)
#pragma unroll
                for (int s = 0; s < 2; ++s) { LAS unsigned char* vb = bb + AT_VS + (32 * s + 4 * fq + (fr >> 2)) * AT_ROW + (16 * dt + 4 * (fr & 3)) * 2;
                    const s16x4 lo = lds_tr16(vb), hi = lds_tr16(vb + 16 * AT_ROW);
                    const bf16x8 vf = (bf16x8){lo[0], lo[1], lo[2], lo[3], hi[0], hi[1], hi[2], hi[3]};
                    O[dt][0] = __builtin_amdgcn_mfma_f32_16x16x32_bf16(vf, Pf[0][s], O[dt][0], 0, 0, 0); O[dt][1] = __builtin_amdgcn_mfma_f32_16x16x32_bf16(vf, Pf[1][s], O[dt][1], 0, 0, 0); }
            if (c < c_hi) { AT_PARK(((c - c_lo) & 1) ^ 1); WG_BAR(); }
        }
#undef AT_FETCH
#undef AT_PARK
        const float sk = __builtin_amdgcn_exp2f(sink[h] * LOG2E - 12.0f);
#pragma unroll
        for (int qt = 0; qt < 2; ++qt) { float l = lsum[qt]; l += __shfl_xor(l, 16); l += __shfl_xor(l, 32); const float inv = 1.0f / (l + sk);
            const int row = q0 + 32 * hq + 16 * qt + fr; bf16_t* op = MRG + (size_t)row * D + h * 128 + 4 * fq; float ss = 0.f;
#pragma unroll
            for (int dt = 0; dt < 8; ++dt) { u32x2 o; o.x = pg8::cvt_pk_bf16(O[dt][qt][0] * inv, O[dt][qt][1] * inv); o.y = pg8::cvt_pk_bf16(O[dt][qt][2] * inv, O[dt][qt][3] * inv); *(u32x2*)(op + 16 * dt) = o;
                const float e0 = bflo(o.x), e1 = bfhi(o.x), e2 = bflo(o.y), e3 = bfhi(o.y); ss += (e0 * e0 + e1 * e1) + (e2 * e2 + e3 * e3); }
            ss += __shfl_xor(ss, 16); ss += __shfl_xor(ss, 32); if (fq == 0) SSQA[(size_t)row * 8 + h] = ss; }
    }
    WG_BAR();
}

constexpr int LR_HF = 0, LR_HF_ROW = 528, LR_XCB = 67584, LR_YG = 102656, LR_YG_ROW = 272, LR_END = 137472;
static_assert(LR_END <= LDS_CTL, "LRU LDS map");
__device__ __forceinline__ int xcb_off(int tok) { return tok * 272 + (tok >> 5) * 64; }
struct LruConsts { float ba_f, ba_b, bx_f, bx_b, sp_f, sp_b; };
__device__ __forceinline__ void lru_fetch_xr(const Frame& F, const bf16_t* Z, int row0, int n, unsigned (&xr)[19]) {
    const int cp = F.tid & 63, tg = F.tid >> 6, ch = 128 * n + 2 * cp; int b_, t0, S; rowinfo(row0, b_, t0, S);
#pragma unroll
    for (int i = 0; i < 19; ++i) { const int tt = t0 + 16 * tg - 2 + i; unsigned v = 0u; if (tt >= 0 && tt < S) v = *(const unsigned*)(Z + (size_t)(row0 + 16 * tg - 2 + i) * ZC + ZX + ch); xr[i] = v; }
}
__device__ __forceinline__ void lru_park_xc(const Frame& F, const float* cw, const float* cb, int n, const unsigned (&xr)[19]) {
    const int cp = F.tid & 63, tg = F.tid >> 6, ch = 128 * n + 2 * cp;
    const float w00 = cw[ch], w01 = cw[ch + 1], w10 = cw[1024 + ch], w11 = cw[1024 + ch + 1], w20 = cw[2048 + ch], w21 = cw[2048 + ch + 1], w30 = cw[3072 + ch], w31 = cw[3072 + ch + 1], b0 = cb[ch], b1 = cb[ch + 1];
#pragma unroll
    for (int i = 0; i < 16; ++i) { const float y0 = b0 + w00 * bflo(xr[i]) + w10 * bflo(xr[i + 1]) + w20 * bflo(xr[i + 2]) + w30 * bflo(xr[i + 3]), y1 = b1 + w01 * bfhi(xr[i]) + w11 * bfhi(xr[i + 1]) + w21 * bfhi(xr[i + 2]) + w31 * bfhi(xr[i + 3]);
        const int tk = 16 * tg + i; *(LAS unsigned*)(F.lds + LR_XCB + xcb_off(tk) + 4 * cp) = pk2(y0, y1); }
}
typedef _Float16 f16x8 __attribute__((ext_vector_type(8)));
__device__ __forceinline__ void lru_ab2(f32x2 ga, f32x2 gx, f32x2 xc, float ba, float bx, float sp, f32x2& la, f32x2& a, f32x2& b) {
    const f32x2 ta = (ga + ba) * (-LOG2E), tx = (gx + bx) * (-LOG2E);
    f32x2 da, dx; da.x = 1.0f + __builtin_amdgcn_exp2f(ta.x); da.y = 1.0f + __builtin_amdgcn_exp2f(ta.y); dx.x = 1.0f + __builtin_amdgcn_exp2f(tx.x); dx.y = 1.0f + __builtin_amdgcn_exp2f(tx.y);
    const f32x2 dd = da * dx; f32x2 rc; rc.x = __builtin_amdgcn_rcpf(dd.x); rc.y = __builtin_amdgcn_rcpf(dd.y);
    const f32x2 r = dx * rc, ig = da * rc;
    la = r * (-8.0f * sp);
    const f32x2 tl = la * LOG2E; a.x = __builtin_amdgcn_exp2f(tl.x); a.y = __builtin_amdgcn_exp2f(tl.y);
    const f32x2 x2 = la * 2.0f;
    const f32x2 ser = -x2 * (1.0f + x2 * (0.5f + x2 * 0.16666667f)), alt = (1.0f - a) * (1.0f + a);
    f32x2 om; om.x = x2.x > -0.25f ? ser.x : alt.x; om.y = x2.y > -0.25f ? ser.y : alt.y;
    f32x2 sq; sq.x = __builtin_amdgcn_sqrtf(om.x); sq.y = __builtin_amdgcn_sqrtf(om.y);
    b = sq * ig * xc;
}
__device__ __forceinline__ void lru_load_w(const bf16_t* LWl, int n, int w, int lane, int gs, bf16x8 (&Wf)[4]) {
    int lo = lane * 8; asm volatile("" : "+v"(lo));
#pragma unroll
    for (int ks = 0; ks < 4; ++ks) Wf[ks] = *(const bf16x8*)(LWl + (size_t)(((n * 8 + w) * 4 + gs) * 4 + ks) * 512 + lo);
}
__device__ __forceinline__ LruConsts lru_consts(const float* b_a, const float* b_x, const float* lam, int ch) {
    LruConsts c; c.ba_f = b_a[ch]; c.ba_b = b_a[1024 + ch]; c.bx_f = b_x[ch]; c.bx_b = b_x[1024 + ch]; c.sp_f = lam[ch]; c.sp_b = lam[1024 + ch]; return c;
}
__device__ __forceinline__ void phase_lru1(const Frame& F0, const bf16_t* Z, const bf16_t* LWl, const float* cw, const float* cb, const float* b_a, const float* b_x, const float* lam, float* SUM, f16x8* LC) { const Frame F = fresh(F0);
    const int lane = F.lane, w = F.wave, fr = lane & 15, fq = lane >> 4, n = F.bid & 7, ch = 128 * n + 16 * w + fr;
    bf16x8 Waf[4], Wab[4], Wxf[4], Wxb[4]; lru_load_w(LWl, n, w, lane, 0, Waf); lru_load_w(LWl, n, w, lane, 1, Wab); lru_load_w(LWl, n, w, lane, 2, Wxf); lru_load_w(LWl, n, w, lane, 3, Wxb);
    const LruConsts C = lru_consts(b_a, b_x, lam, ch);
    const int arow = 32 * (fr >> 2) + (fr & 3);
    unsigned xr[19];
    if (F.bid < (T / 128) * 8) lru_fetch_xr(F, Z, (F.bid >> 3) * 128, n, xr);
    for (int item = F.bid; item < (T / 128) * 8; item += F.G) { const int chunk = item >> 3;
        WG_BAR(); lru_park_xc(F, cw, cb, n, xr);
        if (item + F.G < (T / 128) * 8) lru_fetch_xr(F, Z, ((item + F.G) >> 3) * 128, n, xr);
        asm volatile("s_waitcnt lgkmcnt(0)" ::: "memory"); __builtin_amdgcn_s_barrier(); asm volatile("" ::: "memory");
        float RAf = 1.f, RBf = 0.f, RAb = 1.f, RBb = 0.f;
#pragma unroll 2
        for (int tau = 0; tau < 8; ++tau) {
            f32x4 gaf = (f32x4){0.f, 0.f, 0.f, 0.f}, gab = gaf, gxf = gaf, gxb = gaf;
#pragma unroll
            for (int ks = 0; ks < 4; ++ks) { const bf16x8 af = *(const LAS bf16x8*)(F.lds + LR_XCB + xcb_off(arow + 4 * tau) + (32 * ks + 8 * fq) * 2);
                gaf = __builtin_amdgcn_mfma_f32_16x16x32_bf16(af, Waf[ks], gaf, 0, 0, 0); gab = __builtin_amdgcn_mfma_f32_16x16x32_bf16(af, Wab[ks], gab, 0, 0, 0);
                gxf = __builtin_amdgcn_mfma_f32_16x16x32_bf16(af, Wxf[ks], gxf, 0, 0, 0); gxb = __builtin_amdgcn_mfma_f32_16x16x32_bf16(af, Wxb[ks], gxb, 0, 0, 0); }
            float xc[4];
#pragma unroll
            for (int i = 0; i < 4; ++i) xc[i] = bf2f(*(const LAS bf16_t*)(F.lds + LR_XCB + xcb_off(32 * fq + 4 * tau + i) + (16 * w + fr) * 2));
            f16x8 cf, cbk;
#pragma unroll
            for (int p = 0; p < 2; ++p) { f32x2 la, a, b; const f32x2 x = (f32x2){xc[2 * p], xc[2 * p + 1]};
                lru_ab2((f32x2){gaf[2 * p], gaf[2 * p + 1]}, (f32x2){gxf[2 * p], gxf[2 * p + 1]}, x, C.ba_f, C.bx_f, C.sp_f, la, a, b);
                RBf = a.x * RBf + b.x; RAf = a.x * RAf; RBf = a.y * RBf + b.y; RAf = a.y * RAf;
                cf[4 * p] = (_Float16)la.x; cf[4 * p + 1] = (_Float16)b.x; cf[4 * p + 2] = (_Float16)la.y; cf[4 * p + 3] = (_Float16)b.y;
                lru_ab2((f32x2){gab[2 * p], gab[2 * p + 1]}, (f32x2){gxb[2 * p], gxb[2 * p + 1]}, x, C.ba_b, C.bx_b, C.sp_b, la, a, b);
                RBb = RAb * b.x + RBb; RAb = RAb * a.x; RBb = RAb * b.y + RBb; RAb = RAb * a.y;
                cbk[4 * p] = (_Float16)la.x; cbk[4 * p + 1] = (_Float16)b.x; cbk[4 * p + 2] = (_Float16)la.y; cbk[4 * p + 3] = (_Float16)b.y; }
            f16x8* cp = LC + ((size_t)(item * 8 + w) * 16 + tau) * 64 + lane;
            __builtin_nontemporal_store(cf, cp); __builtin_nontemporal_store(cbk, cp + 8 * 64); }
#pragma unroll
        for (int st = 0; st < 2; ++st) { const int o = 16 << st; const bool early = ((fq >> st) & 1) == 0;
            const float pAf = __shfl_xor(RAf, o), pBf = __shfl_xor(RBf, o), pAb = __shfl_xor(RAb, o), pBb = __shfl_xor(RBb, o);
            const float XAf = early ? RAf : pAf, XBf = early ? RBf : pBf, YAf = early ? pAf : RAf, YBf = early ? pBf : RBf;
            const float XAb = early ? RAb : pAb, XBb = early ? RBb : pBb, YAb = early ? pAb : RAb, YBb = early ? pBb : RBb;
            RAf = YAf * XAf; RBf = YAf * XBf + YBf; RAb = XAb * YAb; RBb = XAb * YBb + XBb; }
        if (fq == 0) { float* s = SUM + (size_t)chunk * 4096 + ch; s[0] = RAf; s[1024] = RBf; s[2048] = RAb; s[3072] = RBb; }
    }
    WG_BAR();
}
__device__ __forceinline__ void phase_lru_carry(const Frame& F0, const float* SUM, float* CAR) { const Frame F = fresh(F0);
    for (int id = F.bid * 512 + F.tid; id < NB * 2048; id += F.G * 512) { const int s = id >> 11, dir = (id >> 10) & 1, ch = id & 1023;
        const int c0 = s < 2 ? 64 * s : 128 + 32 * (s - 2), nc = s < 2 ? 64 : 32; float h = 0.f;
        for (int j0 = 0; j0 < nc; j0 += 8) { float A[8], B[8];
#pragma unroll
            for (int k = 0; k < 8; ++k) { const int j = dir == 0 ? j0 + k : nc - 1 - (j0 + k); const size_t o = (size_t)(c0 + j) * 4096 + (dir ? 2048 : 0) + ch; A[k] = SUM[o]; B[k] = SUM[o + 1024]; }
#pragma unroll
            for (int k = 0; k < 8; ++k) { const int j = dir == 0 ? j0 + k : nc - 1 - (j0 + k); CAR[(size_t)(c0 + j) * 2048 + (dir ? 1024 : 0) + ch] = h; h = A[k] * h + B[k]; } } }
}
__device__ __forceinline__ void lru_unpack_ab(const f16x8 (&c)[8], float (&a)[32], float (&b)[32]) {
#pragma unroll
    for (int tau = 0; tau < 8; ++tau)
#pragma unroll
        for (int i = 0; i < 4; ++i) { a[4 * tau + i] = __builtin_amdgcn_exp2f((float)c[tau][2 * i] * LOG2E); b[4 * tau + i] = (float)c[tau][2 * i + 1]; }
}
__device__ __forceinline__ void phase_lru2(const Frame& F0, const bf16_t* Z, const f16x8* LC, const float* CAR, bf16_t* MRG, float* SSQL) { const Frame F = fresh(F0);
    const int lane = F.lane, w = F.wave, fr = lane & 15, fq = lane >> 4, n = F.bid & 7, ch = 128 * n + 16 * w + fr;
    constexpr int NITEM = (T / 128) * 8;
    f16x8 cf_[8], cb_[8]; float cf = 0.f, cbk = 0.f; u32x4 yv[4];
#define LR2_FETCH(it) do { const int chunk_ = (it) >> 3; const f16x8* cp_ = LC + (size_t)((it) * 8 + w) * 16 * 64 + lane; \
        _Pragma("unroll") for (int tau = 0; tau < 8; ++tau) { cf_[tau] = __builtin_nontemporal_load(cp_ + tau * 64); cb_[tau] = __builtin_nontemporal_load(cp_ + (8 + tau) * 64); } \
        cf = CAR[(size_t)chunk_ * 2048 + ch]; cbk = CAR[(size_t)chunk_ * 2048 + 1024 + ch]; \
        _Pragma("unroll") for (int i = 0; i < 4; ++i) { const int p = F.tid + 512 * i, tk = p >> 4, part = p & 15; yv[i] = *(const u32x4*)(Z + (size_t)(chunk_ * 128 + tk) * ZC + ZY + 128 * n + 8 * part); } } while (0)
    if (F.bid < NITEM) LR2_FETCH(F.bid);
    for (int item = F.bid; item < NITEM; item += F.G) { const int chunk = item >> 3, row0 = chunk * 128;
        WG_BAR();
#pragma unroll
        for (int i = 0; i < 4; ++i) { const int p = F.tid + 512 * i, tk = p >> 4, part = p & 15; *(LAS u32x4*)(F.lds + LR_YG + tk * LR_YG_ROW + part * 16) = yv[i]; }
        float a[32], b[32], hf[32]; const float cfw = cf, cbw = cbk;
        lru_unpack_ab(cf_, a, b);
        { float IA = 1.f, IB = 0.f;
#pragma unroll
          for (int t = 0; t < 32; ++t) { IB = a[t] * IB + b[t]; IA = a[t] * IA; }
          { const float xA = __shfl_up(IA, 16), xB = __shfl_up(IB, 16); if (fq >= 1) { IB = IA * xB + IB; IA = IA * xA; } }
          { const float xA = __shfl_up(IA, 32), xB = __shfl_up(IB, 32); if (fq >= 2) { IB = IA * xB + IB; IA = IA * xA; } }
          float EA = __shfl_up(IA, 16), EB = __shfl_up(IB, 16); if (fq == 0) { EA = 1.f; EB = 0.f; }
          float h = EA * cfw + EB;
#pragma unroll
          for (int t = 0; t < 32; ++t) { h = a[t] * h + b[t]; hf[t] = h; } }
        lru_unpack_ab(cb_, a, b);
        if (item + F.G < NITEM) LR2_FETCH(item + F.G);
        asm volatile("s_waitcnt lgkmcnt(0)" ::: "memory"); __builtin_amdgcn_s_barrier(); asm volatile("" ::: "memory");
        { float IA = 1.f, IB = 0.f;
#pragma unroll
          for (int t = 31; t >= 0; --t) { IB = a[t] * IB + b[t]; IA = a[t] * IA; }
          { const float xA = __shfl_down(IA, 16), xB = __shfl_down(IB, 16); if (fq <= 2) { IB = IA * xB + IB; IA = IA * xA; } }
          { const float xA = __shfl_down(IA, 32), xB = __shfl_down(IB, 32); if (fq <= 1) { IB = IA * xB + IB; IA = IA * xA; } }
          float EA = __shfl_down(IA, 16), EB = __shfl_down(IB, 16); if (fq == 3) { EA = 1.f; EB = 0.f; }
          float h = EA * cbw + EB;
#pragma unroll
          for (int t = 31; t >= 0; --t) { h = a[t] * h + b[t]; LAS bf16_t* yp = (LAS bf16_t*)(F.lds + LR_YG + (32 * fq + t) * LR_YG_ROW + (16 * w + fr) * 2);
              *yp = (bf16_t)f2bf((hf[t] + h) * pg8::gelu_tanh_f(bf2f(*yp))); if ((t & 7) == 0) __builtin_amdgcn_sched_barrier(0); } }
        asm volatile("s_waitcnt lgkmcnt(0)" ::: "memory"); __builtin_amdgcn_s_barrier(); asm volatile("" ::: "memory");
#pragma unroll
        for (int i = 0; i < 4; ++i) { const int p = F.tid + 512 * i, tk = p >> 4, part = p & 15; const u32x4 v = *(const LAS u32x4*)(F.lds + LR_YG + tk * LR_YG_ROW + part * 16);
            *(u32x4*)(MRG + (size_t)(row0 + tk) * D + 1024 + 128 * n + 8 * part) = v;
            float ss = (bflo(v.x) * bflo(v.x) + bfhi(v.x) * bfhi(v.x)) + (bflo(v.y) * bflo(v.y) + bfhi(v.y) * bfhi(v.y)) + (bflo(v.z) * bflo(v.z) + bfhi(v.z) * bfhi(v.z)) + (bflo(v.w) * bflo(v.w) + bfhi(v.w) * bfhi(v.w));
            ss += __shfl_xor(ss, 1); ss += __shfl_xor(ss, 2); ss += __shfl_xor(ss, 4); ss += __shfl_xor(ss, 8); if (part == 0) SSQL[(size_t)(row0 + tk) * 8 + n] = ss; }
    }
#undef LR2_FETCH
    WG_BAR();
}

__device__ __forceinline__ void phase_glu_fix(const Frame& F0, const float* HALO, const float* cw, const float* cb, bf16_t* ACT) { const Frame F = fresh(F0);
    for (int id = F.bid * 512 + F.tid; id < 384 * (DFF / 4); id += F.G * 512) { const int e = id / (DFF / 4), c = (id - e * (DFF / 4)) * 4, pm = e >> 1, side = e & 1, row = 256 * pm + (side ? 255 : 0);
        int b_, t, S; rowinfo(row, b_, t, S);
        const float* hp = HALO + (size_t)pm * 6 * DFF + c; const f32x4 z = (f32x4){0.f, 0.f, 0.f, 0.f};
        f32x4 gp, gc, gn, up;
        if (side == 0) { gp = t == 0 ? z : *(const f32x4*)(hp - 6 * DFF + 3 * DFF); gc = *(const f32x4*)(hp); gn = *(const f32x4*)(hp + DFF); up = *(const f32x4*)(hp + 4 * DFF); }
        else { gp = *(const f32x4*)(hp + 2 * DFF); gc = *(const f32x4*)(hp + 3 * DFF); gn = t == S - 1 ? z : *(const f32x4*)(hp + 6 * DFF); up = *(const f32x4*)(hp + 5 * DFF); }
        const f32x4 g = *(const f32x4*)(cw + c) * gp + *(const f32x4*)(cw + DFF + c) * gc + *(const f32x4*)(cw + 2 * DFF + c) * gn + *(const f32x4*)(cb + c);
        u32x2 o; o.x = pg8::cvt_pk_bf16(pg8::gelu_tanh_f(g[0]) * up[0], pg8::gelu_tanh_f(g[1]) * up[1]); o.y = pg8::cvt_pk_bf16(pg8::gelu_tanh_f(g[2]) * up[2], pg8::gelu_tanh_f(g[3]) * up[3]);
        *(u32x2*)(ACT + (size_t)row * DFF + c) = o; }
}

constexpr int PH_PER_LAYER = 11, PH0 = 2, N_PHASES = PH0 + DEPTH * PH_PER_LAYER;
#ifndef PHMASK
#define PHMASK 0xfff
#endif
#define PEN(k) ((PHMASK >> (k)) & 1)
#ifndef DBLMASK
#define DBLMASK 0
#endif
#define REP(k) for (int rep_ = 0; rep_ < 1 + ((DBLMASK >> (k)) & 1); ++rep_)
__global__ void __launch_bounds__(NWAVES * 64, 2) mega_fwd(Args a) {
    extern __shared__ __attribute__((aligned(16))) unsigned char lds_raw[];
    Frame F; F.lds = (LAS unsigned char*)lds_raw; F.tid = threadIdx.x; F.lane = F.tid & 63; F.wave = __builtin_amdgcn_readfirstlane(F.tid >> 6); F.G = gridDim.x; F.bid = blockIdx.x;
    unsigned char* ws = karg_ws();
    volatile LAS unsigned* MISC = (volatile LAS unsigned*)(F.lds + LDS_CTL);
    if (F.tid < 64) MISC[F.tid] = 0u;
    __syncthreads();
    const int lo = a.ph_lo, hi = a.ph_hi;
    XcdBarrier bar; bar.bar = (unsigned*)(ws + WS_CTL) + CW_BAR; bar.x = 0; bar.st = MISC; bar.wv = F.wave;
    if (hi - lo > 1) bar = xcd_barrier_post((unsigned*)(ws + WS_CTL) + CW_BAR, MISC, F.wave);
#define IN(k) (lo <= (k) && (k) < hi)
#define SEAM(k) do { if (IN(k) && IN((k) + 1)) xcd_barrier(bar); } while (0)
#define WSP(type, off) ((type*)(karg_ws() + (off)))
    PG8_LAS unsigned char* ring = (PG8_LAS unsigned char*)lds_raw;

    if (PEN(0) && IN(0)) { REP(0) phase_prologue(F, a); } SEAM(0);
    if (PEN(11) && IN(1)) { phase_bias(F, WSP(float, WS_MOD), WSP(bf16_t, WS_WIN), WSP(bf16_t, WS_WGU), WSP(float, WS_BIN), WSP(float, WS_BGU)); phase_norm0(F, karg_in(0), karg_in(1), WSP(float, WS_MOD), WSP(bf16_t, WS_H), WSP(float, WS_RSTD), WSP(_Float16, WS_XR)); } SEAM(1);
    for (int l = 0; l < DEPTH; ++l) {
        const int pb = PH0 + PH_PER_LAYER * l;
        const float* bp = l == 0 ? karg_in(0) : karg_out(); const float* bs = l == 0 ? karg_in(1) : karg_out() + (size_t)ROWS_P * D;
        if (PEN(1) && IN(pb + 0)) { if (l > 0) phase_rstd(F, 0, WSP(float, WS_SSQX), WSP(float, WS_RSTD), nullptr, nullptr, nullptr, nullptr); } SEAM(pb + 0);
        if (PEN(2) && IN(pb + 1)) { REP(2) { pg8::Gemm g{WSP(bf16_t, WS_H), WSP(bf16_t, WS_WIN) + (size_t)l * ZC * D, T, ZC, D}; pg8::StaticOrder S; S.init(T, ZC, F.G, F.bid); pg8::EpiStoreBf16N E{WSP(bf16_t, WS_Z), ZC, WSP(float, WS_RSTD), WSP(float, WS_BIN) + (size_t)l * NB * ZC};
            pg8::gemm_phase(ring, g, S, E, pg8::IdentMap{}, F.wave); } } SEAM(pb + 1);
        if (IN(pb + 2)) {
            if (PEN(3)) REP(3) phase_attn(F, WSP(bf16_t, WS_Z), karg_in(10) + l * 128, karg_in(11) + l * 128, karg_in(12) + l * 8, karg_in(4), WSP(bf16_t, WS_MRG), WSP(float, WS_SSQA));
            if (PEN(4)) REP(4) phase_lru1(F, WSP(bf16_t, WS_Z), WSP(bf16_t, WS_LW) + (size_t)l * 512 * 1024, karg_in(13) + (size_t)l * 4096, karg_in(14) + l * 1024, karg_in(16) + l * 2048, karg_in(18) + l * 2048, WSP(float, WS_LSP) + l * 2048, WSP(float, WS_SUM), (f16x8*)karg_out()); } SEAM(pb + 2);
        if (IN(pb + 3)) { if (PEN(5)) REP(5) phase_lru_carry(F, WSP(float, WS_SUM), WSP(float, WS_CAR)); } SEAM(pb + 3);
        if (IN(pb + 4)) { if (PEN(6)) REP(6) phase_lru2(F, WSP(bf16_t, WS_Z), (const f16x8*)karg_out(), WSP(float, WS_CAR), WSP(bf16_t, WS_MRG), WSP(float, WS_SSQL)); } SEAM(pb + 4);
        if (PEN(7) && IN(pb + 5)) { phase_rstd(F, 1, nullptr, nullptr, WSP(float, WS_SSQA), WSP(float, WS_SSQL), WSP(float, WS_RATIO), WSP(float, WS_S2)); } SEAM(pb + 5);
        if (PEN(8) && IN(pb + 6)) for (int rep_ = 0; rep_ < 1 + ((l == 0) ? ((DBLMASK >> 8) & 1) : 0); ++rep_) { const float* modl = WSP(float, WS_MOD) + (size_t)l * NB * MODSTRIDE; pg8::Gemm g{WSP(bf16_t, WS_MRG), WSP(bf16_t, WS_WOUT) + (size_t)l * D * D, T, D, D}; pg8::StaticOrder S; S.init(T, D, F.G, F.bid);
            pg8::EpiResid2<true> E{WSP(_Float16, WS_XR), nullptr, modl + 2 * D, modl + 4 * D, WSP(bf16_t, WS_H), WSP(float, WS_SSQX), WSP(float, WS_RATIO), WSP(float, WS_S2)}; pg8::gemm_phase(ring, g, S, E, pg8::IdentMap{}, F.wave); } SEAM(pb + 6);
        if (PEN(1) && IN(pb + 7)) { phase_rstd(F, 0, WSP(float, WS_SSQX), WSP(float, WS_RSTD), nullptr, nullptr, nullptr, nullptr); } SEAM(pb + 7);
        if (IN(pb + 8)) { if (PEN(9)) REP(9) { pg8::Gemm g{WSP(bf16_t, WS_H), WSP(bf16_t, WS_WGU) + (size_t)l * 2 * DFF * D, T, 2 * DFF, D}; pg8::StaticOrder S; S.init(T, 2 * DFF, F.G, F.bid);
            pg8::EpiGLU2 E{WSP(bf16_t, WS_ACT), karg_in(25) + (size_t)l * 3 * DFF, karg_in(26) + l * DFF, WSP(float, WS_RSTD), WSP(float, WS_BGU) + (size_t)l * NB * 2 * DFF, WSP(float, WS_HALO), (PG8_LAS float*)(ring + pg8::STAGE_BYTES)};
            pg8::gemm_phase(ring, g, S, E, pg8::IdentMap{}, F.wave); } } SEAM(pb + 8);
        if (IN(pb + 9)) { if (PEN(9)) phase_glu_fix(F, WSP(float, WS_HALO), karg_in(25) + (size_t)l * 3 * DFF, karg_in(26) + l * DFF, WSP(bf16_t, WS_ACT)); } SEAM(pb + 9);
        if (IN(pb + 10)) { if (PEN(10)) { const float* modl = WSP(float, WS_MOD) + (size_t)l * NB * MODSTRIDE; pg8::Gemm g{WSP(bf16_t, WS_ACT), WSP(bf16_t, WS_WDN) + (size_t)l * D * DFF, T, D, DFF}; pg8::StaticOrder S; S.init(T, D, F.G, F.bid);
            pg8::EpiResid2<false> E{WSP(_Float16, WS_XR), l + 1 < DEPTH ? nullptr : karg_out(), modl + 5 * D, l + 1 < DEPTH ? modl + (size_t)NB * MODSTRIDE + D : nullptr, WSP(bf16_t, WS_H), WSP(float, WS_SSQX), nullptr, nullptr};
            pg8::gemm_phase(ring, g, S, E, pg8::IdentMap{}, F.wave); } } SEAM(pb + 10);
    }
#undef IN
#undef SEAM
}
#ifndef HYB
#define HYB 0
#endif
extern "C" void kernel_launch(void* const* d_in, const int* in_sizes, int n_in, void* d_out, int out_size, void* d_ws, size_t ws_size, hipStream_t stream) {
    static int grid = 0;
    if (grid == 0) {
        if (n_in != 28 || ws_size < WS_END || out_size != T * D) { fprintf(stderr, "kernel_launch: unexpected sizes (n_in %d, ws %zu, out %d)\n", n_in, ws_size, out_size); grid = -1; return; }
        int dev = 0, cus = 0, per_cu = 0;
        if (hipGetDevice(&dev) != hipSuccess || hipDeviceGetAttribute(&cus, hipDeviceAttributeMultiprocessorCount, dev) != hipSuccess) { grid = -1; return; }
        if (hipFuncSetAttribute((const void*)mega_fwd, hipFuncAttributeMaxDynamicSharedMemorySize, LDS_BYTES) != hipSuccess) { fprintf(stderr, "kernel_launch: hipFuncSetAttribute failed\n"); grid = -1; return; }
        if (hipOccupancyMaxActiveBlocksPerMultiprocessor(&per_cu, (const void*)mega_fwd, NWAVES * 64, LDS_BYTES) != hipSuccess || per_cu < 1) { fprintf(stderr, "kernel_launch: occupancy query says %d blocks per CU\n", per_cu); grid = -1; (void)hipGetLastError(); return; }
        grid = cus & ~7;
    }
    if (grid < 0) return;
    (void)hipMemsetAsync((char*)d_ws + WS_CTL, 0, CTL_ZERO_BYTES, stream);
    Args a{};
    for (int i = 0; i < 28; ++i) a.in[i] = (const float*)d_in[i];
    a.out = (float*)d_out; a.ws = (unsigned char*)d_ws; a.flags = 0; a.pad = 0;
#if HYB & 8
    for (int p = 0; p < N_PHASES; ++p) { a.ph_lo = p; a.ph_hi = p + 1; hipLaunchKernelGGL(mega_fwd, dim3(grid), dim3(NWAVES * 64), LDS_BYTES, stream, a); }
#else
    a.ph_lo = 0; a.ph_hi = N_PHASES; hipLaunchKernelGGL(mega_fwd, dim3(grid), dim3(NWAVES * 64), LDS_BYTES, stream, a);
#endif
}
```

```cpp
#include <hip/hip_runtime.h>
#include <cstdio>
#include <cstdint>
#define HYB 0
#define DBLMASK 0

namespace pg8 {
#define PG8_LAS __attribute__((address_space(3)))
typedef unsigned short bf16_t;
typedef short bf16x8 __attribute__((ext_vector_type(8)));
typedef float f32x4 __attribute__((ext_vector_type(4)));
typedef unsigned u32x4 __attribute__((ext_vector_type(4)));
constexpr int BM = 256, BK = 64, HALF = 128, HTB = HALF * BK * 2  , STAGE_BYTES = 8 * HTB, NXCD = 8, WGM = 4;

__host__ __device__ __forceinline__ int lds_byte(int r, int c) { const int st = (r >> 4) * 2 + (c >> 5), rr = r & 15, cc = c & 31, ob = rr * 64 + cc * 2; return st * 1024 + (ob ^ (((ob >> 9) & 1) << 5)); }
__host__ __device__ __forceinline__ void stage_rc(int b, int& R, int& C) { const int st = b / 1024, sb = b % 1024, swz = sb ^ (((sb >> 9) & 1) << 5); R = (st >> 1) * 16 + swz / 64; C = (st & 1) * 32 + (swz % 64) / 2; }
__host__ __device__ __forceinline__ int perm32(int rho) { const int n = rho >> 4, i = rho & 15; return 8 * (i >> 2) + 4 * n + (i & 3); }

struct Unit { int pm, pn; };
struct Gemm { const bf16_t* A; const bf16_t* Bt; int M, N, K; };

struct StaticOrder {
    int nM, nN, nwg, G, c;
    __host__ __device__ void init(int M, int N, int G_, int c_) { nM = M / BM; nN = N / BM; nwg = nM * nN; G = G_; c = c_; }
    __host__ __device__ bool next(int i, Unit& u) const {
        const long L = (long)i * G + c; if (L >= nwg) return false;
        int wgid = (int)L; { const int q = nwg / NXCD, r = nwg % NXCD, xcd = wgid % NXCD, off = wgid / NXCD; wgid = (xcd < r ? xcd * (q + 1) : r * (q + 1) + (xcd - r) * q) + off; }
        const int nig = WGM * nN, gid = wgid / nig, fm = gid * WGM, gsz = (nM - fm) < WGM ? (nM - fm) : WGM;
        u.pm = fm + ((wgid % nig) % gsz); u.pn = (wgid % nig) / gsz; return true;
    }
    __device__ __forceinline__ void a_ready(const Unit&) const {}
    __device__ __forceinline__ void done(const Unit&) const {}
};

__device__ __forceinline__ unsigned cvt_pk_bf16(float lo, float hi) { unsigned r; asm volatile("v_cvt_pk_bf16_f32 %0, %1, %2" : "=v"(r) : "v"(lo), "v"(hi)); return r; }
typedef float f32x2 __attribute__((ext_vector_type(2)));
typedef unsigned u32x2 __attribute__((ext_vector_type(2)));
constexpr int ROWS_P = 16384;
constexpr int MODSTRIDE = 12288;
__device__ __forceinline__ int batch_of_row(int row) { return row < ROWS_P ? (row >> 13) : 2 + ((row - ROWS_P) >> 12); }

struct EpiStoreBf16 {
    static constexpr bool PERM = true, PERMA = false, AFTER_DRAIN = false, HAS_MID = false;
    bf16_t* O; int ldc;
    __device__ __forceinline__ void operator()(const f32x4 (&acc)[2][2][4][2], const Unit& u, int wr, int wc, int fr_, int fq_) const {
        int fr = fr_, fq = fq_; asm volatile("" : "+v"(fr), "+v"(fq));
        const int row0 = u.pm * BM + wr * 64 + fr, col0 = u.pn * BM + wc * 32 + 8 * fq;
#pragma unroll
        for (int ai = 0; ai < 2; ++ai)
#pragma unroll
            for (int m = 0; m < 4; ++m) { bf16_t* rowp = O + (size_t)(row0 + ai * HALF + m * 16) * ldc + col0;
#pragma unroll
                for (int bj = 0; bj < 2; ++bj) { const f32x4 v0 = acc[ai][bj][m][0], v1 = acc[ai][bj][m][1];
                    u32x4 w; w.x = cvt_pk_bf16(v0[0], v0[1]); w.y = cvt_pk_bf16(v0[2], v0[3]); w.z = cvt_pk_bf16(v1[0], v1[1]); w.w = cvt_pk_bf16(v1[2], v1[3]);
                    *(u32x4*)(rowp + bj * HALF) = w; } }
    }
};
struct EpiResid {
    static constexpr bool PERM = false, PERMA = false, AFTER_DRAIN = false, HAS_MID = false;
    const float* base_p; const float* base_s; float* out; const float* gate; int row_off;
    __device__ __forceinline__ void operator()(const f32x4 (&acc)[2][2][4][2], const Unit& u, int wr, int wc, int fr_, int fq_) const {
        int fr = fr_, fq = fq_; asm volatile("" : "+v"(fr), "+v"(fq));
        const int grow0 = row_off + u.pm * BM; const int b = batch_of_row(grow0);
        const float* g = gate + (size_t)b * MODSTRIDE;
        const float* bt = grow0 < ROWS_P ? base_p + (size_t)grow0 * 2048 : base_s + (size_t)(grow0 - ROWS_P) * 2048;
        float* ot = out + (size_t)grow0 * 2048;
        const int col0 = u.pn * BM + wc * 32 + 4 * fq;
        f32x4 gv[2][2];
#pragma unroll
        for (int bj = 0; bj < 2; ++bj)
#pragma unroll
            for (int n = 0; n < 2; ++n) gv[bj][n] = *(const f32x4*)(g + col0 + bj * HALF + n * 16);
#pragma unroll
        for (int ai = 0; ai < 2; ++ai)
#pragma unroll
            for (int m = 0; m < 4; ++m) { const size_t off = (size_t)(wr * 64 + fr + ai * HALF + m * 16) * 2048 + col0;
#pragma unroll
                for (int bj = 0; bj < 2; ++bj)
#pragma unroll
                    for (int n = 0; n < 2; ++n) { const f32x4 bs = *(const f32x4*)(bt + off + bj * HALF + n * 16);
                        *(f32x4*)(ot + off + bj * HALF + n * 16) = bs + gv[bj][n] * acc[ai][bj][m][n]; }
                asm volatile("" ::: "memory"); }
    }
};
struct EpiStoreBf16N {
    static constexpr bool PERM = true, PERMA = false, AFTER_DRAIN = false, HAS_MID = false;
    bf16_t* O; int ldc; const float* rstd; const float* bias;
    __device__ __forceinline__ void operator()(const f32x4 (&acc)[2][2][4][2], const Unit& u, int wr, int wc, int fr_, int fq_) const {
        int fr = fr_, fq = fq_; asm volatile("" : "+v"(fr), "+v"(fq));
        const int row0 = u.pm * BM + wr * 64 + fr, col0 = u.pn * BM + wc * 32 + 8 * fq;
        const float* bp = bias + (size_t)batch_of_row(u.pm * BM) * ldc + col0;
        f32x4 bv[2][2];
#pragma unroll
        for (int bj = 0; bj < 2; ++bj)
#pragma unroll
            for (int n = 0; n < 2; ++n) bv[bj][n] = *(const f32x4*)(bp + bj * HALF + 4 * n);
#pragma unroll
        for (int ai = 0; ai < 2; ++ai)
#pragma unroll
            for (int m = 0; m < 4; ++m) { const int r = row0 + ai * HALF + m * 16; const float rs = rstd[r]; bf16_t* rowp = O + (size_t)r * ldc + col0;
#pragma unroll
                for (int bj = 0; bj < 2; ++bj) { const f32x4 v0 = acc[ai][bj][m][0] * rs + bv[bj][0], v1 = acc[ai][bj][m][1] * rs + bv[bj][1];
                    u32x4 w; w.x = cvt_pk_bf16(v0[0], v0[1]); w.y = cvt_pk_bf16(v0[2], v0[3]); w.z = cvt_pk_bf16(v1[0], v1[1]); w.w = cvt_pk_bf16(v1[2], v1[3]);
                    *(u32x4*)(rowp + bj * HALF) = w; } }
    }
};
template <bool MID> struct EpiResid2 {
    static constexpr bool PERM = true, PERMA = false, AFTER_DRAIN = false, HAS_MID = MID;
    const float* gmo; float* out32; const float* gate; const float* gm; bf16_t* XG; float* SSQ; const float* ratio; const float* s2;
    __device__ __forceinline__ void mid(f32x4 (&acc)[2][2][4][2], const Unit& u, int wr, int fr) const {
        unsigned z_ = 0u; asm volatile("" : "+v"(z_)); const int fq = (int)__builtin_amdgcn_mbcnt_hi(~0u, __builtin_amdgcn_mbcnt_lo(~0u, z_)) >> 4, base = u.pm * BM + wr * 64 + fr + (fq >> 1) * HALF + (fq & 1) * 32;
        const float v0 = ratio[base], v1 = ratio[base + 16];
#pragma unroll
        for (int ai = 0; ai < 2; ++ai)
#pragma unroll
            for (int m = 0; m < 4; ++m) { const float r = __shfl((m & 1) ? v1 : v0, fr + 16 * (ai * 2 + (m >> 1)));
#pragma unroll
                for (int bj = 0; bj < 2; ++bj)
#pragma unroll
                    for (int n = 0; n < 2; ++n) acc[ai][bj][m][n] = acc[ai][bj][m][n] * r; }
    }
    __device__ __forceinline__ void operator()(const f32x4 (&acc)[2][2][4][2], const Unit& u, int wr, int wc, int fr_, int fq_) const {
        int fr = fr_, fq = fq_; asm volatile("" : "+v"(fr), "+v"(fq));
        typedef __attribute__((address_space(1))) const f32x4 gcf4; typedef __attribute__((address_space(1))) f32x4 gf4; typedef __attribute__((address_space(1))) u32x4 gu4; typedef _Float16 h16x8 __attribute__((ext_vector_type(8))); typedef __attribute__((address_space(1))) h16x8 gh8; typedef __attribute__((address_space(1))) const h16x8 gch8; typedef __attribute__((address_space(1))) float gf1;
        const int grow0 = u.pm * BM; const int b = batch_of_row(grow0);
        const float* g = gate + (size_t)b * MODSTRIDE;
        const size_t t0 = (size_t)grow0 * 2048;
        const int col0 = u.pn * BM + wc * 32 + 8 * fq;
        float ss[2][4], rs[2][4];
#pragma unroll
        for (int ai = 0; ai < 2; ++ai)
#pragma unroll
            for (int m = 0; m < 4; ++m) { ss[ai][m] = 0.f; rs[ai][m] = MID ? s2[grow0 + wr * 64 + fr + ai * HALF + m * 16] : 1.0f; }
        const float* go = gmo + (size_t)b * MODSTRIDE; typedef __attribute__((address_space(1))) const u32x4 gcu4;
#pragma unroll
        for (int bj = 0; bj < 2; ++bj) { const int co = col0 + bj * HALF;
            const f32x4 gv0 = *(gcf4*)(g + co), gv1 = *(gcf4*)(g + co + 4); f32x4 gm0 = (f32x4){0.f, 0.f, 0.f, 0.f}, gm1 = gm0; if (gm) { gm0 = *(gcf4*)(gm + (size_t)b * MODSTRIDE + co); gm1 = *(gcf4*)(gm + (size_t)b * MODSTRIDE + co + 4); }
            f32x4 ri0 = *(gcf4*)(go + co), ri1 = *(gcf4*)(go + co + 4);
#pragma unroll
            for (int q = 0; q < 4; ++q) { ri0[q] = __builtin_amdgcn_rcpf(ri0[q]); ri1[q] = __builtin_amdgcn_rcpf(ri1[q]); }
#pragma unroll
            for (int ai = 0; ai < 2; ++ai) { u32x4 raw[4];
#pragma unroll
                for (int m = 0; m < 4; ++m) raw[m] = *(gcu4*)(XG + t0 + (size_t)(wr * 64 + fr + ai * HALF + m * 16) * 2048 + co);
#pragma unroll
                for (int m = 0; m < 4; ++m) { const size_t off = t0 + (size_t)(wr * 64 + fr + ai * HALF + m * 16) * 2048 + co;
                    const f32x4 b0 = (f32x4){__uint_as_float(raw[m].x << 16), __uint_as_float(raw[m].x & 0xffff0000u), __uint_as_float(raw[m].y << 16), __uint_as_float(raw[m].y & 0xffff0000u)} * ri0;
                    const f32x4 b1 = (f32x4){__uint_as_float(raw[m].z << 16), __uint_as_float(raw[m].z & 0xffff0000u), __uint_as_float(raw[m].w << 16), __uint_as_float(raw[m].w & 0xffff0000u)} * ri1;
                    const f32x4 o0 = b0 + gv0 * (acc[ai][bj][m][0] * rs[ai][m]), o1 = b1 + gv1 * (acc[ai][bj][m][1] * rs[ai][m]);
                    if (out32) { *(gf4*)(out32 + off) = o0; *(gf4*)(out32 + off + 4) = o1; }
                    if (gm) { const f32x4 x0 = o0 * gm0, x1 = o1 * gm1; ss[ai][m] += ((o0[0] * o0[0] + o0[1] * o0[1]) + (o0[2] * o0[2] + o0[3] * o0[3])) + ((o1[0] * o1[0] + o1[1] * o1[1]) + (o1[2] * o1[2] + o1[3] * o1[3]));
                        u32x4 w; w.x = cvt_pk_bf16(x0[0], x0[1]); w.y = cvt_pk_bf16(x0[2], x0[3]); w.z = cvt_pk_bf16(x1[0], x1[1]); w.w = cvt_pk_bf16(x1[2], x1[3]); *(gu4*)(XG + off) = w; } }
                asm volatile("" ::: "memory"); } }
        if (gm) {
#pragma unroll
            for (int ai = 0; ai < 2; ++ai)
#pragma unroll
                for (int m = 0; m < 4; ++m) { float s = ss[ai][m]; s += __shfl_xor(s, 16); s += __shfl_xor(s, 32); if (fq == 0) *(gf1*)(SSQ + (size_t)(grow0 + wr * 64 + fr + ai * HALF + m * 16) * 32 + u.pn * 4 + wc) = s; } }
    }
};
constexpr int GLU_BLOCKS = 802, GLU_TILES = 201;
struct GluMap {
    static constexpr bool UNIFORM = false;
    static __device__ __forceinline__ void block(int gb, int& base, int& t0, int& S) {
        if (gb < 266) { const int s = gb >= 133 ? 1 : 0; const int j = gb - 133 * s; base = s * 8192; t0 = 62 * j - 1; S = 8192; }
        else if (gb < GLU_BLOCKS) { const int g2 = gb - 266; const int s = g2 / 67, j = g2 - 67 * s; base = ROWS_P + s * 4096; t0 = 62 * j - 1; S = 4096; }
        else { base = 0; t0 = 0; S = 0; }
    }
    __device__ __forceinline__ unsigned rowq(int pm, int q, int r) const { int base, t0, S; block(4 * pm + q, base, t0, S); int t = t0 + r; t = t >= S ? S - 1 : t; t = t < 0 ? 0 : t; return (unsigned)(base + t); }
    __device__ __forceinline__ unsigned row(int pm, int R) const { int base, t0, S; block(4 * pm + (R >> 6), base, t0, S); int t = t0 + (R & 63); t = t >= S ? S - 1 : t; t = t < 0 ? 0 : t; return (unsigned)(base + t); }
};
template <int CTRL> __device__ __forceinline__ float dppf(float x) { return __builtin_bit_cast(float, __builtin_amdgcn_update_dpp(0, __builtin_bit_cast(int, x), CTRL, 0xf, 0xf, false)); }
template <int CTRL> __device__ __forceinline__ float dpp_any(float x) { return __builtin_bit_cast(float, __builtin_amdgcn_mov_dpp(__builtin_bit_cast(int, x), CTRL, 0xf, 0xf, false)); }
template <int CTRL> __device__ __forceinline__ float dpp_keep(float old, float x) { return __builtin_bit_cast(float, __builtin_amdgcn_update_dpp(__builtin_bit_cast(int, old), __builtin_bit_cast(int, x), CTRL, 0xf, 0xf, false)); }
typedef float f32x2 __attribute__((ext_vector_type(2)));
struct GeluK { f32x2 c0, c1, one;
    __device__ __forceinline__ GeluK() { c0 = (f32x2){-2.302208198f * 0.044715f, -2.302208198f * 0.044715f}; c1 = (f32x2){-2.302208198f, -2.302208198f}; one = (f32x2){1.0f, 1.0f}; asm volatile("" : "+v"(c0), "+v"(c1), "+v"(one)); } };
__device__ __forceinline__ f32x2 gelu_tanh_2(f32x2 x, const GeluK& k) {
    const f32x2 p = (x * x) * k.c0 + k.c1; const f32x2 a = x * p; f32x2 e; e.x = __builtin_amdgcn_exp2f(a.x); e.y = __builtin_amdgcn_exp2f(a.y);
    const f32x2 d = e + k.one; f32x2 r; r.x = __builtin_amdgcn_rcpf(d.x); r.y = __builtin_amdgcn_rcpf(d.y);
    return x * r;
}
__device__ __forceinline__ f32x4 gelu_tanh_4(f32x4 x, const GeluK& k) { const f32x2 lo = gelu_tanh_2((f32x2){x[0], x[1]}, k), hi = gelu_tanh_2((f32x2){x[2], x[3]}, k); return (f32x4){lo.x, lo.y, hi.x, hi.y}; }
__device__ __forceinline__ float gelu_tanh_f(float x) {
    const float u = x * (1.0f + 0.044715f * x * x); const float e = __builtin_amdgcn_exp2f(-2.302208198f * u);
    return x * __builtin_amdgcn_rcpf(1.0f + e);
}
struct EpiGLU {
    static constexpr bool PERM = true, PERMA = false, AFTER_DRAIN = false, HAS_MID = false;
    bf16_t* act; const float* cw; const float* cb;
    const float* rstd; const float* bias;
    __device__ __forceinline__ void operator()(const f32x4 (&acc)[2][2][4][2], const Unit& u, int wr, int wc, int fr_, int fq_) const {
        int fr = fr_, fq = fq_; asm volatile("" : "+v"(fr), "+v"(fq));
        const int c0 = u.pn * HALF + wc * 32 + 8 * fq;
        f32x4 w0[2], w1[2], w2[2], bb[2];
#pragma unroll
        for (int n = 0; n < 2; ++n) { w0[n] = *(const f32x4*)(cw + c0 + 4 * n); w1[n] = *(const f32x4*)(cw + 6144 + c0 + 4 * n); w2[n] = *(const f32x4*)(cw + 2 * 6144 + c0 + 4 * n); bb[n] = *(const f32x4*)(cb + c0 + 4 * n); }
#pragma unroll
        for (int ai = 0; ai < 2; ++ai) {
            int base, t0, S; GluMap::block(4 * u.pm + 2 * ai + wr, base, t0, S);
            f32x4 gt[4][2], bg[2], bu[2]; float rs[4];
            { const float* bp = bias + (size_t)batch_of_row(base) * 12288 + u.pn * BM + wc * 32 + 8 * fq;
#pragma unroll
              for (int n = 0; n < 2; ++n) { bg[n] = *(const f32x4*)(bp + 4 * n); bu[n] = *(const f32x4*)(bp + HALF + 4 * n); } }
#pragma unroll
            for (int m = 0; m < 4; ++m) { const int tok = t0 + 16 * m + fr; const bool in = tok >= 0 && tok < S; int tc = tok >= S ? S - 1 : tok; tc = tc < 0 ? 0 : tc; rs[m] = rstd[base + tc];
#pragma unroll
                for (int n = 0; n < 2; ++n) gt[m][n] = in ? acc[ai][0][m][n] * rs[m] + bg[n] : (f32x4){0.f, 0.f, 0.f, 0.f}; }
#pragma unroll
            for (int m = 0; m < 4; ++m) { const int i = 16 * m + fr, tok = t0 + i; u32x4 w;
                unsigned pk[4];
#pragma unroll
                for (int n = 0; n < 2; ++n) { f32x4 pv, nx;
#pragma unroll
                    for (int e = 0; e < 4; ++e) {
                        const float rcur = dppf<0x121>(gt[m][n][e]), rprv = dppf<0x121>(gt[m > 0 ? m - 1 : 0][n][e]);
                        const float lcur = dppf<0x12F>(gt[m][n][e]), lnxt = dppf<0x12F>(gt[m < 3 ? m + 1 : 3][n][e]);
                        pv[e] = fr == 0 ? rprv : rcur; nx[e] = fr == 15 ? lnxt : lcur; }
                    const f32x4 g = w0[n] * pv + w1[n] * gt[m][n] + w2[n] * nx + bb[n];
                    const f32x4 up = acc[ai][1][m][n] * rs[m] + bu[n];
                    const float a0 = gelu_tanh_f(g[0]) * up[0], a1 = gelu_tanh_f(g[1]) * up[1], a2 = gelu_tanh_f(g[2]) * up[2], a3 = gelu_tanh_f(g[3]) * up[3];
                    pk[2 * n] = cvt_pk_bf16(a0, a1); pk[2 * n + 1] = cvt_pk_bf16(a2, a3); }
                w.x = pk[0]; w.y = pk[1]; w.z = pk[2]; w.w = pk[3];
                if (i >= 1 && i <= 62 && tok < S) *(u32x4*)(act + (size_t)(base + tok) * 6144 + c0) = w; }
        }
    }
};

struct EpiGLU2 {
    static constexpr bool PERM = true, PERMA = true, AFTER_DRAIN = false, HAS_MID = false;
    bf16_t* act; const float* cw; const float* cb; const float* rstd; const float* bias; float* halo; PG8_LAS float* xch;
    __device__ __forceinline__ void operator()(const f32x4 (&acc)[2][2][4][2], const Unit& u, int wr, int wc, int fr_, int fq_) const {
        int fr = fr_, fq = fq_; asm volatile("" : "+v"(fr), "+v"(fq));
        const int lc = wc * 32 + 8 * fq, c0 = u.pn * HALF + lc;
        f32x4 w0[2], w1[2], w2[2], bb[2], bg[2], bu[2];
        { const float* bp = bias + (size_t)batch_of_row(u.pm * BM) * 12288 + u.pn * BM + lc;
#pragma unroll
          for (int n = 0; n < 2; ++n) { w0[n] = *(const f32x4*)(cw + c0 + 4 * n); w1[n] = *(const f32x4*)(cw + 6144 + c0 + 4 * n); w2[n] = *(const f32x4*)(cw + 2 * 6144 + c0 + 4 * n); bb[n] = *(const f32x4*)(cb + c0 + 4 * n);
              bg[n] = *(const f32x4*)(bp + 4 * n); bu[n] = *(const f32x4*)(bp + HALF + 4 * n); } }
        const GeluK GK;
        f32x4 gt[2][4][2]; float rs[2][4];
#pragma unroll
        for (int ai = 0; ai < 2; ++ai)
#pragma unroll
            for (int m = 0; m < 4; ++m) { rs[ai][m] = rstd[u.pm * BM + ai * HALF + wr * 64 + 4 * fr + m];
#pragma unroll
                for (int n = 0; n < 2; ++n) gt[ai][m][n] = acc[ai][0][m][n] * rs[ai][m] + bg[n]; }
#pragma unroll
        for (int ai = 0; ai < 2; ++ai) { const int blk = 2 * ai + wr;
#pragma unroll
            for (int n = 0; n < 2; ++n) { if (fr == 0) *(PG8_LAS f32x4*)(xch + (blk * 2 + 0) * HALF + lc + 4 * n) = gt[ai][0][n]; if (fr == 15) *(PG8_LAS f32x4*)(xch + (blk * 2 + 1) * HALF + lc + 4 * n) = gt[ai][3][n]; } }
        asm volatile("s_waitcnt lgkmcnt(0)" ::: "memory"); __builtin_amdgcn_s_barrier(); asm volatile("" ::: "memory");
#pragma unroll
        for (int ai = 0; ai < 2; ++ai) { const int blk = 2 * ai + wr; f32x4 pvb[2], nxb[2];
#pragma unroll
            for (int n = 0; n < 2; ++n) { pvb[n] = *(const PG8_LAS f32x4*)(xch + ((blk > 0 ? blk - 1 : 0) * 2 + 1) * HALF + lc + 4 * n); nxb[n] = *(const PG8_LAS f32x4*)(xch + ((blk < 3 ? blk + 1 : 3) * 2 + 0) * HALF + lc + 4 * n); }
#pragma unroll
            for (int m = 0; m < 4; ++m) { const int i = 4 * fr + m; u32x4 w; unsigned pk[4]; f32x4 upv[2];
#pragma unroll
                for (int n = 0; n < 2; ++n) { f32x4 pv, nx;
#pragma unroll
                    for (int e = 0; e < 4; ++e) {
                        pv[e] = m > 0 ? gt[ai][m > 0 ? m - 1 : 0][n][e] : dpp_keep<0x111>(pvb[n][e], gt[ai][3][n][e]);
                        nx[e] = m < 3 ? gt[ai][m < 3 ? m + 1 : 3][n][e] : dpp_keep<0x101>(nxb[n][e], gt[ai][0][n][e]); }
                    const f32x4 g = w2[n] * nx + (w1[n] * gt[ai][m][n] + (w0[n] * pv + bb[n]));
                    upv[n] = acc[ai][1][m][n] * rs[ai][m] + bu[n];
                    const f32x4 av = gelu_tanh_4(g, GK) * upv[n];
                    pk[2 * n] = cvt_pk_bf16(av[0], av[1]); pk[2 * n + 1] = cvt_pk_bf16(av[2], av[3]); }
                w.x = pk[0]; w.y = pk[1]; w.z = pk[2]; w.w = pk[3];
                const int trow = 64 * blk + i;
                __builtin_nontemporal_store(w, (u32x4*)(act + (size_t)(u.pm * BM + trow) * 6144 + c0));
                if ((ai == 0 && m < 2) || (ai == 1 && m >= 2)) {
                    if (ai == 0 ? (wr == 0 && fr == 0) : (wr == 1 && fr == 15)) { float* hp = halo + ((size_t)u.pm * 6 + m) * 6144 + c0; *(f32x4*)hp = gt[ai][m][0]; *(f32x4*)(hp + 4) = gt[ai][m][1];
                        if (m == 0 || m == 3) { float* hu = halo + ((size_t)u.pm * 6 + (m == 0 ? 4 : 5)) * 6144 + c0; *(f32x4*)hu = upv[0]; *(f32x4*)(hu + 4) = upv[1]; } } } }
        }
    }
};
struct IdentMap { static constexpr bool UNIFORM = true; __device__ __forceinline__ unsigned row(int pm, int R) const { return (unsigned)(pm * BM + R); } __device__ __forceinline__ unsigned rowq(int pm, int q, int r) const { return (unsigned)(pm * BM + 64 * q + r); } };
template <class Epi, class Sched, class AMap>
__device__ __forceinline__ void gemm_phase(PG8_LAS unsigned char* lds, const Gemm g, const Sched& S, const Epi& E, const AMap& AM, int wave) {
    unsigned z_ = 0u; asm volatile("" : "+v"(z_)); const int ln_ = (int)__builtin_amdgcn_mbcnt_hi(~0u, __builtin_amdgcn_mbcnt_lo(~0u, z_)); const int tid_ = wave * 64 + ln_;
    const int tid = tid_, wid = wave, lane = ln_, wr = wid >> 2, wc = wid & 3, fr = lane & 15, fq = lane >> 4;
    const int K = g.K, nt = K / BK;
    int RA[2], CA[2]; unsigned voffB[2], voffA[2];
#pragma unroll
    for (int i = 0; i < 2; ++i) { int R, C; stage_rc(tid * 16 + i * 8192, R, C); const int Rb = Epi::PERM ? ((R & ~31) + perm32(R & 31)) : R; const int Ra = Epi::PERMA ? ((R & ~63) + 4 * (R & 15) + ((R & 63) >> 4)) : R; RA[i] = R; CA[i] = C; voffA[i] = (unsigned)(Ra * K + C) * 2u; voffB[i] = (unsigned)(Rb * K + C) * 2u; }
    const size_t kstep = (size_t)(BK * 2);
    const size_t qstep = (size_t)64 * K * 2;
    const size_t hstep = (size_t)HALF * K * 2;
    const size_t tstep = 2 * hstep;
    const unsigned ldsw = (unsigned)wid * 1024u;
    const int aoff = lds_byte(wr * 64 + fr, fq * 8), boff = lds_byte(wc * 32 + fr, fq * 8);
#define PG8_SA(b, h) (((b) * 2 + (h)) * HTB)
#define PG8_SB(b, h) ((4 + (b) * 2 + (h)) * HTB)
#define PG8_STAGE(bufoff, gbase, voff) do { _Pragma("unroll") for (int _i = 0; _i < 2; ++_i) \
        __builtin_amdgcn_global_load_lds((const unsigned*)((const char*)(gbase) + (size_t)_i * qstep + (voff)[0]), (PG8_LAS unsigned*)(lds + (bufoff) + ldsw + _i * 8192), 16, 0, 0); } while (0)
#define PG8_LDA(dst, b, h) do { _Pragma("unroll") for (int m = 0; m < 4; ++m) _Pragma("unroll") for (int k = 0; k < 2; ++k) dst[m][k] = *(const PG8_LAS bf16x8*)(lds + PG8_SA(b, h) + aoff + m * 2048 + k * 1024); } while (0)
#define PG8_LDB(dst, b, h) do { _Pragma("unroll") for (int n = 0; n < 2; ++n) _Pragma("unroll") for (int k = 0; k < 2; ++k) dst[n][k] = *(const PG8_LAS bf16x8*)(lds + PG8_SB(b, h) + boff + n * 2048 + k * 1024); } while (0)
#define PG8_MMA(ai, bj, At, Bt) do { __builtin_amdgcn_s_setprio(1); _Pragma("unroll") for (int m = 0; m < 4; ++m) _Pragma("unroll") for (int n = 0; n < 2; ++n) _Pragma("unroll") for (int k = 0; k < 2; ++k) \
        acc[ai][bj][m][n] = __builtin_amdgcn_mfma_f32_16x16x32_bf16(Bt[n][k], At[m][k], acc[ai][bj][m][n], 0, 0, 0); __builtin_amdgcn_s_setprio(0); } while (0)
#define PG8_WAIT_V(n) asm volatile("s_waitcnt vmcnt(" #n ")" ::: "memory")
#define PG8_WAIT_L(n) asm volatile("s_waitcnt lgkmcnt(" #n ")" ::: "memory")
#define PG8_BAR __builtin_amdgcn_s_barrier()
#define PG8_SCHED __builtin_amdgcn_sched_barrier(0)
#define PG8_STAGE_A(bufoff, kb, h, NX) do { if constexpr (AMap::UNIFORM) { const char* _b = ((NX) ? nA : cA) + (kb) + (h) * hstep; PG8_STAGE(bufoff, _b, voffA); } \
        else { unsigned _o[2]; _o[0] = (NX) ? offN[h][0] : offC[h][0]; _o[1] = (NX) ? offN[h][1] : offC[h][1]; PG8_STAGE(bufoff, Ab + (kb), _o); } } while (0)
#define PG8_OFFS(dst, pm) do { _Pragma("unroll") for (int _h = 0; _h < 2; ++_h) _Pragma("unroll") for (int _i = 0; _i < 2; ++_i) dst[_h][_i] = (AM.rowq((pm), 2 * _h + _i, RA[_i] & 63) * (unsigned)K + (unsigned)CA[_i]) * 2u; } while (0)
    Unit cur, nxt; int ui = 0;
    if (!S.next(0, cur)) return;
    f32x4 acc[2][2][4][2];
#pragma unroll
    for (int a = 0; a < 2; ++a)
#pragma unroll
        for (int b = 0; b < 2; ++b)
#pragma unroll
            for (int m = 0; m < 4; ++m)
#pragma unroll
                for (int n = 0; n < 2; ++n) acc[a][b][m][n] = (f32x4){0.f, 0.f, 0.f, 0.f};
    bf16x8 At[4][2], B0[2][2], B1[2][2];
    unsigned offC[2][2], offN[2][2];
    if constexpr (!AMap::UNIFORM) { PG8_OFFS(offC, cur.pm); }
    const char* const Ab = (const char*)g.A;
    const char* cA = (const char*)g.A + (size_t)cur.pm * tstep; const char* nA = cA;
    const char* cB = (const char*)g.Bt + (size_t)cur.pn * tstep;
    S.a_ready(cur);
    PG8_STAGE(PG8_SB(0, 0), cB, voffB); PG8_STAGE(PG8_SB(0, 1), cB + hstep, voffB); PG8_STAGE_A(PG8_SA(0, 0), 0, 0, false); PG8_STAGE_A(PG8_SA(0, 1), 0, 1, false);
    if (wr == 1) PG8_BAR;
    PG8_WAIT_V(2); PG8_BAR;
    PG8_STAGE(PG8_SB(1, 0), cB + kstep, voffB); PG8_STAGE_A(PG8_SA(1, 0), kstep, 0, false); PG8_STAGE(PG8_SB(1, 1), cB + hstep + kstep, voffB);
    PG8_WAIT_V(6); PG8_BAR;
    for (;;) {
        const bool has_next = S.next(ui + 1, nxt);
        const char* nB = has_next ? (const char*)g.Bt + (size_t)nxt.pn * tstep : cB;
        if constexpr (AMap::UNIFORM) { nA = has_next ? (const char*)g.A + (size_t)nxt.pm * tstep : cA; }
        else { if (has_next) { PG8_OFFS(offN, nxt.pm); } else {
#pragma unroll
            for (int _h = 0; _h < 2; ++_h)
#pragma unroll
                for (int _i = 0; _i < 2; ++_i) offN[_h][_i] = offC[_h][_i]; } }
        for (int t = 0; t < nt; t += 2) {
            const bool last = (t == nt - 2);
            const size_t k1 = (size_t)(t + 1) * kstep, k2 = last ? (size_t)0 : (size_t)(t + 2) * kstep, k3 = k2 + kstep;
            const char* b2 = last ? nB : cB + (size_t)(t + 2) * kstep; const char* b3 = b2 + kstep;
            if (last && has_next) S.a_ready(nxt);
            if constexpr (Epi::HAS_MID) { if (t == nt / 2) E.mid(acc, cur, wr, fr); }
            PG8_LDB(B0, 0, 0); PG8_LDB(B1, 0, 1); PG8_SCHED; PG8_LDA(At, 0, 0); PG8_STAGE_A(PG8_SA(1, 1), k1, 1, false);
            PG8_WAIT_V(8); PG8_WAIT_L(0); PG8_BAR; PG8_MMA(0, 0, At, B0); PG8_MMA(0, 1, At, B1); PG8_BAR; PG8_SCHED;
            PG8_LDA(At, 0, 1); PG8_STAGE(PG8_SB(0, 0), b2, voffB); PG8_STAGE(PG8_SB(0, 1), b2 + hstep, voffB); PG8_STAGE_A(PG8_SA(0, 0), k2, 0, last);
            PG8_WAIT_V(8); PG8_WAIT_L(0); PG8_BAR; PG8_MMA(1, 0, At, B0); PG8_MMA(1, 1, At, B1); PG8_BAR; PG8_SCHED;
            PG8_LDB(B0, 1, 0); PG8_LDB(B1, 1, 1); PG8_SCHED; PG8_LDA(At, 1, 0); PG8_STAGE_A(PG8_SA(0, 1), k2, 1, last);
            PG8_WAIT_V(8); PG8_WAIT_L(0); PG8_BAR; PG8_MMA(0, 0, At, B0); PG8_MMA(0, 1, At, B1); PG8_BAR; PG8_SCHED;
            PG8_LDA(At, 1, 1); PG8_STAGE(PG8_SB(1, 0), b3, voffB); PG8_STAGE(PG8_SB(1, 1), b3 + hstep, voffB); PG8_STAGE_A(PG8_SA(1, 0), k3, 0, last);
            PG8_WAIT_V(8); PG8_WAIT_L(0); PG8_BAR; PG8_MMA(1, 0, At, B0); PG8_MMA(1, 1, At, B1); PG8_BAR; PG8_SCHED;
        }
        if (wr == 0) PG8_BAR;
        E(acc, cur, wr, wc, fr, fq); S.done(cur);
        if (!has_next) break;
#pragma unroll
        for (int a = 0; a < 2; ++a)
#pragma unroll
            for (int b = 0; b < 2; ++b)
#pragma unroll
                for (int m = 0; m < 4; ++m)
#pragma unroll
                    for (int n = 0; n < 2; ++n) acc[a][b][m][n] = (f32x4){0.f, 0.f, 0.f, 0.f};
        cur = nxt; cB = nB; cA = nA; ++ui;
        if constexpr (!AMap::UNIFORM) {
#pragma unroll
        for (int _h = 0; _h < 2; ++_h)
#pragma unroll
            for (int _i = 0; _i < 2; ++_i) offC[_h][_i] = offN[_h][_i]; }
        if (wr == 1) PG8_BAR;
    }
    PG8_WAIT_V(0);
    PG8_BAR;
#undef PG8_SA
#undef PG8_SB
#undef PG8_STAGE
#undef PG8_LDA
#undef PG8_LDB
#undef PG8_MMA
#undef PG8_WAIT_V
#undef PG8_WAIT_L
#undef PG8_BAR
#undef PG8_SCHED
#undef PG8_OFFS
#undef PG8_STAGE_A
}
}

#define LAS __attribute__((address_space(3)))
typedef unsigned short bf16_t;
typedef float f32x4 __attribute__((ext_vector_type(4)));
typedef float f32x2 __attribute__((ext_vector_type(2)));
typedef unsigned u32x4 __attribute__((ext_vector_type(4)));
typedef unsigned u32x2 __attribute__((ext_vector_type(2)));
typedef short bf16x8 __attribute__((ext_vector_type(8)));
typedef short s16x4 __attribute__((ext_vector_type(4)));
constexpr int D = 2048, T = 49152, ROWS_P = 16384, NB = 10, DEPTH = 4;
constexpr int ZC = 3584, ZQ = 0, ZK = 1024, ZV = 1280, ZX = 1536, ZY = 2560;
constexpr int DFF = 6144, MODSTRIDE = 12288;
constexpr float EPS = 1e-6f;
constexpr size_t MiB = 1u << 20;
constexpr size_t WS_CTL = 0, CTL_ZERO_BYTES = 64 * 1024, WS_MOD = 1 * MiB, WS_SUM = 3 * MiB  , WS_CAR = 9 * MiB  , WS_LW = 12 * MiB  ,
                 WS_WIN = 16 * MiB, WS_WOUT = 72 * MiB, WS_WGU = 104 * MiB, WS_WDN = 296 * MiB, WS_H = 392 * MiB, WS_Z = 584 * MiB,
                 WS_ATT = 920 * MiB, WS_LRU = 1016 * MiB, WS_AB = 1112 * MiB, WS_LC = 1112 * MiB  ,
                 WS_SSQX = 1496 * MiB  , WS_SSQA = 1502 * MiB  , WS_SSQL = 1503 * MiB + 512 * 1024, WS_RSTD = 1505 * MiB, WS_RATIO = 1505 * MiB + 256 * 1024, WS_S2 = 1505 * MiB + 512 * 1024,
                 WS_BIN = 1506 * MiB  , WS_BGU = 1507 * MiB  , WS_END = 1510 * MiB;
constexpr size_t WS_XR = 1160 * MiB;
constexpr size_t WS_HALO = 1352 * MiB;
constexpr size_t WS_MRG = WS_ATT;
constexpr size_t WS_LSP = 3 * MiB - 65536;
constexpr size_t WS_ACT = WS_Z;
constexpr size_t WS_GUC = WS_Z, WS_ACTC = WS_Z + 192 * MiB;
static_assert(WS_ACT + (size_t)T * DFF * 2 <= WS_XR && WS_XR + (size_t)T * D * 2 <= WS_HALO && WS_HALO + (size_t)192 * 6 * DFF * 4 <= WS_SSQX, "act overlay / residual stream / halo");
constexpr int LDS_BYTES = 147456, LDS_CTL = LDS_BYTES - 256;
constexpr int NWAVES = 8;
constexpr int CW_BAR = 1024;

__device__ __forceinline__ void rowinfo(int row, int& b, int& t, int& S) { if (row < ROWS_P) { b = row >> 13; t = row & 8191; S = 8192; } else { const int r = row - ROWS_P; b = 2 + (r >> 12); t = r & 4095; S = 4096; } }
__device__ __forceinline__ float bf2f(unsigned short u) { return __uint_as_float(((unsigned)u) << 16); }
__device__ __forceinline__ float bflo(unsigned w) { return __uint_as_float(w << 16); }
__device__ __forceinline__ float bfhi(unsigned w) { return __uint_as_float(w & 0xffff0000u); }
__device__ __forceinline__ unsigned f2bf(float f) { unsigned u = __float_as_uint(f); return (u + 0x7fffu + ((u >> 16) & 1u)) >> 16; }
__device__ __forceinline__ unsigned pk2(float lo, float hi) { return f2bf(lo) | (f2bf(hi) << 16); }
__device__ __forceinline__ float wave_sum(float v) {
#pragma unroll
    for (int o = 1; o < 64; o <<= 1) v += __shfl_xor(v, o);
    return v; }
__device__ __forceinline__ float wave_max(float v) {
#pragma unroll
    for (int o = 1; o < 64; o <<= 1) v = fmaxf(v, __shfl_xor(v, o));
    return v; }
__device__ __forceinline__ float gelu_tanh(float x) { const float u = 0.7978845608028654f * (x + 0.044715f * x * x * x); return x / (1.0f + __expf(-2.0f * u)); }
__device__ __forceinline__ float sigmoidf(float x) { return 1.0f / (1.0f + __expf(-x)); }
#define LDS_WAIT() asm volatile("s_waitcnt lgkmcnt(0)" ::: "memory")
#define VM_WAIT() asm volatile("s_waitcnt vmcnt(0)" ::: "memory")
#define WG_BAR() do { asm volatile("s_waitcnt vmcnt(0) lgkmcnt(0)" ::: "memory"); __builtin_amdgcn_s_barrier(); asm volatile("" ::: "memory"); } while (0)

__device__ __forceinline__ unsigned char* ws_now(unsigned char* p) { asm volatile("" : "+s"(p)); return p; }
__device__ __forceinline__ int lane_id() { unsigned z = 0u; asm volatile("" : "+v"(z)); return (int)__builtin_amdgcn_mbcnt_hi(~0u, __builtin_amdgcn_mbcnt_lo(~0u, z)); }
#define XB_TMO      128
#define XB_XCNT(j)  (256  + 64 * (j))
#define XB_XSUB(j)  (1280 + 64 * (j))
#define XB_XGEN(j)  (2304 + 64 * (j))
#define XB_TOP      3328
#define XB_TOPGEN   3392
#define XCD_BAR_WORDS 3456
#define XB_SPIN_CAP (1u << 18)

__device__ __forceinline__ unsigned xb_ld(unsigned* p)              { return __hip_atomic_load(p, __ATOMIC_RELAXED, __HIP_MEMORY_SCOPE_AGENT); }
__device__ __forceinline__ unsigned xb_add(unsigned* p, unsigned v) { return __hip_atomic_fetch_add(p, v, __ATOMIC_RELAXED, __HIP_MEMORY_SCOPE_AGENT); }
__device__ __forceinline__ unsigned xb_xcc_id() { return (unsigned)__builtin_amdgcn_s_getreg((3 << 11) | 20) & 0xFu; }
#define XB_SPIN(cond, bar) do { unsigned _sp = 0; while (cond) { __builtin_amdgcn_s_sleep(1); \
    if ((++_sp & 255u) == 0u) { if (xb_ld(&(bar)[XB_TMO])) break; if (_sp > XB_SPIN_CAP) { atomicAdd(&(bar)[XB_TMO], 1u); break; } } } } while (0)

struct XcdBarrier {
    unsigned* bar; unsigned x; int wv;
    volatile LAS unsigned* st;
};

__device__ __forceinline__ XcdBarrier xcd_barrier_post(unsigned* bar, volatile LAS unsigned* st, int wv) {
    XcdBarrier b; b.bar = bar; b.x = xb_xcc_id(); b.st = st; b.wv = wv;
    if (wv == 0 && lane_id() == 0) (void)xb_add(&bar[XB_XCNT(b.x)], 1u);
    return b;
}
__device__ __forceinline__ void xcd_barrier_complete(unsigned* bar, unsigned x, unsigned& nloc, unsigned& nx) {
    const unsigned G = gridDim.x * gridDim.y * gridDim.z;
    unsigned sum, cnt, mine, sp = 0u;
    for (;;) {
        sum = 0u; cnt = 0u; mine = 0u;
#pragma unroll
        for (unsigned j = 0; j < 16; ++j) { const unsigned c = xb_ld(&bar[XB_XCNT(j)]); sum += c; cnt += (c > 0u) ? 1u : 0u; mine = (j == x) ? c : mine; }
        if (sum == G) break;
        __builtin_amdgcn_s_sleep(1);
        if ((++sp & 255u) == 0u) { if (xb_ld(&bar[XB_TMO])) break; if (sp > XB_SPIN_CAP) { atomicAdd(&bar[XB_TMO], 1u); break; } }
    }
    nloc = mine > 0u ? mine : 1u; nx = cnt > 0u ? cnt : 1u;
}

__device__ __forceinline__ void xcd_barrier(const XcdBarrier& b) {
    asm volatile("s_waitcnt vmcnt(0)" ::: "memory");
    __syncthreads();
    if (b.wv == 0 && lane_id() == 0) {
        unsigned* bar = b.bar; asm volatile("" : "+s"(bar));
        __builtin_amdgcn_s_waitcnt(0);
        unsigned nloc = b.st[0], nx = b.st[1];
        if (nloc == 0u) { xcd_barrier_complete(bar, b.x, nloc, nx); b.st[0] = nloc; b.st[1] = nx; }
        const unsigned old = xb_add(&bar[XB_XSUB(b.x)], 1u);
        const unsigned gen = old / nloc;
        if (old + 1u == (gen + 1u) * nloc) {
            __builtin_amdgcn_fence(__ATOMIC_RELEASE, "agent");
            asm volatile("s_waitcnt vmcnt(0)" ::: "memory");
            const unsigned og = xb_add(&bar[XB_TOP], 1u);
            const unsigned tg = og / nx;
            if (og + 1u == (tg + 1u) * nx) xb_add(&bar[XB_TOPGEN], 1u);
            else XB_SPIN(xb_ld(&bar[XB_TOPGEN]) == tg, bar);
            __builtin_amdgcn_fence(__ATOMIC_ACQUIRE, "agent");
            xb_add(&bar[XB_XGEN(b.x)], 1u);
            asm volatile("s_waitcnt vmcnt(0)" ::: "memory");
        } else {
            XB_SPIN(xb_ld(&bar[XB_XGEN(b.x)]) == gen, bar);
            __builtin_amdgcn_fence(__ATOMIC_ACQUIRE, "agent");
            asm volatile("s_waitcnt vmcnt(0)" ::: "memory");
        }
    }
    __syncthreads();
}

struct Args { const float* in[28]; float* out; unsigned char* ws; int ph_lo, ph_hi, flags, pad; };
struct Frame {
    LAS unsigned char* lds; int tid, lane, wave, G, bid;
};
#define KAS __attribute__((address_space(4)))
__device__ __forceinline__ const KAS unsigned char* karg_base() { const KAS unsigned char* p = (const KAS unsigned char*)__builtin_amdgcn_kernarg_segment_ptr(); asm volatile("" : "+s"(p)); return p; }
__device__ __forceinline__ const float* karg_in(int k) { return *(const float* const KAS*)(karg_base() + 8 * k); }
__device__ __forceinline__ float* karg_out() { return *(float* const KAS*)(karg_base() + 8 * 28); }
__device__ __forceinline__ unsigned char* karg_ws() { return *(unsigned char* const KAS*)(karg_base() + 8 * 29); }
#define INP(k) (karg_in(k))
__device__ __forceinline__ Frame fresh(const Frame& F0) { Frame F = F0; int ln = lane_id(); asm volatile("" : "+v"(ln)); F.lane = ln; F.tid = F0.wave * 64 + ln; return F; }

__device__ __forceinline__ void p0_transpose_item(const float* W, int K, int N, bf16_t* WT, int mode, LAS float* scr, int item, int lane, const float* ks0 = nullptr, const float* ks1 = nullptr) {
    const int nblk = N / 64, kb = item / nblk, nb = item % nblk, k0 = 64 * kb, n0 = 64 * nb;
    const int drow0 = mode == 0 ? n0 : ((n0 >> 7) * 256 + (n0 & 127) + (mode == 2 ? 128 : 0));
    f32x4 v[16];
#pragma unroll
    for (int i = 0; i < 16; ++i) v[i] = *(const f32x4*)(W + (size_t)(k0 + 4 * i + (lane >> 4)) * N + n0 + 4 * (lane & 15));
#pragma unroll
    for (int i = 0; i < 16; ++i) { const int kk = 4 * i + (lane >> 4); float sc = 1.0f; if (ks0) sc = (k0 + kk < 1024 ? ks0[k0 + kk] : ks1[k0 + kk - 1024]);
        LAS float* d = scr + kk * 65 + 4 * (lane & 15); d[0] = v[i].x * sc; d[1] = v[i].y * sc; d[2] = v[i].z * sc; d[3] = v[i].w * sc; }
    LDS_WAIT(); asm volatile("" ::: "memory");
    const int c = lane & 7;
#pragma unroll
    for (int j = 0; j < 8; ++j) { const int n = (lane >> 3) + 8 * j; const LAS float* s = scr + (8 * c) * 65 + n;
        u32x4 o; o.x = pk2(s[0 * 65], s[1 * 65]); o.y = pk2(s[2 * 65], s[3 * 65]); o.z = pk2(s[4 * 65], s[5 * 65]); o.w = pk2(s[6 * 65], s[7 * 65]);
        *(u32x4*)(WT + (size_t)(drow0 + n) * K + k0 + 8 * c) = o; }
    LDS_WAIT(); asm volatile("" ::: "memory");
}
__device__ __forceinline__ void phase_prologue(const Frame& F0, const Args& a) { const Frame F = fresh(F0);
    unsigned char* ws = karg_ws();
    bf16_t* WIN = (bf16_t*)(ws + WS_WIN); bf16_t* WOUT = (bf16_t*)(ws + WS_WOUT); bf16_t* WGU = (bf16_t*)(ws + WS_WGU); bf16_t* WDN = (bf16_t*)(ws + WS_WDN);
    LAS float* scr = (LAS float*)(F.lds + F.wave * 16640);
    const int gw = F.bid * NWAVES + F.wave, NGW = F.G * NWAVES;
    constexpr int I_IN = (D / 64) * (ZC / 64), I_OUT = (D / 64) * (D / 64), I_G = (D / 64) * (DFF / 64), I_D = (DFF / 64) * (D / 64), I_L = I_IN + I_OUT + 2 * I_G + I_D;
    for (int it = gw; it < DEPTH * I_L; it += NGW) { const int l = it / I_L; int r = it - l * I_L;
        if (r < I_IN) { p0_transpose_item(INP(9) + (size_t)l * D * ZC, D, ZC, WIN + (size_t)l * ZC * D, 0, scr, r, F.lane); continue; } r -= I_IN;
        if (r < I_OUT) { p0_transpose_item(INP(22) + (size_t)l * D * D, D, D, WOUT + (size_t)l * D * D, 0, scr, r, F.lane, INP(20) + l * 1024, INP(21) + l * 1024); continue; } r -= I_OUT;
        if (r < I_G) { p0_transpose_item(INP(23) + (size_t)l * D * DFF, D, DFF, WGU + (size_t)l * 2 * DFF * D, 1, scr, r, F.lane); continue; } r -= I_G;
        if (r < I_G) { p0_transpose_item(INP(24) + (size_t)l * D * DFF, D, DFF, WGU + (size_t)l * 2 * DFF * D, 2, scr, r, F.lane); continue; } r -= I_G;
        p0_transpose_item(INP(27) + (size_t)l * DFF * D, DFF, D, WDN + (size_t)l * D * DFF, 0, scr, r, F.lane); }
    { bf16_t* LW = (bf16_t*)(ws + WS_LW);
      for (int it = gw; it < DEPTH * 8 * 8 * 16; it += NGW) { const int ks = it & 3, gs = (it >> 2) & 3, w = (it >> 4) & 7, n = (it >> 7) & 7, l = it >> 10;
          const float* src = (gs < 2 ? INP(15) : INP(17)) + ((size_t)((l * 2 + (gs & 1)) * 8 + n) * 128) * 128;
          const int c0 = 32 * ks + 8 * (F.lane >> 4), jc = 16 * w + (F.lane & 15); float v[8];
#pragma unroll
          for (int j = 0; j < 8; ++j) v[j] = src[(size_t)(c0 + j) * 128 + jc];
          u32x4 o; o.x = pk2(v[0], v[1]); o.y = pk2(v[2], v[3]); o.z = pk2(v[4], v[5]); o.w = pk2(v[6], v[7]);
          *(u32x4*)(LW + ((size_t)it * 64 + F.lane) * 8) = o; } }
    { float* LSP = (float*)(ws + WS_LSP); for (int i = F.bid * 512 + F.tid; i < DEPTH * 2048; i += F.G * 512) LSP[i] = log1pf(expf(-INP(19)[i])); }
    WG_BAR();
    { LAS float* cs = (LAS float*)F.lds; LAS float* red = (LAS float*)(F.lds + 81920); float* MOD = (float*)(ws + WS_MOD);
      const float* c_p = INP(2); const float* c_s = INP(3); const float* w_mod = INP(5); const float* b_mod = INP(6); const float* n1g = INP(7); const float* n2g = INP(8);
      for (int i = F.tid; i < NB * D; i += 512) { const int b = i >> 11, k = i & 2047; const float c = b < 2 ? c_p[b * D + k] : c_s[(b - 2) * D + k]; cs[i] = c / (1.0f + __expf(-c)); }
      WG_BAR();
      for (int item = F.bid; item < DEPTH * 192; item += F.G) { const int l = item / 192, col0 = (item % 192) * 64, w = F.wave, lane = F.lane;
          float acc[NB];
#pragma unroll
          for (int b = 0; b < NB; ++b) acc[b] = 0.f;
          const float* W = w_mod + (size_t)l * D * MODSTRIDE + col0 + lane;
          for (int k0 = 256 * w; k0 < 256 * w + 256; k0 += 16) { float wv[16];
#pragma unroll
              for (int j = 0; j < 16; ++j) wv[j] = W[(size_t)(k0 + j) * MODSTRIDE];
#pragma unroll
              for (int j4 = 0; j4 < 4; ++j4)
#pragma unroll
                  for (int b = 0; b < NB; ++b) { const f32x4 c4 = *(const LAS f32x4*)(cs + b * D + k0 + 4 * j4); acc[b] += (c4.x * wv[4 * j4] + c4.y * wv[4 * j4 + 1]) + (c4.z * wv[4 * j4 + 2] + c4.w * wv[4 * j4 + 3]); } }
#pragma unroll
          for (int b = 0; b < NB; ++b) red[(w * NB + b) * 64 + lane] = acc[b];
          WG_BAR();
          for (int i = F.tid; i < NB * 64; i += 512) { const int b = i >> 6, cc = i & 63, col = col0 + cc; float s = b_mod[l * MODSTRIDE + col];
#pragma unroll
              for (int ww = 0; ww < 8; ++ww) s += red[(ww * NB + b) * 64 + cc];
              const int slot = col >> 11, c = col & 2047;
              if (slot == 1) s = n1g[l * D + c] * (1.0f + s); else if (slot == 4) s = n2g[l * D + c] * (1.0f + s);
              MOD[((size_t)l * NB + b) * MODSTRIDE + col] = s; }
          WG_BAR(); } }
}

__device__ __forceinline__ void phase_norm0(const Frame& F0, const float* x_p, const float* x_s, const float* mod0, bf16_t* XG, float* RSTD) { const Frame F = fresh(F0);
    const int gw = F.bid * NWAVES + F.wave, NGW = F.G * NWAVES, lane = F.lane;
    for (int row = gw; row < T; row += NGW) { const int b = row < ROWS_P ? (row >> 13) : 2 + ((row - ROWS_P) >> 12);
        const float* xr = row < ROWS_P ? x_p + (size_t)row * D : x_s + (size_t)(row - ROWS_P) * D; const float* gm = mod0 + (size_t)b * MODSTRIDE + D;
        f32x4 v[8]; float ss = 0.f;
#pragma unroll
        for (int j = 0; j < 8; ++j) { v[j] = ((const f32x4*)xr)[lane + 64 * j]; ss += (v[j].x * v[j].x + v[j].y * v[j].y) + (v[j].z * v[j].z + v[j].w * v[j].w); }
        ss = wave_sum(ss); if (lane == 0) RSTD[row] = rsqrtf(ss * (1.0f / D) + EPS);
#pragma unroll
        for (int j = 0; j < 8; ++j) { const f32x4 g = ((const f32x4*)gm)[lane + 64 * j]; const f32x4 o = v[j] * g; u32x2 p; p.x = pk2(o.x, o.y); p.y = pk2(o.z, o.w); ((u32x2*)(XG + (size_t)row * D))[lane + 64 * j] = p; } }
}
__device__ __forceinline__ void phase_rstd(const Frame& F0, int mode, const float* SSQX, float* RSTD, const float* SSQA, const float* SSQL, float* RATIO, float* S2) { const Frame F = fresh(F0);
    for (int row = F.bid * 512 + F.tid; row < T; row += F.G * 512) {
        if (mode == 0) { const f32x4* p = (const f32x4*)(SSQX + (size_t)row * 32); f32x4 s = p[0];
#pragma unroll
            for (int j = 1; j < 8; ++j) s += p[j];
            RSTD[row] = rsqrtf(((s.x + s.y) + (s.z + s.w)) * (1.0f / D) + EPS); }
        else { const f32x4* pa = (const f32x4*)(SSQA + (size_t)row * 8); const f32x4* pl = (const f32x4*)(SSQL + (size_t)row * 8); const f32x4 a = pa[0] + pa[1], l = pl[0] + pl[1];
            const float s1 = rsqrtf(((a.x + a.y) + (a.z + a.w)) * (1.0f / 1024.0f) + EPS), s2 = rsqrtf(((l.x + l.y) + (l.z + l.w)) * (1.0f / 1024.0f) + EPS);
            RATIO[row] = s1 / s2; S2[row] = s2; } }
}
__device__ __forceinline__ void phase_bias(const Frame& F0, const float* MOD, const bf16_t* WIN, const bf16_t* WGU, float* BIN, float* BGU) { const Frame F = fresh(F0);
    const int fr = F.lane & 15, fq = F.lane >> 4;
    constexpr int T_IN = ZC / 16, T_GU = 2 * DFF / 16, T_L = T_IN + T_GU;
    for (int tile = F.bid * NWAVES + F.wave; tile < DEPTH * T_L; tile += F.G * NWAVES) { const int l = tile / T_L; int r = tile - l * T_L; const int which = r >= T_IN ? 1 : 0; if (which) r -= T_IN;
        const int N = which ? 2 * DFF : ZC, n0 = 16 * r;
        const bf16_t* wp = (which ? WGU + (size_t)l * 2 * DFF * D : WIN + (size_t)l * ZC * D) + (size_t)(n0 + fr) * D + 8 * fq;
        const float* sp = MOD + ((size_t)l * NB + (fr < NB ? fr : 0)) * MODSTRIDE + (which ? 3 : 0) * D + 8 * fq;
        f32x4 acc = (f32x4){0.f, 0.f, 0.f, 0.f};
#pragma unroll 4
        for (int ks = 0; ks < D / 32; ++ks) { const bf16x8 af = *(const bf16x8*)(wp + 32 * ks); f32x4 s0 = *(const f32x4*)(sp + 32 * ks), s1 = *(const f32x4*)(sp + 32 * ks + 4);
            if (fr >= NB) { s0 = (f32x4){0.f, 0.f, 0.f, 0.f}; s1 = s0; }
            unsigned hi[4], lo[4]; const float sv[8] = {s0.x, s0.y, s0.z, s0.w, s1.x, s1.y, s1.z, s1.w};
#pragma unroll
            for (int j = 0; j < 4; ++j) { const unsigned h0 = f2bf(sv[2 * j]), h1 = f2bf(sv[2 * j + 1]); hi[j] = h0 | (h1 << 16); lo[j] = pk2(sv[2 * j] - __uint_as_float(h0 << 16), sv[2 * j + 1] - __uint_as_float(h1 << 16)); }
            const u32x4 hv = (u32x4){hi[0], hi[1], hi[2], hi[3]}, lv = (u32x4){lo[0], lo[1], lo[2], lo[3]};
            acc = __builtin_amdgcn_mfma_f32_16x16x32_bf16(af, __builtin_bit_cast(bf16x8, hv), acc, 0, 0, 0); acc = __builtin_amdgcn_mfma_f32_16x16x32_bf16(af, __builtin_bit_cast(bf16x8, lv), acc, 0, 0, 0); }
        if (fr < NB) { float* bp = (which ? BGU + (size_t)l * NB * 2 * DFF : BIN + (size_t)l * NB * ZC) + (size_t)fr * N + n0 + 4 * fq; *(f32x4*)bp = acc; }
    }
}

constexpr int AT_ROW = 272, AT_BUF = 2 * 64 * AT_ROW + 256  , AT_KS = 0, AT_VS = 64 * AT_ROW, AT_RSK = 2 * 64 * AT_ROW, AT_BIAS = 2 * AT_BUF, AT_GQ = AT_BIAS + 8 * 384 * 4;
static_assert(AT_GQ + 512 <= LDS_CTL, "attention LDS map");
constexpr float LOG2E = 1.4426950408889634f;
__device__ __forceinline__ int t5_bucket(int rel) { const int n = rel < 0 ? -rel : rel; int v; if (n < 8) v = n; else { v = (31 - __clz(n * n)) + 2; v = v > 15 ? 15 : v; } return (rel > 0 ? 16 : 0) + v; }
__device__ __forceinline__ s16x4 lds_tr16(LAS unsigned char* p) { typedef short v4i16_t __attribute__((ext_vector_type(4))); return __builtin_bit_cast(s16x4, __builtin_amdgcn_ds_read_tr16_b64_v4i16((LAS v4i16_t*)p)); }
__device__ __forceinline__ void phase_attn(const Frame& F0, const bf16_t* Z, const float* qg, const float* kg, const float* sink, const float* relb, bf16_t* MRG, float* SSQA) { const Frame F = fresh(F0);
    LAS unsigned char* lds = F.lds; const int tid = F.tid, lane = F.lane, w = F.wave, fr = lane & 15, fq = lane >> 4, g = w & 3, hq = w >> 2;
    LAS float* bias = (LAS float*)(lds + AT_BIAS);
    for (int i = tid; i < 8 * 384; i += 512) { const int h = i / 384, rel = i - 384 * h - 192; bias[i] = (rel >= -128 && rel <= 128) ? relb[t5_bucket(rel) * 8 + h] * LOG2E - 12.0f : -1e30f; }
    LAS float* gqt = (LAS float*)(lds + AT_GQ);
    if (tid < 128) gqt[tid] = qg[tid] * kg[tid];
    WG_BAR();
    const int p0 = tid, p1 = tid + 512;
    const int per_x = ((T / 64) * 2 + 7) / 8, slots = F.G / 8;
    for (int it_ = F.bid >> 3; it_ < per_x; it_ += slots) { const int item = (F.bid & 7) * per_x + it_; if (item >= (T / 64) * 2) break;
        const int qb = item >> 1, kvh = item & 1, q0 = qb * 64, h = kvh * 4 + g; int b_, t0, S; rowinfo(q0, b_, t0, S); const int seq0 = q0 - t0;
        bf16x8 Qf[2][4];
#pragma unroll
        for (int qt = 0; qt < 2; ++qt) { const bf16_t* qp = Z + (size_t)(q0 + 32 * hq + 16 * qt + fr) * ZC + ZQ + h * 128 + 8 * fq; u32x4 raw[4]; float ss = 0.f;
#pragma unroll
            for (int ks = 0; ks < 4; ++ks) { raw[ks] = *(const u32x4*)(qp + 32 * ks); const unsigned rw[4] = {raw[ks].x, raw[ks].y, raw[ks].z, raw[ks].w};
#pragma unroll
                for (int e = 0; e < 4; ++e) { const float a0 = bflo(rw[e]), a1 = bfhi(rw[e]); ss += a0 * a0 + a1 * a1; } }
            ss += __shfl_xor(ss, 16); ss += __shfl_xor(ss, 32);
            const float rs = rsqrtf(ss * (1.0f / 128.0f) + EPS) * (0.08838834764831845f * LOG2E);
#pragma unroll
            for (int ks = 0; ks < 4; ++ks) { const unsigned rw[4] = {raw[ks].x, raw[ks].y, raw[ks].z, raw[ks].w}; u32x4 o;
                const f32x4 g0 = *(const LAS f32x4*)(gqt + 32 * ks + 8 * fq), g1 = *(const LAS f32x4*)(gqt + 32 * ks + 8 * fq + 4);
                o.x = pg8::cvt_pk_bf16(bflo(rw[0]) * rs * g0[0], bfhi(rw[0]) * rs * g0[1]); o.y = pg8::cvt_pk_bf16(bflo(rw[1]) * rs * g0[2], bfhi(rw[1]) * rs * g0[3]);
                o.z = pg8::cvt_pk_bf16(bflo(rw[2]) * rs * g1[0], bfhi(rw[2]) * rs * g1[1]); o.w = pg8::cvt_pk_bf16(bflo(rw[3]) * rs * g1[2], bfhi(rw[3]) * rs * g1[3]);
                Qf[qt][ks] = __builtin_bit_cast(bf16x8, o); } }
        f32x4 O[8][2];
#pragma unroll
        for (int dt = 0; dt < 8; ++dt) { O[dt][0] = (f32x4){0.f, 0.f, 0.f, 0.f}; O[dt][1] = (f32x4){0.f, 0.f, 0.f, 0.f}; }
        float lsum[2] = {0.f, 0.f};
        const int c_lo = t0 >= 128 ? 0 : (128 - t0) / 64, c_hi = (t0 + 192 <= S) ? 4 : 4 - (t0 + 192 - S) / 64;
        u32x4 kr[2], vr[2];
#define AT_FETCH(c) do { const size_t rb = (size_t)(seq0 + t0 - 128 + 64 * (c)); \
          kr[0] = *(const u32x4*)(Z + (rb + (p0 >> 4)) * ZC + ZK + kvh * 128 + 8 * (p0 & 15)); kr[1] = *(const u32x4*)(Z + (rb + (p1 >> 4)) * ZC + ZK + kvh * 128 + 8 * (p1 & 15)); \
          vr[0] = *(const u32x4*)(Z + (rb + (p0 >> 4)) * ZC + ZV + kvh * 128 + 8 * (p0 & 15)); vr[1] = *(const u32x4*)(Z + (rb + (p1 >> 4)) * ZC + ZV + kvh * 128 + 8 * (p1 & 15)); } while (0)
#define AT_PARK(buf) do { LAS unsigned char* bb = lds + (buf) * AT_BUF; _Pragma("unroll") for (int i = 0; i < 2; ++i) { const int p = i ? p1 : p0, key = p >> 4, part = p & 15; \
                *(LAS u32x4*)(bb + AT_KS + key * AT_ROW + part * 16) = kr[i]; *(LAS u32x4*)(bb + AT_VS + key * AT_ROW + part * 16) = vr[i]; \
                const unsigned kw[4] = {kr[i].x, kr[i].y, kr[i].z, kr[i].w}; float ss = 0.f; \
                _Pragma("unroll") for (int e = 0; e < 4; ++e) { const float a0 = bflo(kw[e]), a1 = bfhi(kw[e]); ss += a0 * a0 + a1 * a1; } \
                ss += __shfl_xor(ss, 1); ss += __shfl_xor(ss, 2); ss += __shfl_xor(ss, 4); ss += __shfl_xor(ss, 8); \
                if (part == 0) ((LAS float*)(bb + AT_RSK))[key] = rsqrtf(ss * (1.0f / 128.0f) + EPS); } } while (0)
        AT_FETCH(c_lo);
        WG_BAR();
        AT_PARK(0);
        WG_BAR();
        for (int c = c_lo; c <= c_hi; ++c) { LAS unsigned char* bb = lds + ((c - c_lo) & 1) * AT_BUF;
            if (c < c_hi) AT_FETCH(c + 1);
            f32x4 Sx[4][2];
#pragma unroll
            for (int kt = 0; kt < 4; ++kt) { Sx[kt][0] = (f32x4){0.f, 0.f, 0.f, 0.f}; Sx[kt][1] = (f32x4){0.f, 0.f, 0.f, 0.f};
#pragma unroll
                for (int ks = 0; ks < 4; ++ks) { const bf16x8 kf = *(const LAS bf16x8*)(bb + AT_KS + (16 * kt + fr) * AT_ROW + (32 * ks + 8 * fq) * 2);
                    Sx[kt][0] = __builtin_amdgcn_mfma_f32_16x16x32_bf16(kf, Qf[0][ks], Sx[kt][0], 0, 0, 0); Sx[kt][1] = __builtin_amdgcn_mfma_f32_16x16x32_bf16(kf, Qf[1][ks], Sx[kt][1], 0, 0, 0); } }
            bf16x8 Pf[2][2];
            f32x4 rk[4];
#pragma unroll
            for (int kt = 0; kt < 4; ++kt) rk[kt] = *(const LAS f32x4*)(bb + AT_RSK + (16 * kt + 4 * fq) * 4);
#pragma unroll
            for (int qt = 0; qt < 2; ++qt) { float pv[4][4]; const LAS float* bp = bias + h * 384 + 64 * c + 64 + 4 * fq - (32 * hq + 16 * qt + fr);
#pragma unroll
                for (int kt = 0; kt < 4; ++kt)
#pragma unroll
                    for (int i = 0; i < 4; ++i) { const float p = __builtin_amdgcn_exp2f(Sx[kt][qt][i] * rk[kt][i] + bp[16 * kt + i]); pv[kt][i] = p; lsum[qt] += p; }
#pragma unroll
                for (int s = 0; s < 2; ++s) { u32x4 o; o.x = pg8::cvt_pk_bf16(pv[2 * s][0], pv[2 * s][1]); o.y = pg8::cvt_pk_bf16(pv[2 * s][2], pv[2 * s][3]); o.z = pg8::cvt_pk_bf16(pv[2 * s + 1][0], pv[2 * s + 1][1]); o.w = pg8::cvt_pk_bf16(pv[2 * s + 1][2], pv[2 * s + 1][3]);
                    Pf[qt][s] = __builtin_bit_cast(bf16x8, o); } }
#pragma unroll
            for (int dt = 0; dt < 8; ++dt)
#pragma unroll
                for (int s = 0; s < 2; ++s) { LAS unsigned char* vb = bb + AT_VS + (32 * s + 4 * fq + (fr >> 2)) * AT_ROW + (16 * dt + 4 * (fr & 3)) * 2;
                    const s16x4 lo = lds_tr16(vb), hi = lds_tr16(vb + 16 * AT_ROW);
                    const bf16x8 vf = (bf16x8){lo[0], lo[1], lo[2], lo[3], hi[0], hi[1], hi[2], hi[3]};
                    O[dt][0] = __builtin_amdgcn_mfma_f32_16x16x32_bf16(vf, Pf[0][s], O[dt][0], 0, 0, 0); O[dt][1] = __builtin_amdgcn_mfma_f32_16x16x32_bf16(vf, Pf[1][s], O[dt][1], 0, 0, 0); }
            if (c < c_hi) { AT_PARK(((c - c_lo) & 1) ^ 1); WG_BAR(); }
        }
#undef AT_FETCH
#undef AT_PARK
        const float sk = __builtin_amdgcn_exp2f(sink[h] * LOG2E - 12.0f);
#pragma unroll
        for (int qt = 0; qt < 2; ++qt) { float l = lsum[qt]; l += __shfl_xor(l, 16); l += __shfl_xor(l, 32); const float inv = 1.0f / (l + sk);
            const int row = q0 + 32 * hq + 16 * qt + fr; bf16_t* op = MRG + (size_t)row * D + h * 128 + 4 * fq; float ss = 0.f;
#pragma unroll
            for (int dt = 0; dt < 8; ++dt) { u32x2 o; o.x = pg8::cvt_pk_bf16(O[dt][qt][0] * inv, O[dt][qt][1] * inv); o.y = pg8::cvt_pk_bf16(O[dt][qt][2] * inv, O[dt][qt][3] * inv); *(u32x2*)(op + 16 * dt) = o;
                const float e0 = bflo(o.x), e1 = bfhi(o.x), e2 = bflo(o.y), e3 = bfhi(o.y); ss += (e0 * e0 + e1 * e1) + (e2 * e2 + e3 * e3); }
            ss += __shfl_xor(ss, 16); ss += __shfl_xor(ss, 32); if (fq == 0) SSQA[(size_t)row * 8 + h] = ss; }
    }
    WG_BAR();
}

constexpr int LR_HF = 0, LR_HF_ROW = 528, LR_XCB = 67584, LR_YG = 102656, LR_YG_ROW = 272, LR_END = 137472;
static_assert(LR_END <= LDS_CTL, "LRU LDS map");
__device__ __forceinline__ int xcb_off(int tok) { return tok * 272 + (tok >> 5) * 64; }
struct LruConsts { float ba_f, ba_b, bx_f, bx_b, sp_f, sp_b; };
__device__ __forceinline__ void lru_fetch_xr(const Frame& F, const bf16_t* Z, int row0, int n, unsigned (&xr)[19]) {
    const int cp = F.tid & 63, tg = F.tid >> 6, ch = 128 * n + 2 * cp; int b_, t0, S; rowinfo(row0, b_, t0, S);
#pragma unroll
    for (int i = 0; i < 19; ++i) { const int tt = t0 + 16 * tg - 2 + i; unsigned v = 0u; if (tt >= 0 && tt < S) v = *(const unsigned*)(Z + (size_t)(row0 + 16 * tg - 2 + i) * ZC + ZX + ch); xr[i] = v; }
}
__device__ __forceinline__ void lru_park_xc(const Frame& F, const float* cw, const float* cb, int n, const unsigned (&xr)[19]) {
    const int cp = F.tid & 63, tg = F.tid >> 6, ch = 128 * n + 2 * cp;
    const float w00 = cw[ch], w01 = cw[ch + 1], w10 = cw[1024 + ch], w11 = cw[1024 + ch + 1], w20 = cw[2048 + ch], w21 = cw[2048 + ch + 1], w30 = cw[3072 + ch], w31 = cw[3072 + ch + 1], b0 = cb[ch], b1 = cb[ch + 1];
#pragma unroll
    for (int i = 0; i < 16; ++i) { const float y0 = b0 + w00 * bflo(xr[i]) + w10 * bflo(xr[i + 1]) + w20 * bflo(xr[i + 2]) + w30 * bflo(xr[i + 3]), y1 = b1 + w01 * bfhi(xr[i]) + w11 * bfhi(xr[i + 1]) + w21 * bfhi(xr[i + 2]) + w31 * bfhi(xr[i + 3]);
        const int tk = 16 * tg + i; *(LAS unsigned*)(F.lds + LR_XCB + xcb_off(tk) + 4 * cp) = pk2(y0, y1); }
}
typedef _Float16 f16x8 __attribute__((ext_vector_type(8)));
__device__ __forceinline__ void lru_ab2(f32x2 ga, f32x2 gx, f32x2 xc, float ba, float bx, float sp, f32x2& la, f32x2& a, f32x2& b) {
    const f32x2 ta = (ga + ba) * (-LOG2E), tx = (gx + bx) * (-LOG2E);
    f32x2 da, dx; da.x = 1.0f + __builtin_amdgcn_exp2f(ta.x); da.y = 1.0f + __builtin_amdgcn_exp2f(ta.y); dx.x = 1.0f + __builtin_amdgcn_exp2f(tx.x); dx.y = 1.0f + __builtin_amdgcn_exp2f(tx.y);
    const f32x2 dd = da * dx; f32x2 rc; rc.x = __builtin_amdgcn_rcpf(dd.x); rc.y = __builtin_amdgcn_rcpf(dd.y);
    const f32x2 r = dx * rc, ig = da * rc;
    la = r * (-8.0f * sp);
    const f32x2 tl = la * LOG2E; a.x = __builtin_amdgcn_exp2f(tl.x); a.y = __builtin_amdgcn_exp2f(tl.y);
    const f32x2 x2 = la * 2.0f;
    const f32x2 ser = -x2 * (1.0f + x2 * (0.5f + x2 * 0.16666667f)), alt = (1.0f - a) * (1.0f + a);
    f32x2 om; om.x = x2.x > -0.25f ? ser.x : alt.x; om.y = x2.y > -0.25f ? ser.y : alt.y;
    f32x2 sq; sq.x = __builtin_amdgcn_sqrtf(om.x); sq.y = __builtin_amdgcn_sqrtf(om.y);
    b = sq * ig * xc;
}
__device__ __forceinline__ void lru_load_w(const bf16_t* LWl, int n, int w, int lane, int gs, bf16x8 (&Wf)[4]) {
    int lo = lane * 8; asm volatile("" : "+v"(lo));
#pragma unroll
    for (int ks = 0; ks < 4; ++ks) Wf[ks] = *(const bf16x8*)(LWl + (size_t)(((n * 8 + w) * 4 + gs) * 4 + ks) * 512 + lo);
}
__device__ __forceinline__ LruConsts lru_consts(const float* b_a, const float* b_x, const float* lam, int ch) {
    LruConsts c; c.ba_f = b_a[ch]; c.ba_b = b_a[1024 + ch]; c.bx_f = b_x[ch]; c.bx_b = b_x[1024 + ch]; c.sp_f = lam[ch]; c.sp_b = lam[1024 + ch]; return c;
}
__device__ __forceinline__ void phase_lru1(const Frame& F0, const bf16_t* Z, const bf16_t* LWl, const float* cw, const float* cb, const float* b_a, const float* b_x, const float* lam, float* SUM, f16x8* LC) { const Frame F = fresh(F0);
    const int lane = F.lane, w = F.wave, fr = lane & 15, fq = lane >> 4, n = F.bid & 7, ch = 128 * n + 16 * w + fr;
    bf16x8 Waf[4], Wab[4], Wxf[4], Wxb[4]; lru_load_w(LWl, n, w, lane, 0, Waf); lru_load_w(LWl, n, w, lane, 1, Wab); lru_load_w(LWl, n, w, lane, 2, Wxf); lru_load_w(LWl, n, w, lane, 3, Wxb);
    const LruConsts C = lru_consts(b_a, b_x, lam, ch);
    const int arow = 32 * (fr >> 2) + (fr & 3);
    unsigned xr[19];
    if (F.bid < (T / 128) * 8) lru_fetch_xr(F, Z, (F.bid >> 3) * 128, n, xr);
    for (int item = F.bid; item < (T / 128) * 8; item += F.G) { const int chunk = item >> 3;
        WG_BAR(); lru_park_xc(F, cw, cb, n, xr);
        if (item + F.G < (T / 128) * 8) lru_fetch_xr(F, Z, ((item + F.G) >> 3) * 128, n, xr);
        asm volatile("s_waitcnt lgkmcnt(0)" ::: "memory"); __builtin_amdgcn_s_barrier(); asm volatile("" ::: "memory");
        float RAf = 1.f, RBf = 0.f, RAb = 1.f, RBb = 0.f;
#pragma unroll 2
        for (int tau = 0; tau < 8; ++tau) {
            f32x4 gaf = (f32x4){0.f, 0.f, 0.f, 0.f}, gab = gaf, gxf = gaf, gxb = gaf;
#pragma unroll
            for (int ks = 0; ks < 4; ++ks) { const bf16x8 af = *(const LAS bf16x8*)(F.lds + LR_XCB + xcb_off(arow + 4 * tau) + (32 * ks + 8 * fq) * 2);
                gaf = __builtin_amdgcn_mfma_f32_16x16x32_bf16(af, Waf[ks], gaf, 0, 0, 0); gab = __builtin_amdgcn_mfma_f32_16x16x32_bf16(af, Wab[ks], gab, 0, 0, 0);
                gxf = __builtin_amdgcn_mfma_f32_16x16x32_bf16(af, Wxf[ks], gxf, 0, 0, 0); gxb = __builtin_amdgcn_mfma_f32_16x16x32_bf16(af, Wxb[ks], gxb, 0, 0, 0); }
            float xc[4];
#pragma unroll
            for (int i = 0; i < 4; ++i) xc[i] = bf2f(*(const LAS bf16_t*)(F.lds + LR_XCB + xcb_off(32 * fq + 4 * tau + i) + (16 * w + fr) * 2));
            f16x8 cf, cbk;
#pragma unroll
            for (int p = 0; p < 2; ++p) { f32x2 la, a, b; const f32x2 x = (f32x2){xc[2 * p], xc[2 * p + 1]};
                lru_ab2((f32x2){gaf[2 * p], gaf[2 * p + 1]}, (f32x2){gxf[2 * p], gxf[2 * p + 1]}, x, C.ba_f, C.bx_f, C.sp_f, la, a, b);
                RBf = a.x * RBf + b.x; RAf = a.x * RAf; RBf = a.y * RBf + b.y; RAf = a.y * RAf;
                cf[4 * p] = (_Float16)la.x; cf[4 * p + 1] = (_Float16)b.x; cf[4 * p + 2] = (_Float16)la.y; cf[4 * p + 3] = (_Float16)b.y;
                lru_ab2((f32x2){gab[2 * p], gab[2 * p + 1]}, (f32x2){gxb[2 * p], gxb[2 * p + 1]}, x, C.ba_b, C.bx_b, C.sp_b, la, a, b);
                RBb = RAb * b.x + RBb; RAb = RAb * a.x; RBb = RAb * b.y + RBb; RAb = RAb * a.y;
                cbk[4 * p] = (_Float16)la.x; cbk[4 * p + 1] = (_Float16)b.x; cbk[4 * p + 2] = (_Float16)la.y; cbk[4 * p + 3] = (_Float16)b.y; }
            f16x8* cp = LC + ((size_t)(item * 8 + w) * 16 + tau) * 64 + lane;
            __builtin_nontemporal_store(cf, cp); __builtin_nontemporal_store(cbk, cp + 8 * 64); }
#pragma unroll
        for (int st = 0; st < 2; ++st) { const int o = 16 << st; const bool early = ((fq >> st) & 1) == 0;
            const float pAf = __shfl_xor(RAf, o), pBf = __shfl_xor(RBf, o), pAb = __shfl_xor(RAb, o), pBb = __shfl_xor(RBb, o);
            const float XAf = early ? RAf : pAf, XBf = early ? RBf : pBf, YAf = early ? pAf : RAf, YBf = early ? pBf : RBf;
            const float XAb = early ? RAb : pAb, XBb = early ? RBb : pBb, YAb = early ? pAb : RAb, YBb = early ? pBb : RBb;
            RAf = YAf * XAf; RBf = YAf * XBf + YBf; RAb = XAb * YAb; RBb = XAb * YBb + XBb; }
        if (fq == 0) { float* s = SUM + (size_t)chunk * 4096 + ch; s[0] = RAf; s[1024] = RBf; s[2048] = RAb; s[3072] = RBb; }
    }
    WG_BAR();
}
__device__ __forceinline__ void phase_lru_carry(const Frame& F0, const float* SUM, float* CAR) { const Frame F = fresh(F0);
    for (int id = F.bid * 512 + F.tid; id < NB * 2048; id += F.G * 512) { const int s = id >> 11, dir = (id >> 10) & 1, ch = id & 1023;
        const int c0 = s < 2 ? 64 * s : 128 + 32 * (s - 2), nc = s < 2 ? 64 : 32; float h = 0.f;
        for (int j0 = 0; j0 < nc; j0 += 8) { float A[8], B[8];
#pragma unroll
            for (int k = 0; k < 8; ++k) { const int j = dir == 0 ? j0 + k : nc - 1 - (j0 + k); const size_t o = (size_t)(c0 + j) * 4096 + (dir ? 2048 : 0) + ch; A[k] = SUM[o]; B[k] = SUM[o + 1024]; }
#pragma unroll
            for (int k = 0; k < 8; ++k) { const int j = dir == 0 ? j0 + k : nc - 1 - (j0 + k); CAR[(size_t)(c0 + j) * 2048 + (dir ? 1024 : 0) + ch] = h; h = A[k] * h + B[k]; } } }
}
__device__ __forceinline__ void lru_unpack_ab(const f16x8 (&c)[8], float (&a)[32], float (&b)[32]) {
#pragma unroll
    for (int tau = 0; tau < 8; ++tau)
#pragma unroll
        for (int i = 0; i < 4; ++i) { a[4 * tau + i] = __builtin_amdgcn_exp2f((float)c[tau][2 * i] * LOG2E); b[4 * tau + i] = (float)c[tau][2 * i + 1]; }
}
__device__ __forceinline__ void phase_lru2(const Frame& F0, const bf16_t* Z, const f16x8* LC, const float* CAR, bf16_t* MRG, float* SSQL) { const Frame F = fresh(F0);
    const int lane = F.lane, w = F.wave, fr = lane & 15, fq = lane >> 4, n = F.bid & 7, ch = 128 * n + 16 * w + fr;
    constexpr int NITEM = (T / 128) * 8;
    f16x8 cf_[8], cb_[8]; float cf = 0.f, cbk = 0.f; u32x4 yv[4];
#define LR2_FETCH(it) do { const int chunk_ = (it) >> 3; const f16x8* cp_ = LC + (size_t)((it) * 8 + w) * 16 * 64 + lane; \
        _Pragma("unroll") for (int tau = 0; tau < 8; ++tau) { cf_[tau] = __builtin_nontemporal_load(cp_ + tau * 64); cb_[tau] = __builtin_nontemporal_load(cp_ + (8 + tau) * 64); } \
        cf = CAR[(size_t)chunk_ * 2048 + ch]; cbk = CAR[(size_t)chunk_ * 2048 + 1024 + ch]; \
        _Pragma("unroll") for (int i = 0; i < 4; ++i) { const int p = F.tid + 512 * i, tk = p >> 4, part = p & 15; yv[i] = *(const u32x4*)(Z + (size_t)(chunk_ * 128 + tk) * ZC + ZY + 128 * n + 8 * part); } } while (0)
    if (F.bid < NITEM) LR2_FETCH(F.bid);
    for (int item = F.bid; item < NITEM; item += F.G) { const int chunk = item >> 3, row0 = chunk * 128;
        WG_BAR();
#pragma unroll
        for (int i = 0; i < 4; ++i) { const int p = F.tid + 512 * i, tk = p >> 4, part = p & 15; *(LAS u32x4*)(F.lds + LR_YG + tk * LR_YG_ROW + part * 16) = yv[i]; }
        float a[32], b[32], hf[32]; const float cfw = cf, cbw = cbk;
        lru_unpack_ab(cf_, a, b);
        { float IA = 1.f, IB = 0.f;
#pragma unroll
          for (int t = 0; t < 32; ++t) { IB = a[t] * IB + b[t]; IA = a[t] * IA; }
          { const float xA = __shfl_up(IA, 16), xB = __shfl_up(IB, 16); if (fq >= 1) { IB = IA * xB + IB; IA = IA * xA; } }
          { const float xA = __shfl_up(IA, 32), xB = __shfl_up(IB, 32); if (fq >= 2) { IB = IA * xB + IB; IA = IA * xA; } }
          float EA = __shfl_up(IA, 16), EB = __shfl_up(IB, 16); if (fq == 0) { EA = 1.f; EB = 0.f; }
          float h = EA * cfw + EB;
#pragma unroll
          for (int t = 0; t < 32; ++t) { h = a[t] * h + b[t]; hf[t] = h; } }
        lru_unpack_ab(cb_, a, b);
        if (item + F.G < NITEM) LR2_FETCH(item + F.G);
        asm volatile("s_waitcnt lgkmcnt(0)" ::: "memory"); __builtin_amdgcn_s_barrier(); asm volatile("" ::: "memory");
        { float IA = 1.f, IB = 0.f;
#pragma unroll
          for (int t = 31; t >= 0; --t) { IB = a[t] * IB + b[t]; IA = a[t] * IA; }
          { const float xA = __shfl_down(IA, 16), xB = __shfl_down(IB, 16); if (fq <= 2) { IB = IA * xB + IB; IA = IA * xA; } }
          { const float xA = __shfl_down(IA, 32), xB = __shfl_down(IB, 32); if (fq <= 1) { IB = IA * xB + IB; IA = IA * xA; } }
          float EA = __shfl_down(IA, 16), EB = __shfl_down(IB, 16); if (fq == 3) { EA = 1.f; EB = 0.f; }
          float h = EA * cbw + EB;
#pragma unroll
          for (int t = 31; t >= 0; --t) { h = a[t] * h + b[t]; LAS bf16_t* yp = (LAS bf16_t*)(F.lds + LR_YG + (32 * fq + t) * LR_YG_ROW + (16 * w + fr) * 2);
              *yp = (bf16_t)f2bf((hf[t] + h) * pg8::gelu_tanh_f(bf2f(*yp))); if ((t & 7) == 0) __builtin_amdgcn_sched_barrier(0); } }
        asm volatile("s_waitcnt lgkmcnt(0)" ::: "memory"); __builtin_amdgcn_s_barrier(); asm volatile("" ::: "memory");
#pragma unroll
        for (int i = 0; i < 4; ++i) { const int p = F.tid + 512 * i, tk = p >> 4, part = p & 15; const u32x4 v = *(const LAS u32x4*)(F.lds + LR_YG + tk * LR_YG_ROW + part * 16);
            *(u32x4*)(MRG + (size_t)(row0 + tk) * D + 1024 + 128 * n + 8 * part) = v;
            float ss = (bflo(v.x) * bflo(v.x) + bfhi(v.x) * bfhi(v.x)) + (bflo(v.y) * bflo(v.y) + bfhi(v.y) * bfhi(v.y)) + (bflo(v.z) * bflo(v.z) + bfhi(v.z) * bfhi(v.z)) + (bflo(v.w) * bflo(v.w) + bfhi(v.w) * bfhi(v.w));
            ss += __shfl_xor(ss, 1); ss += __shfl_xor(ss, 2); ss += __shfl_xor(ss, 4); ss += __shfl_xor(ss, 8); if (part == 0) SSQL[(size_t)(row0 + tk) * 8 + n] = ss; }
    }
#undef LR2_FETCH
    WG_BAR();
}

__device__ __forceinline__ void phase_glu_fix(const Frame& F0, const float* HALO, const float* cw, const float* cb, bf16_t* ACT) { const Frame F = fresh(F0);
    for (int id = F.bid * 512 + F.tid; id < 384 * (DFF / 4); id += F.G * 512) { const int e = id / (DFF / 4), c = (id - e * (DFF / 4)) * 4, pm = e >> 1, side = e & 1, row = 256 * pm + (side ? 255 : 0);
        int b_, t, S; rowinfo(row, b_, t, S);
        const float* hp = HALO + (size_t)pm * 6 * DFF + c; const f32x4 z = (f32x4){0.f, 0.f, 0.f, 0.f};
        f32x4 gp, gc, gn, up;
        if (side == 0) { gp = t == 0 ? z : *(const f32x4*)(hp - 6 * DFF + 3 * DFF); gc = *(const f32x4*)(hp); gn = *(const f32x4*)(hp + DFF); up = *(const f32x4*)(hp + 4 * DFF); }
        else { gp = *(const f32x4*)(hp + 2 * DFF); gc = *(const f32x4*)(hp + 3 * DFF); gn = t == S - 1 ? z : *(const f32x4*)(hp + 6 * DFF); up = *(const f32x4*)(hp + 5 * DFF); }
        const f32x4 g = *(const f32x4*)(cw + c) * gp + *(const f32x4*)(cw + DFF + c) * gc + *(const f32x4*)(cw + 2 * DFF + c) * gn + *(const f32x4*)(cb + c);
        u32x2 o; o.x = pg8::cvt_pk_bf16(pg8::gelu_tanh_f(g[0]) * up[0], pg8::gelu_tanh_f(g[1]) * up[1]); o.y = pg8::cvt_pk_bf16(pg8::gelu_tanh_f(g[2]) * up[2], pg8::gelu_tanh_f(g[3]) * up[3]);
        *(u32x2*)(ACT + (size_t)row * DFF + c) = o; }
}

constexpr int PH_PER_LAYER = 11, PH0 = 2, N_PHASES = PH0 + DEPTH * PH_PER_LAYER;
#ifndef PHMASK
#define PHMASK 0xfff
#endif
#define PEN(k) ((PHMASK >> (k)) & 1)
#ifndef DBLMASK
#define DBLMASK 0
#endif
#define REP(k) for (int rep_ = 0; rep_ < 1 + ((DBLMASK >> (k)) & 1); ++rep_)
__global__ void __launch_bounds__(NWAVES * 64, 2) mega_fwd(Args a) {
    extern __shared__ __attribute__((aligned(16))) unsigned char lds_raw[];
    Frame F; F.lds = (LAS unsigned char*)lds_raw; F.tid = threadIdx.x; F.lane = F.tid & 63; F.wave = __builtin_amdgcn_readfirstlane(F.tid >> 6); F.G = gridDim.x; F.bid = blockIdx.x;
    unsigned char* ws = karg_ws();
    volatile LAS unsigned* MISC = (volatile LAS unsigned*)(F.lds + LDS_CTL);
    if (F.tid < 64) MISC[F.tid] = 0u;
    __syncthreads();
    const int lo = a.ph_lo, hi = a.ph_hi;
    XcdBarrier bar; bar.bar = (unsigned*)(ws + WS_CTL) + CW_BAR; bar.x = 0; bar.st = MISC; bar.wv = F.wave;
    if (hi - lo > 1) bar = xcd_barrier_post((unsigned*)(ws + WS_CTL) + CW_BAR, MISC, F.wave);
#define IN(k) (lo <= (k) && (k) < hi)
#define SEAM(k) do { if (IN(k) && IN((k) + 1)) xcd_barrier(bar); } while (0)
#define WSP(type, off) ((type*)(karg_ws() + (off)))
    PG8_LAS unsigned char* ring = (PG8_LAS unsigned char*)lds_raw;

    if (PEN(0) && IN(0)) { REP(0) phase_prologue(F, a); } SEAM(0);
    if (PEN(11) && IN(1)) { phase_bias(F, WSP(float, WS_MOD), WSP(bf16_t, WS_WIN), WSP(bf16_t, WS_WGU), WSP(float, WS_BIN), WSP(float, WS_BGU)); phase_norm0(F, karg_in(0), karg_in(1), WSP(float, WS_MOD), WSP(bf16_t, WS_H), WSP(float, WS_RSTD)); } SEAM(1);
    for (int l = 0; l < DEPTH; ++l) {
        const int pb = PH0 + PH_PER_LAYER * l;
        const float* bp = l == 0 ? karg_in(0) : karg_out(); const float* bs = l == 0 ? karg_in(1) : karg_out() + (size_t)ROWS_P * D;
        if (PEN(1) && IN(pb + 0)) { if (l > 0) phase_rstd(F, 0, WSP(float, WS_SSQX), WSP(float, WS_RSTD), nullptr, nullptr, nullptr, nullptr); } SEAM(pb + 0);
        if (PEN(2) && IN(pb + 1)) { REP(2) { pg8::Gemm g{WSP(bf16_t, WS_H), WSP(bf16_t, WS_WIN) + (size_t)l * ZC * D, T, ZC, D}; pg8::StaticOrder S; S.init(T, ZC, F.G, F.bid); pg8::EpiStoreBf16N E{WSP(bf16_t, WS_Z), ZC, WSP(float, WS_RSTD), WSP(float, WS_BIN) + (size_t)l * NB * ZC};
            pg8::gemm_phase(ring, g, S, E, pg8::IdentMap{}, F.wave); } } SEAM(pb + 1);
        if (IN(pb + 2)) {
            if (PEN(3)) REP(3) phase_attn(F, WSP(bf16_t, WS_Z), karg_in(10) + l * 128, karg_in(11) + l * 128, karg_in(12) + l * 8, karg_in(4), WSP(bf16_t, WS_MRG), WSP(float, WS_SSQA));
            if (PEN(4)) REP(4) phase_lru1(F, WSP(bf16_t, WS_Z), WSP(bf16_t, WS_LW) + (size_t)l * 512 * 1024, karg_in(13) + (size_t)l * 4096, karg_in(14) + l * 1024, karg_in(16) + l * 2048, karg_in(18) + l * 2048, WSP(float, WS_LSP) + l * 2048, WSP(float, WS_SUM), (f16x8*)karg_out()); } SEAM(pb + 2);
        if (IN(pb + 3)) { if (PEN(5)) REP(5) phase_lru_carry(F, WSP(float, WS_SUM), WSP(float, WS_CAR)); } SEAM(pb + 3);
        if (IN(pb + 4)) { if (PEN(6)) REP(6) phase_lru2(F, WSP(bf16_t, WS_Z), (const f16x8*)karg_out(), WSP(float, WS_CAR), WSP(bf16_t, WS_MRG), WSP(float, WS_SSQL)); } SEAM(pb + 4);
        if (PEN(7) && IN(pb + 5)) { phase_rstd(F, 1, nullptr, nullptr, WSP(float, WS_SSQA), WSP(float, WS_SSQL), WSP(float, WS_RATIO), WSP(float, WS_S2)); } SEAM(pb + 5);
        if (PEN(8) && IN(pb + 6)) for (int rep_ = 0; rep_ < 1 + ((l == 0) ? ((DBLMASK >> 8) & 1) : 0); ++rep_) { const float* modl = WSP(float, WS_MOD) + (size_t)l * NB * MODSTRIDE; pg8::Gemm g{WSP(bf16_t, WS_MRG), WSP(bf16_t, WS_WOUT) + (size_t)l * D * D, T, D, D}; pg8::StaticOrder S; S.init(T, D, F.G, F.bid);
            pg8::EpiResid2<true> E{modl + D, nullptr, modl + 2 * D, modl + 4 * D, WSP(bf16_t, WS_H), WSP(float, WS_SSQX), WSP(float, WS_RATIO), WSP(float, WS_S2)}; pg8::gemm_phase(ring, g, S, E, pg8::IdentMap{}, F.wave); } SEAM(pb + 6);
        if (PEN(1) && IN(pb + 7)) { phase_rstd(F, 0, WSP(float, WS_SSQX), WSP(float, WS_RSTD), nullptr, nullptr, nullptr, nullptr); } SEAM(pb + 7);
        if (IN(pb + 8)) { if (PEN(9)) REP(9) { pg8::Gemm g{WSP(bf16_t, WS_H), WSP(bf16_t, WS_WGU) + (size_t)l * 2 * DFF * D, T, 2 * DFF, D}; pg8::StaticOrder S; S.init(T, 2 * DFF, F.G, F.bid);
            pg8::EpiGLU2 E{WSP(bf16_t, WS_ACT), karg_in(25) + (size_t)l * 3 * DFF, karg_in(26) + l * DFF, WSP(float, WS_RSTD), WSP(float, WS_BGU) + (size_t)l * NB * 2 * DFF, WSP(float, WS_HALO), (PG8_LAS float*)(ring + pg8::STAGE_BYTES)};
            pg8::gemm_phase(ring, g, S, E, pg8::IdentMap{}, F.wave); } } SEAM(pb + 8);
        if (IN(pb + 9)) { if (PEN(9)) phase_glu_fix(F, WSP(float, WS_HALO), karg_in(25) + (size_t)l * 3 * DFF, karg_in(26) + l * DFF, WSP(bf16_t, WS_ACT)); } SEAM(pb + 9);
        if (IN(pb + 10)) { if (PEN(10)) { const float* modl = WSP(float, WS_MOD) + (size_t)l * NB * MODSTRIDE; pg8::Gemm g{WSP(bf16_t, WS_ACT), WSP(bf16_t, WS_WDN) + (size_t)l * D * DFF, T, D, DFF}; pg8::StaticOrder S; S.init(T, D, F.G, F.bid);
            pg8::EpiResid2<false> E{modl + 4 * D, l + 1 < DEPTH ? nullptr : karg_out(), modl + 5 * D, l + 1 < DEPTH ? modl + (size_t)NB * MODSTRIDE + D : nullptr, WSP(bf16_t, WS_H), WSP(float, WS_SSQX), nullptr, nullptr};
            pg8::gemm_phase(ring, g, S, E, pg8::IdentMap{}, F.wave); } } SEAM(pb + 10);
    }
#undef IN
#undef SEAM
}
#ifndef HYB
#define HYB 0
#endif
extern "C" void kernel_launch(void* const* d_in, const int* in_sizes, int n_in, void* d_out, int out_size, void* d_ws, size_t ws_size, hipStream_t stream) {
    static int grid = 0;
    if (grid == 0) {
        if (n_in != 28 || ws_size < WS_END || out_size != T * D) { fprintf(stderr, "kernel_launch: unexpected sizes (n_in %d, ws %zu, out %d)\n", n_in, ws_size, out_size); grid = -1; return; }
        int dev = 0, cus = 0, per_cu = 0;
        if (hipGetDevice(&dev) != hipSuccess || hipDeviceGetAttribute(&cus, hipDeviceAttributeMultiprocessorCount, dev) != hipSuccess) { grid = -1; return; }
        if (hipFuncSetAttribute((const void*)mega_fwd, hipFuncAttributeMaxDynamicSharedMemorySize, LDS_BYTES) != hipSuccess) { fprintf(stderr, "kernel_launch: hipFuncSetAttribute failed\n"); grid = -1; return; }
        if (hipOccupancyMaxActiveBlocksPerMultiprocessor(&per_cu, (const void*)mega_fwd, NWAVES * 64, LDS_BYTES) != hipSuccess || per_cu < 1) { fprintf(stderr, "kernel_launch: occupancy query says %d blocks per CU\n", per_cu); grid = -1; (void)hipGetLastError(); return; }
        grid = cus & ~7;
    }
    if (grid < 0) return;
    (void)hipMemsetAsync((char*)d_ws + WS_CTL, 0, CTL_ZERO_BYTES, stream);
    Args a{};
    for (int i = 0; i < 28; ++i) a.in[i] = (const float*)d_in[i];
    a.out = (float*)d_out; a.ws = (unsigned char*)d_ws; a.flags = 0; a.pad = 0;
#if HYB & 8
    for (int p = 0; p < N_PHASES; ++p) { a.ph_lo = p; a.ph_hi = p + 1; hipLaunchKernelGGL(mega_fwd, dim3(grid), dim3(NWAVES * 64), LDS_BYTES, stream, a); }
#else
    a.ph_lo = 0; a.ph_hi = N_PHASES; hipLaunchKernelGGL(mega_fwd, dim3(grid), dim3(NWAVES * 64), LDS_BYTES, stream, a);
#endif
}
```

```cpp
#include <hip/hip_runtime.h>
#include <cstdio>
#include <cstdint>
#define HYB 0
#define DBLMASK 0

namespace pg8 {
#define PG8_LAS __attribute__((address_space(3)))
typedef unsigned short bf16_t;
typedef short bf16x8 __attribute__((ext_vector_type(8)));
typedef float f32x4 __attribute__((ext_vector_type(4)));
typedef unsigned u32x4 __attribute__((ext_vector_type(4)));
constexpr int BM = 256, BK = 64, HALF = 128, HTB = HALF * BK * 2  , STAGE_BYTES = 8 * HTB, NXCD = 8, WGM = 4;

__host__ __device__ __forceinline__ int lds_byte(int r, int c) { const int st = (r >> 4) * 2 + (c >> 5), rr = r & 15, cc = c & 31, ob = rr * 64 + cc * 2; return st * 1024 + (ob ^ (((ob >> 9) & 1) << 5)); }
__host__ __device__ __forceinline__ void stage_rc(int b, int& R, int& C) { const int st = b / 1024, sb = b % 1024, swz = sb ^ (((sb >> 9) & 1) << 5); R = (st >> 1) * 16 + swz / 64; C = (st & 1) * 32 + (swz % 64) / 2; }
__host__ __device__ __forceinline__ int perm32(int rho) { const int n = rho >> 4, i = rho & 15; return 8 * (i >> 2) + 4 * n + (i & 3); }

struct Unit { int pm, pn; };
struct Gemm { const bf16_t* A; const bf16_t* Bt; int M, N, K; };

struct StaticOrder {
    int nM, nN, nwg, G, c;
    __host__ __device__ void init(int M, int N, int G_, int c_) { nM = M / BM; nN = N / BM; nwg = nM * nN; G = G_; c = c_; }
    __host__ __device__ bool next(int i, Unit& u) const {
        const long L = (long)i * G + c; if (L >= nwg) return false;
        int wgid = (int)L; { const int q = nwg / NXCD, r = nwg % NXCD, xcd = wgid % NXCD, off = wgid / NXCD; wgid = (xcd < r ? xcd * (q + 1) : r * (q + 1) + (xcd - r) * q) + off; }
        const int nig = WGM * nN, gid = wgid / nig, fm = gid * WGM, gsz = (nM - fm) < WGM ? (nM - fm) : WGM;
        u.pm = fm + ((wgid % nig) % gsz); u.pn = (wgid % nig) / gsz; return true;
    }
    __device__ __forceinline__ void a_ready(const Unit&) const {}
    __device__ __forceinline__ void done(const Unit&) const {}
};

__device__ __forceinline__ unsigned cvt_pk_bf16(float lo, float hi) { unsigned r; asm volatile("v_cvt_pk_bf16_f32 %0, %1, %2" : "=v"(r) : "v"(lo), "v"(hi)); return r; }
typedef float f32x2 __attribute__((ext_vector_type(2)));
typedef unsigned u32x2 __attribute__((ext_vector_type(2)));
constexpr int ROWS_P = 16384;
constexpr int MODSTRIDE = 12288;
__device__ __forceinline__ int batch_of_row(int row) { return row < ROWS_P ? (row >> 13) : 2 + ((row - ROWS_P) >> 12); }

struct EpiStoreBf16 {
    static constexpr bool PERM = true, PERMA = false, AFTER_DRAIN = false, HAS_MID = false;
    bf16_t* O; int ldc;
    __device__ __forceinline__ void operator()(const f32x4 (&acc)[2][2][4][2], const Unit& u, int wr, int wc, int fr_, int fq_) const {
        int fr = fr_, fq = fq_; asm volatile("" : "+v"(fr), "+v"(fq));
        const int row0 = u.pm * BM + wr * 64 + fr, col0 = u.pn * BM + wc * 32 + 8 * fq;
#pragma unroll
        for (int ai = 0; ai < 2; ++ai)
#pragma unroll
            for (int m = 0; m < 4; ++m) { bf16_t* rowp = O + (size_t)(row0 + ai * HALF + m * 16) * ldc + col0;
#pragma unroll
                for (int bj = 0; bj < 2; ++bj) { const f32x4 v0 = acc[ai][bj][m][0], v1 = acc[ai][bj][m][1];
                    u32x4 w; w.x = cvt_pk_bf16(v0[0], v0[1]); w.y = cvt_pk_bf16(v0[2], v0[3]); w.z = cvt_pk_bf16(v1[0], v1[1]); w.w = cvt_pk_bf16(v1[2], v1[3]);
                    *(u32x4*)(rowp + bj * HALF) = w; } }
    }
};
struct EpiResid {
    static constexpr bool PERM = false, PERMA = false, AFTER_DRAIN = false, HAS_MID = false;
    const float* base_p; const float* base_s; float* out; const float* gate; int row_off;
    __device__ __forceinline__ void operator()(const f32x4 (&acc)[2][2][4][2], const Unit& u, int wr, int wc, int fr_, int fq_) const {
        int fr = fr_, fq = fq_; asm volatile("" : "+v"(fr), "+v"(fq));
        const int grow0 = row_off + u.pm * BM; const int b = batch_of_row(grow0);
        const float* g = gate + (size_t)b * MODSTRIDE;
        const float* bt = grow0 < ROWS_P ? base_p + (size_t)grow0 * 2048 : base_s + (size_t)(grow0 - ROWS_P) * 2048;
        float* ot = out + (size_t)grow0 * 2048;
        const int col0 = u.pn * BM + wc * 32 + 4 * fq;
        f32x4 gv[2][2];
#pragma unroll
        for (int bj = 0; bj < 2; ++bj)
#pragma unroll
            for (int n = 0; n < 2; ++n) gv[bj][n] = *(const f32x4*)(g + col0 + bj * HALF + n * 16);
#pragma unroll
        for (int ai = 0; ai < 2; ++ai)
#pragma unroll
            for (int m = 0; m < 4; ++m) { const size_t off = (size_t)(wr * 64 + fr + ai * HALF + m * 16) * 2048 + col0;
#pragma unroll
                for (int bj = 0; bj < 2; ++bj)
#pragma unroll
                    for (int n = 0; n < 2; ++n) { const f32x4 bs = *(const f32x4*)(bt + off + bj * HALF + n * 16);
                        *(f32x4*)(ot + off + bj * HALF + n * 16) = bs + gv[bj][n] * acc[ai][bj][m][n]; }
                asm volatile("" ::: "memory"); }
    }
};
struct EpiStoreBf16N {
    static constexpr bool PERM = true, PERMA = false, AFTER_DRAIN = false, HAS_MID = false;
    bf16_t* O; int ldc; const float* rstd; const float* bias;
    __device__ __forceinline__ void operator()(const f32x4 (&acc)[2][2][4][2], const Unit& u, int wr, int wc, int fr_, int fq_) const {
        int fr = fr_, fq = fq_; asm volatile("" : "+v"(fr), "+v"(fq));
        const int row0 = u.pm * BM + wr * 64 + fr, col0 = u.pn * BM + wc * 32 + 8 * fq;
        const float* bp = bias + (size_t)batch_of_row(u.pm * BM) * ldc + col0;
        f32x4 bv[2][2];
#pragma unroll
        for (int bj = 0; bj < 2; ++bj)
#pragma unroll
            for (int n = 0; n < 2; ++n) bv[bj][n] = *(const f32x4*)(bp + bj * HALF + 4 * n);
#pragma unroll
        for (int ai = 0; ai < 2; ++ai)
#pragma unroll
            for (int m = 0; m < 4; ++m) { const int r = row0 + ai * HALF + m * 16; const float rs = rstd[r]; bf16_t* rowp = O + (size_t)r * ldc + col0;
#pragma unroll
                for (int bj = 0; bj < 2; ++bj) { const f32x4 v0 = acc[ai][bj][m][0] * rs + bv[bj][0], v1 = acc[ai][bj][m][1] * rs + bv[bj][1];
                    u32x4 w; w.x = cvt_pk_bf16(v0[0], v0[1]); w.y = cvt_pk_bf16(v0[2], v0[3]); w.z = cvt_pk_bf16(v1[0], v1[1]); w.w = cvt_pk_bf16(v1[2], v1[3]);
                    *(u32x4*)(rowp + bj * HALF) = w; } }
    }
};
template <bool MID> struct EpiResid2 {
    static constexpr bool PERM = true, PERMA = false, AFTER_DRAIN = false, HAS_MID = MID;
    const float* gmo; float* out32; const float* gate; const float* gm; bf16_t* XG; float* SSQ; const float* ratio; const float* s2;
    __device__ __forceinline__ void mid(f32x4 (&acc)[2][2][4][2], const Unit& u, int wr, int fr) const {
        unsigned z_ = 0u; asm volatile("" : "+v"(z_)); const int fq = (int)__builtin_amdgcn_mbcnt_hi(~0u, __builtin_amdgcn_mbcnt_lo(~0u, z_)) >> 4, base = u.pm * BM + wr * 64 + fr + (fq >> 1) * HALF + (fq & 1) * 32;
        const float v0 = ratio[base], v1 = ratio[base + 16];
#pragma unroll
        for (int ai = 0; ai < 2; ++ai)
#pragma unroll
            for (int m = 0; m < 4; ++m) { const float r = __shfl((m & 1) ? v1 : v0, fr + 16 * (ai * 2 + (m >> 1)));
#pragma unroll
                for (int bj = 0; bj < 2; ++bj)
#pragma unroll
                    for (int n = 0; n < 2; ++n) acc[ai][bj][m][n] = acc[ai][bj][m][n] * r; }
    }
    __device__ __forceinline__ void operator()(const f32x4 (&acc)[2][2][4][2], const Unit& u, int wr, int wc, int fr_, int fq_) const {
        int fr = fr_, fq = fq_; asm volatile("" : "+v"(fr), "+v"(fq));
        typedef __attribute__((address_space(1))) const f32x4 gcf4; typedef __attribute__((address_space(1))) f32x4 gf4; typedef __attribute__((address_space(1))) u32x4 gu4; typedef _Float16 h16x8 __attribute__((ext_vector_type(8))); typedef __attribute__((address_space(1))) h16x8 gh8; typedef __attribute__((address_space(1))) const h16x8 gch8; typedef __attribute__((address_space(1))) float gf1;
        const int grow0 = u.pm * BM; const int b = batch_of_row(grow0);
        const float* g = gate + (size_t)b * MODSTRIDE;
        const size_t t0 = (size_t)grow0 * 2048;
        const int col0 = u.pn * BM + wc * 32 + 8 * fq;
        float ss[2][4], rs[2][4];
#pragma unroll
        for (int ai = 0; ai < 2; ++ai)
#pragma unroll
            for (int m = 0; m < 4; ++m) { ss[ai][m] = 0.f; rs[ai][m] = MID ? s2[grow0 + wr * 64 + fr + ai * HALF + m * 16] : 1.0f; }
        const float* go = gmo + (size_t)b * MODSTRIDE; typedef __attribute__((address_space(1))) const u32x4 gcu4;
#pragma unroll
        for (int bj = 0; bj < 2; ++bj) { const int co = col0 + bj * HALF;
            const f32x4 gv0 = *(gcf4*)(g + co), gv1 = *(gcf4*)(g + co + 4); f32x4 gm0 = (f32x4){0.f, 0.f, 0.f, 0.f}, gm1 = gm0; if (gm) { gm0 = *(gcf4*)(gm + (size_t)b * MODSTRIDE + co); gm1 = *(gcf4*)(gm + (size_t)b * MODSTRIDE + co + 4); }
            f32x4 ri0 = *(gcf4*)(go + co), ri1 = *(gcf4*)(go + co + 4);
#pragma unroll
            for (int q = 0; q < 4; ++q) { ri0[q] = __builtin_amdgcn_rcpf(ri0[q]); ri1[q] = __builtin_amdgcn_rcpf(ri1[q]); }
#pragma unroll
            for (int ai = 0; ai < 2; ++ai) { u32x4 raw[4];
#pragma unroll
                for (int m = 0; m < 4; ++m) raw[m] = *(gcu4*)(XG + t0 + (size_t)(wr * 64 + fr + ai * HALF + m * 16) * 2048 + co);
#pragma unroll
                for (int m = 0; m < 4; ++m) { const size_t off = t0 + (size_t)(wr * 64 + fr + ai * HALF + m * 16) * 2048 + co;
                    const f32x4 b0 = (f32x4){__uint_as_float(raw[m].x << 16), __uint_as_float(raw[m].x & 0xffff0000u), __uint_as_float(raw[m].y << 16), __uint_as_float(raw[m].y & 0xffff0000u)} * ri0;
                    const f32x4 b1 = (f32x4){__uint_as_float(raw[m].z << 16), __uint_as_float(raw[m].z & 0xffff0000u), __uint_as_float(raw[m].w << 16), __uint_as_float(raw[m].w & 0xffff0000u)} * ri1;
                    const f32x4 o0 = b0 + gv0 * (acc[ai][bj][m][0] * rs[ai][m]), o1 = b1 + gv1 * (acc[ai][bj][m][1] * rs[ai][m]);
                    if (out32) { *(gf4*)(out32 + off) = o0; *(gf4*)(out32 + off + 4) = o1; }
                    if (gm) { const f32x4 x0 = o0 * gm0, x1 = o1 * gm1; ss[ai][m] += ((o0[0] * o0[0] + o0[1] * o0[1]) + (o0[2] * o0[2] + o0[3] * o0[3])) + ((o1[0] * o1[0] + o1[1] * o1[1]) + (o1[2] * o1[2] + o1[3] * o1[3]));
                        u32x4 w; w.x = cvt_pk_bf16(x0[0], x0[1]); w.y = cvt_pk_bf16(x0[2], x0[3]); w.z = cvt_pk_bf16(x1[0], x1[1]); w.w = cvt_pk_bf16(x1[2], x1[3]); *(gu4*)(XG + off) = w; } }
                asm volatile("" ::: "memory"); } }
        if (gm) {
#pragma unroll
            for (int ai = 0; ai < 2; ++ai)
#pragma unroll
                for (int m = 0; m < 4; ++m) { float s = ss[ai][m]; s += __shfl_xor(s, 16); s += __shfl_xor(s, 32); if (fq == 0) *(gf1*)(SSQ + (size_t)(grow0 + wr * 64 + fr + ai * HALF + m * 16) * 32 + u.pn * 4 + wc) = s; } }
    }
};
constexpr int GLU_BLOCKS = 802, GLU_TILES = 201;
struct GluMap {
    static constexpr bool UNIFORM = false;
    static __device__ __forceinline__ void block(int gb, int& base, int& t0, int& S) {
        if (gb < 266) { const int s = gb >= 133 ? 1 : 0; const int j = gb - 133 * s; base = s * 8192; t0 = 62 * j - 1; S = 8192; }
        else if (gb < GLU_BLOCKS) { const int g2 = gb - 266; const int s = g2 / 67, j = g2 - 67 * s; base = ROWS_P + s * 4096; t0 = 62 * j - 1; S = 4096; }
        else { base = 0; t0 = 0; S = 0; }
    }
    __device__ __forceinline__ unsigned rowq(int pm, int q, int r) const { int base, t0, S; block(4 * pm + q, base, t0, S); int t = t0 + r; t = t >= S ? S - 1 : t; t = t < 0 ? 0 : t; return (unsigned)(base + t); }
    __device__ __forceinline__ unsigned row(int pm, int R) const { int base, t0, S; block(4 * pm + (R >> 6), base, t0, S); int t = t0 + (R & 63); t = t >= S ? S - 1 : t; t = t < 0 ? 0 : t; return (unsigned)(base + t); }
};
template <int CTRL> __device__ __forceinline__ float dppf(float x) { return __builtin_bit_cast(float, __builtin_amdgcn_update_dpp(0, __builtin_bit_cast(int, x), CTRL, 0xf, 0xf, false)); }
template <int CTRL> __device__ __forceinline__ float dpp_any(float x) { return __builtin_bit_cast(float, __builtin_amdgcn_mov_dpp(__builtin_bit_cast(int, x), CTRL, 0xf, 0xf, false)); }
template <int CTRL> __device__ __forceinline__ float dpp_keep(float old, float x) { return __builtin_bit_cast(float, __builtin_amdgcn_update_dpp(__builtin_bit_cast(int, old), __builtin_bit_cast(int, x), CTRL, 0xf, 0xf, false)); }
typedef float f32x2 __attribute__((ext_vector_type(2)));
struct GeluK { f32x2 c0, c1, one;
    __device__ __forceinline__ GeluK() { c0 = (f32x2){-2.302208198f * 0.044715f, -2.302208198f * 0.044715f}; c1 = (f32x2){-2.302208198f, -2.302208198f}; one = (f32x2){1.0f, 1.0f}; asm volatile("" : "+v"(c0), "+v"(c1), "+v"(one)); } };
__device__ __forceinline__ f32x2 gelu_tanh_2(f32x2 x, const GeluK& k) {
    const f32x2 p = (x * x) * k.c0 + k.c1; const f32x2 a = x * p; f32x2 e; e.x = __builtin_amdgcn_exp2f(a.x); e.y = __builtin_amdgcn_exp2f(a.y);
    const f32x2 d = e + k.one; f32x2 r; r.x = __builtin_amdgcn_rcpf(d.x); r.y = __builtin_amdgcn_rcpf(d.y);
    return x * r;
}
__device__ __forceinline__ f32x4 gelu_tanh_4(f32x4 x, const GeluK& k) { const f32x2 lo = gelu_tanh_2((f32x2){x[0], x[1]}, k), hi = gelu_tanh_2((f32x2){x[2], x[3]}, k); return (f32x4){lo.x, lo.y, hi.x, hi.y}; }
__device__ __forceinline__ float gelu_tanh_f(float x) {
    const float u = x * (1.0f + 0.044715f * x * x); const float e = __builtin_amdgcn_exp2f(-2.302208198f * u);
    return x * __builtin_amdgcn_rcpf(1.0f + e);
}
struct EpiGLU {
    static constexpr bool PERM = true, PERMA = false, AFTER_DRAIN = false, HAS_MID = false;
    bf16_t* act; const float* cw; const float* cb;
    const float* rstd; const float* bias;
    __device__ __forceinline__ void operator()(const f32x4 (&acc)[2][2][4][2], const Unit& u, int wr, int wc, int fr_, int fq_) const {
        int fr = fr_, fq = fq_; asm volatile("" : "+v"(fr), "+v"(fq));
        const int c0 = u.pn * HALF + wc * 32 + 8 * fq;
        f32x4 w0[2], w1[2], w2[2], bb[2];
#pragma unroll
        for (int n = 0; n < 2; ++n) { w0[n] = *(const f32x4*)(cw + c0 + 4 * n); w1[n] = *(const f32x4*)(cw + 6144 + c0 + 4 * n); w2[n] = *(const f32x4*)(cw + 2 * 6144 + c0 + 4 * n); bb[n] = *(const f32x4*)(cb + c0 + 4 * n); }
#pragma unroll
        for (int ai = 0; ai < 2; ++ai) {
            int base, t0, S; GluMap::block(4 * u.pm + 2 * ai + wr, base, t0, S);
            f32x4 gt[4][2], bg[2], bu[2]; float rs[4];
            { const float* bp = bias + (size_t)batch_of_row(base) * 12288 + u.pn * BM + wc * 32 + 8 * fq;
#pragma unroll
              for (int n = 0; n < 2; ++n) { bg[n] = *(const f32x4*)(bp + 4 * n); bu[n] = *(const f32x4*)(bp + HALF + 4 * n); } }
#pragma unroll
            for (int m = 0; m < 4; ++m) { const int tok = t0 + 16 * m + fr; const bool in = tok >= 0 && tok < S; int tc = tok >= S ? S - 1 : tok; tc = tc < 0 ? 0 : tc; rs[m] = rstd[base + tc];
#pragma unroll
                for (int n = 0; n < 2; ++n) gt[m][n] = in ? acc[ai][0][m][n] * rs[m] + bg[n] : (f32x4){0.f, 0.f, 0.f, 0.f}; }
#pragma unroll
            for (int m = 0; m < 4; ++m) { const int i = 16 * m + fr, tok = t0 + i; u32x4 w;
                unsigned pk[4];
#pragma unroll
                for (int n = 0; n < 2; ++n) { f32x4 pv, nx;
#pragma unroll
                    for (int e = 0; e < 4; ++e) {
                        const float rcur = dppf<0x121>(gt[m][n][e]), rprv = dppf<0x121>(gt[m > 0 ? m - 1 : 0][n][e]);
                        const float lcur = dppf<0x12F>(gt[m][n][e]), lnxt = dppf<0x12F>(gt[m < 3 ? m + 1 : 3][n][e]);
                        pv[e] = fr == 0 ? rprv : rcur; nx[e] = fr == 15 ? lnxt : lcur; }
                    const f32x4 g = w0[n] * pv + w1[n] * gt[m][n] + w2[n] * nx + bb[n];
                    const f32x4 up = acc[ai][1][m][n] * rs[m] + bu[n];
                    const float a0 = gelu_tanh_f(g[0]) * up[0], a1 = gelu_tanh_f(g[1]) * up[1], a2 = gelu_tanh_f(g[2]) * up[2], a3 = gelu_tanh_f(g[3]) * up[3];
                    pk[2 * n] = cvt_pk_bf16(a0, a1); pk[2 * n + 1] = cvt_pk_bf16(a2, a3); }
                w.x = pk[0]; w.y = pk[1]; w.z = pk[2]; w.w = pk[3];
                if (i >= 1 && i <= 62 && tok < S) *(u32x4*)(act + (size_t)(base + tok) * 6144 + c0) = w; }
        }
    }
};

struct EpiGLU2 {
    static constexpr bool PERM = true, PERMA = true, AFTER_DRAIN = false, HAS_MID = false;
    bf16_t* act; const float* cw; const float* cb; const float* rstd; const float* bias; float* halo; PG8_LAS float* xch;
    __device__ __forceinline__ void operator()(const f32x4 (&acc)[2][2][4][2], const Unit& u, int wr, int wc, int fr_, int fq_) const {
        int fr = fr_, fq = fq_; asm volatile("" : "+v"(fr), "+v"(fq));
        const int lc = wc * 32 + 8 * fq, c0 = u.pn * HALF + lc;
        f32x4 w0[2], w1[2], w2[2], bb[2], bg[2], bu[2];
        { const float* bp = bias + (size_t)batch_of_row(u.pm * BM) * 12288 + u.pn * BM + lc;
#pragma unroll
          for (int n = 0; n < 2; ++n) { w0[n] = *(const f32x4*)(cw + c0 + 4 * n); w1[n] = *(const f32x4*)(cw + 6144 + c0 + 4 * n); w2[n] = *(const f32x4*)(cw + 2 * 6144 + c0 + 4 * n); bb[n] = *(const f32x4*)(cb + c0 + 4 * n);
              bg[n] = *(const f32x4*)(bp + 4 * n); bu[n] = *(const f32x4*)(bp + HALF + 4 * n); } }
        const GeluK GK;
        f32x4 gt[2][4][2]; float rs[2][4];
#pragma unroll
        for (int ai = 0; ai < 2; ++ai)
#pragma unroll
            for (int m = 0; m < 4; ++m) { rs[ai][m] = rstd[u.pm * BM + ai * HALF + wr * 64 + 4 * fr + m];
#pragma unroll
                for (int n = 0; n < 2; ++n) gt[ai][m][n] = acc[ai][0][m][n] * rs[ai][m] + bg[n]; }
#pragma unroll
        for (int ai = 0; ai < 2; ++ai) { const int blk = 2 * ai + wr;
#pragma unroll
            for (int n = 0; n < 2; ++n) { if (fr == 0) *(PG8_LAS f32x4*)(xch + (blk * 2 + 0) * HALF + lc + 4 * n) = gt[ai][0][n]; if (fr == 15) *(PG8_LAS f32x4*)(xch + (blk * 2 + 1) * HALF + lc + 4 * n) = gt[ai][3][n]; } }
        asm volatile("s_waitcnt lgkmcnt(0)" ::: "memory"); __builtin_amdgcn_s_barrier(); asm volatile("" ::: "memory");
#pragma unroll
        for (int ai = 0; ai < 2; ++ai) { const int blk = 2 * ai + wr; f32x4 pvb[2], nxb[2];
#pragma unroll
            for (int n = 0; n < 2; ++n) { pvb[n] = *(const PG8_LAS f32x4*)(xch + ((blk > 0 ? blk - 1 : 0) * 2 + 1) * HALF + lc + 4 * n); nxb[n] = *(const PG8_LAS f32x4*)(xch + ((blk < 3 ? blk + 1 : 3) * 2 + 0) * HALF + lc + 4 * n); }
#pragma unroll
            for (int m = 0; m < 4; ++m) { const int i = 4 * fr + m; u32x4 w; unsigned pk[4]; f32x4 upv[2];
#pragma unroll
                for (int n = 0; n < 2; ++n) { f32x4 pv, nx;
#pragma unroll
                    for (int e = 0; e < 4; ++e) {
                        pv[e] = m > 0 ? gt[ai][m > 0 ? m - 1 : 0][n][e] : dpp_keep<0x111>(pvb[n][e], gt[ai][3][n][e]);
                        nx[e] = m < 3 ? gt[ai][m < 3 ? m + 1 : 3][n][e] : dpp_keep<0x101>(nxb[n][e], gt[ai][0][n][e]); }
                    const f32x4 g = w2[n] * nx + (w1[n] * gt[ai][m][n] + (w0[n] * pv + bb[n]));
                    upv[n] = acc[ai][1][m][n] * rs[ai][m] + bu[n];
                    const f32x4 av = gelu_tanh_4(g, GK) * upv[n];
                    pk[2 * n] = cvt_pk_bf16(av[0], av[1]); pk[2 * n + 1] = cvt_pk_bf16(av[2], av[3]); }
                w.x = pk[0]; w.y = pk[1]; w.z = pk[2]; w.w = pk[3];
                const int trow = 64 * blk + i;
                __builtin_nontemporal_store(w, (u32x4*)(act + (size_t)(u.pm * BM + trow) * 6144 + c0));
                if ((ai == 0 && m < 2) || (ai == 1 && m >= 2)) {
                    if (ai == 0 ? (wr == 0 && fr == 0) : (wr == 1 && fr == 15)) { float* hp = halo + ((size_t)u.pm * 6 + m) * 6144 + c0; *(f32x4*)hp = gt[ai][m][0]; *(f32x4*)(hp + 4) = gt[ai][m][1];
                        if (m == 0 || m == 3) { float* hu = halo + ((size_t)u.pm * 6 + (m == 0 ? 4 : 5)) * 6144 + c0; *(f32x4*)hu = upv[0]; *(f32x4*)(hu + 4) = upv[1]; } } } }
        }
    }
};
struct IdentMap { static constexpr bool UNIFORM = true; __device__ __forceinline__ unsigned row(int pm, int R) const { return (unsigned)(pm * BM + R); } __device__ __forceinline__ unsigned rowq(int pm, int q, int r) const { return (unsigned)(pm * BM + 64 * q + r); } };
template <class Epi, class Sched, class AMap>
__device__ __forceinline__ void gemm_phase(PG8_LAS unsigned char* lds, const Gemm g, const Sched& S, const Epi& E, const AMap& AM, int wave) {
    unsigned z_ = 0u; asm volatile("" : "+v"(z_)); const int ln_ = (int)__builtin_amdgcn_mbcnt_hi(~0u, __builtin_amdgcn_mbcnt_lo(~0u, z_)); const int tid_ = wave * 64 + ln_;
    const int tid = tid_, wid = wave, lane = ln_, wr = wid >> 2, wc = wid & 3, fr = lane & 15, fq = lane >> 4;
    const int K = g.K, nt = K / BK;
    int RA[2], CA[2]; unsigned voffB[2], voffA[2];
#pragma unroll
    for (int i = 0; i < 2; ++i) { int R, C; stage_rc(tid * 16 + i * 8192, R, C); const int Rb = Epi::PERM ? ((R & ~31) + perm32(R & 31)) : R; const int Ra = Epi::PERMA ? ((R & ~63) + 4 * (R & 15) + ((R & 63) >> 4)) : R; RA[i] = R; CA[i] = C; voffA[i] = (unsigned)(Ra * K + C) * 2u; voffB[i] = (unsigned)(Rb * K + C) * 2u; }
    const size_t kstep = (size_t)(BK * 2);
    const size_t qstep = (size_t)64 * K * 2;
    const size_t hstep = (size_t)HALF * K * 2;
    const size_t tstep = 2 * hstep;
    const unsigned ldsw = (unsigned)wid * 1024u;
    const int aoff = lds_byte(wr * 64 + fr, fq * 8), boff = lds_byte(wc * 32 + fr, fq * 8);
#define PG8_SA(b, h) (((b) * 2 + (h)) * HTB)
#define PG8_SB(b, h) ((4 + (b) * 2 + (h)) * HTB)
#define PG8_STAGE(bufoff, gbase, voff) do { _Pragma("unroll") for (int _i = 0; _i < 2; ++_i) \
        __builtin_amdgcn_global_load_lds((const unsigned*)((const char*)(gbase) + (size_t)_i * qstep + (voff)[0]), (PG8_LAS unsigned*)(lds + (bufoff) + ldsw + _i * 8192), 16, 0, 0); } while (0)
#define PG8_LDA(dst, b, h) do { _Pragma("unroll") for (int m = 0; m < 4; ++m) _Pragma("unroll") for (int k = 0; k < 2; ++k) dst[m][k] = *(const PG8_LAS bf16x8*)(lds + PG8_SA(b, h) + aoff + m * 2048 + k * 1024); } while (0)
#define PG8_LDB(dst, b, h) do { _Pragma("unroll") for (int n = 0; n < 2; ++n) _Pragma("unroll") for (int k = 0; k < 2; ++k) dst[n][k] = *(const PG8_LAS bf16x8*)(lds + PG8_SB(b, h) + boff + n * 2048 + k * 1024); } while (0)
#define PG8_MMA(ai, bj, At, Bt) do { __builtin_amdgcn_s_setprio(1); _Pragma("unroll") for (int m = 0; m < 4; ++m) _Pragma("unroll") for (int n = 0; n < 2; ++n) _Pragma("unroll") for (int k = 0; k < 2; ++k) \
        acc[ai][bj][m][n] = __builtin_amdgcn_mfma_f32_16x16x32_bf16(Bt[n][k], At[m][k], acc[ai][bj][m][n], 0, 0, 0); __builtin_amdgcn_s_setprio(0); } while (0)
#define PG8_WAIT_V(n) asm volatile("s_waitcnt vmcnt(" #n ")" ::: "memory")
#define PG8_WAIT_L(n) asm volatile("s_waitcnt lgkmcnt(" #n ")" ::: "memory")
#define PG8_BAR __builtin_amdgcn_s_barrier()
#define PG8_SCHED __builtin_amdgcn_sched_barrier(0)
#define PG8_STAGE_A(bufoff, kb, h, NX) do { if constexpr (AMap::UNIFORM) { const char* _b = ((NX) ? nA : cA) + (kb) + (h) * hstep; PG8_STAGE(bufoff, _b, voffA); } \
        else { unsigned _o[2]; _o[0] = (NX) ? offN[h][0] : offC[h][0]; _o[1] = (NX) ? offN[h][1] : offC[h][1]; PG8_STAGE(bufoff, Ab + (kb), _o); } } while (0)
#define PG8_OFFS(dst, pm) do { _Pragma("unroll") for (int _h = 0; _h < 2; ++_h) _Pragma("unroll") for (int _i = 0; _i < 2; ++_i) dst[_h][_i] = (AM.rowq((pm), 2 * _h + _i, RA[_i] & 63) * (unsigned)K + (unsigned)CA[_i]) * 2u; } while (0)
    Unit cur, nxt; int ui = 0;
    if (!S.next(0, cur)) return;
    f32x4 acc[2][2][4][2];
#pragma unroll
    for (int a = 0; a < 2; ++a)
#pragma unroll
        for (int b = 0; b < 2; ++b)
#pragma unroll
            for (int m = 0; m < 4; ++m)
#pragma unroll
                for (int n = 0; n < 2; ++n) acc[a][b][m][n] = (f32x4){0.f, 0.f, 0.f, 0.f};
    bf16x8 At[4][2], B0[2][2], B1[2][2];
    unsigned offC[2][2], offN[2][2];
    if constexpr (!AMap::UNIFORM) { PG8_OFFS(offC, cur.pm); }
    const char* const Ab = (const char*)g.A;
    const char* cA = (const char*)g.A + (size_t)cur.pm * tstep; const char* nA = cA;
    const char* cB = (const char*)g.Bt + (size_t)cur.pn * tstep;
    S.a_ready(cur);
    PG8_STAGE(PG8_SB(0, 0), cB, voffB); PG8_STAGE(PG8_SB(0, 1), cB + hstep, voffB); PG8_STAGE_A(PG8_SA(0, 0), 0, 0, false); PG8_STAGE_A(PG8_SA(0, 1), 0, 1, false);
    if (wr == 1) PG8_BAR;
    PG8_WAIT_V(2); PG8_BAR;
    PG8_STAGE(PG8_SB(1, 0), cB + kstep, voffB); PG8_STAGE_A(PG8_SA(1, 0), kstep, 0, false); PG8_STAGE(PG8_SB(1, 1), cB + hstep + kstep, voffB);
    PG8_WAIT_V(6); PG8_BAR;
    for (;;) {
        const bool has_next = S.next(ui + 1, nxt);
        const char* nB = has_next ? (const char*)g.Bt + (size_t)nxt.pn * tstep : cB;
        if constexpr (AMap::UNIFORM) { nA = has_next ? (const char*)g.A + (size_t)nxt.pm * tstep : cA; }
        else { if (has_next) { PG8_OFFS(offN, nxt.pm); } else {
#pragma unroll
            for (int _h = 0; _h < 2; ++_h)
#pragma unroll
                for (int _i = 0; _i < 2; ++_i) offN[_h][_i] = offC[_h][_i]; } }
        for (int t = 0; t < nt; t += 2) {
            const bool last = (t == nt - 2);
            const size_t k1 = (size_t)(t + 1) * kstep, k2 = last ? (size_t)0 : (size_t)(t + 2) * kstep, k3 = k2 + kstep;
            const char* b2 = last ? nB : cB + (size_t)(t + 2) * kstep; const char* b3 = b2 + kstep;
            if (last && has_next) S.a_ready(nxt);
            if constexpr (Epi::HAS_MID) { if (t == nt / 2) E.mid(acc, cur, wr, fr); }
            PG8_LDB(B0, 0, 0); PG8_LDB(B1, 0, 1); PG8_SCHED; PG8_LDA(At, 0, 0); PG8_STAGE_A(PG8_SA(1, 1), k1, 1, false);
            PG8_WAIT_V(8); PG8_WAIT_L(0); PG8_BAR; PG8_MMA(0, 0, At, B0); PG8_MMA(0, 1, At, B1); PG8_BAR; PG8_SCHED;
            PG8_LDA(At, 0, 1); PG8_STAGE(PG8_SB(0, 0), b2, voffB); PG8_STAGE(PG8_SB(0, 1), b2 + hstep, voffB); PG8_STAGE_A(PG8_SA(0, 0), k2, 0, last);
            PG8_WAIT_V(8); PG8_WAIT_L(0); PG8_BAR; PG8_MMA(1, 0, At, B0); PG8_MMA(1, 1, At, B1); PG8_BAR; PG8_SCHED;
            PG8_LDB(B0, 1, 0); PG8_LDB(B1, 1, 1); PG8_SCHED; PG8_LDA(At, 1, 0); PG8_STAGE_A(PG8_SA(0, 1), k2, 1, last);
            PG8_WAIT_V(8); PG8_WAIT_L(0); PG8_BAR; PG8_MMA(0, 0, At, B0); PG8_MMA(0, 1, At, B1); PG8_BAR; PG8_SCHED;
            PG8_LDA(At, 1, 1); PG8_STAGE(PG8_SB(1, 0), b3, voffB); PG8_STAGE(PG8_SB(1, 1), b3 + hstep, voffB); PG8_STAGE_A(PG8_SA(1, 0), k3, 0, last);
            PG8_WAIT_V(8); PG8_WAIT_L(0); PG8_BAR; PG8_MMA(1, 0, At, B0); PG8_MMA(1, 1, At, B1); PG8_BAR; PG8_SCHED;
        }
        if (wr == 0) PG8_BAR;
        E(acc, cur, wr, wc, fr, fq); S.done(cur);
        if (!has_next) break;
#pragma unroll
        for (int a = 0; a < 2; ++a)
#pragma unroll
            for (int b = 0; b < 2; ++b)
#pragma unroll
                for (int m = 0; m < 4; ++m)
#pragma unroll
                    for (int n = 0; n < 2; ++n) acc[a][b][m][n] = (f32x4){0.f, 0.f, 0.f, 0.f};
        cur = nxt; cB = nB; cA = nA; ++ui;
        if constexpr (!AMap::UNIFORM) {
#pragma unroll
        for (int _h = 0; _h < 2; ++_h)
#pragma unroll
            for (int _i = 0; _i < 2; ++_i) offC[_h][_i] = offN[_h][_i]; }
        if (wr == 1) PG8_BAR;
    }
    PG8_WAIT_V(0);
    PG8_BAR;
#undef PG8_SA
#undef PG8_SB
#undef PG8_STAGE
#undef PG8_LDA
#undef PG8_LDB
#undef PG8_MMA
#undef PG8_WAIT_V
#undef PG8_WAIT_L
#undef PG8_BAR
#undef PG8_SCHED
#undef PG8_OFFS
#undef PG8_STAGE_A
}
}

#define LAS __attribute__((address_space(3)))
typedef unsigned short bf16_t;
typedef float f32x4 __attribute__((ext_vector_type(4)));
typedef float f32x2 __attribute__((ext_vector_type(2)));
typedef unsigned u32x4 __attribute__((ext_vector_type(4)));
typedef unsigned u32x2 __attribute__((ext_vector_type(2)));
typedef short bf16x8 __attribute__((ext_vector_type(8)));
typedef short s16x4 __attribute__((ext_vector_type(4)));
constexpr int D = 2048, T = 49152, ROWS_P = 16384, NB = 10, DEPTH = 4;
constexpr int ZC = 3584, ZQ = 0, ZK = 1024, ZV = 1280, ZX = 1536, ZY = 2560;
constexpr int DFF = 6144, MODSTRIDE = 12288;
constexpr float EPS = 1e-6f;
constexpr size_t MiB = 1u << 20;
constexpr size_t WS_CTL = 0, CTL_ZERO_BYTES = 64 * 1024, WS_MOD = 1 * MiB, WS_SUM = 3 * MiB  , WS_CAR = 9 * MiB  , WS_LW = 12 * MiB  ,
                 WS_WIN = 16 * MiB, WS_WOUT = 72 * MiB, WS_WGU = 104 * MiB, WS_WDN = 296 * MiB, WS_H = 392 * MiB, WS_Z = 584 * MiB,
                 WS_ATT = 920 * MiB, WS_LRU = 1016 * MiB, WS_AB = 1112 * MiB, WS_LC = 1112 * MiB  ,
                 WS_SSQX = 1496 * MiB  , WS_SSQA = 1502 * MiB  , WS_SSQL = 1503 * MiB + 512 * 1024, WS_RSTD = 1505 * MiB, WS_RATIO = 1505 * MiB + 256 * 1024, WS_S2 = 1505 * MiB + 512 * 1024,
                 WS_BIN = 1506 * MiB  , WS_BGU = 1507 * MiB  , WS_END = 1510 * MiB;
constexpr size_t WS_XR = 1160 * MiB;
constexpr size_t WS_HALO = 1352 * MiB;
constexpr size_t WS_MRG = WS_ATT;
constexpr size_t WS_LSP = 3 * MiB - 65536;
constexpr size_t WS_ACT = WS_Z;
constexpr size_t WS_GUC = WS_Z, WS_ACTC = WS_Z + 192 * MiB;
static_assert(WS_ACT + (size_t)T * DFF * 2 <= WS_XR && WS_XR + (size_t)T * D * 2 <= WS_HALO && WS_HALO + (size_t)192 * 6 * DFF * 4 <= WS_SSQX, "act overlay / residual stream / halo");
constexpr int LDS_BYTES = 147456, LDS_CTL = LDS_BYTES - 256;
constexpr int NWAVES = 8;
constexpr int CW_BAR = 1024;

__device__ __forceinline__ void rowinfo(int row, int& b, int& t, int& S) { if (row < ROWS_P) { b = row >> 13; t = row & 8191; S = 8192; } else { const int r = row - ROWS_P; b = 2 + (r >> 12); t = r & 4095; S = 4096; } }
__device__ __forceinline__ float bf2f(unsigned short u) { return __uint_as_float(((unsigned)u) << 16); }
__device__ __forceinline__ float bflo(unsigned w) { return __uint_as_float(w << 16); }
__device__ __forceinline__ float bfhi(unsigned w) { return __uint_as_float(w & 0xffff0000u); }
__device__ __forceinline__ unsigned f2bf(float f) { unsigned u = __float_as_uint(f); return (u + 0x7fffu + ((u >> 16) & 1u)) >> 16; }
__device__ __forceinline__ unsigned pk2(float lo, float hi) { return f2bf(lo) | (f2bf(hi) << 16); }
__device__ __forceinline__ float wave_sum(float v) {
#pragma unroll
    for (int o = 1; o < 64; o <<= 1) v += __shfl_xor(v, o);
    return v; }
__device__ __forceinline__ float wave_max(float v) {
#pragma unroll
    for (int o = 1; o < 64; o <<= 1) v = fmaxf(v, __shfl_xor(v, o));
    return v; }
__device__ __forceinline__ float gelu_tanh(float x) { const float u = 0.7978845608028654f * (x + 0.044715f * x * x * x); return x / (1.0f + __expf(-2.0f * u)); }
__device__ __forceinline__ float sigmoidf(float x) { return 1.0f / (1.0f + __expf(-x)); }
#define LDS_WAIT() asm volatile("s_waitcnt lgkmcnt(0)" ::: "memory")
#define VM_WAIT() asm volatile("s_waitcnt vmcnt(0)" ::: "memory")
#define WG_BAR() do { asm volatile("s_waitcnt vmcnt(0) lgkmcnt(0)" ::: "memory"); __builtin_amdgcn_s_barrier(); asm volatile("" ::: "memory"); } while (0)

__device__ __forceinline__ unsigned char* ws_now(unsigned char* p) { asm volatile("" : "+s"(p)); return p; }
__device__ __forceinline__ int lane_id() { unsigned z = 0u; asm volatile("" : "+v"(z)); return (int)__builtin_amdgcn_mbcnt_hi(~0u, __builtin_amdgcn_mbcnt_lo(~0u, z)); }
#define XB_TMO      128
#define XB_XCNT(j)  (256  + 64 * (j))
#define XB_XSUB(j)  (1280 + 64 * (j))
#define XB_XGEN(j)  (2304 + 64 * (j))
#define XB_TOP      3328
#define XB_TOPGEN   3392
#define XCD_BAR_WORDS 3456
#define XB_SPIN_CAP (1u << 18)

__device__ __forceinline__ unsigned xb_ld(unsigned* p)              { return __hip_atomic_load(p, __ATOMIC_RELAXED, __HIP_MEMORY_SCOPE_AGENT); }
__device__ __forceinline__ unsigned xb_add(unsigned* p, unsigned v) { return __hip_atomic_fetch_add(p, v, __ATOMIC_RELAXED, __HIP_MEMORY_SCOPE_AGENT); }
__device__ __forceinline__ unsigned xb_xcc_id() { return (unsigned)__builtin_amdgcn_s_getreg((3 << 11) | 20) & 0xFu; }
#define XB_SPIN(cond, bar) do { unsigned _sp = 0; while (cond) { __builtin_amdgcn_s_sleep(1); \
    if ((++_sp & 255u) == 0u) { if (xb_ld(&(bar)[XB_TMO])) break; if (_sp > XB_SPIN_CAP) { atomicAdd(&(bar)[XB_TMO], 1u); break; } } } } while (0)

struct XcdBarrier {
    unsigned* bar; unsigned x; int wv;
    volatile LAS unsigned* st;
};

__device__ __forceinline__ XcdBarrier xcd_barrier_post(unsigned* bar, volatile LAS unsigned* st, int wv) {
    XcdBarrier b; b.bar = bar; b.x = xb_xcc_id(); b.st = st; b.wv = wv;
    if (wv == 0 && lane_id() == 0) (void)xb_add(&bar[XB_XCNT(b.x)], 1u);
    return b;
}
__device__ __forceinline__ void xcd_barrier_complete(unsigned* bar, unsigned x, unsigned& nloc, unsigned& nx) {
    const unsigned G = gridDim.x * gridDim.y * gridDim.z;
    unsigned sum, cnt, mine, sp = 0u;
    for (;;) {
        sum = 0u; cnt = 0u; mine = 0u;
#pragma unroll
        for (unsigned j = 0; j < 16; ++j) { const unsigned c = xb_ld(&bar[XB_XCNT(j)]); sum += c; cnt += (c > 0u) ? 1u : 0u; mine = (j == x) ? c : mine; }
        if (sum == G) break;
        __builtin_amdgcn_s_sleep(1);
        if ((++sp & 255u) == 0u) { if (xb_ld(&bar[XB_TMO])) break; if (sp > XB_SPIN_CAP) { atomicAdd(&bar[XB_TMO], 1u); break; } }
    }
    nloc = mine > 0u ? mine : 1u; nx = cnt > 0u ? cnt : 1u;
}

__device__ __forceinline__ void xcd_barrier(const XcdBarrier& b) {
    asm volatile("s_waitcnt vmcnt(0)" ::: "memory");
    __syncthreads();
    if (b.wv == 0 && lane_id() == 0) {
        unsigned* bar = b.bar; asm volatile("" : "+s"(bar));
        __builtin_amdgcn_s_waitcnt(0);
        unsigned nloc = b.st[0], nx = b.st[1];
        if (nloc == 0u) { xcd_barrier_complete(bar, b.x, nloc, nx); b.st[0] = nloc; b.st[1] = nx; }
        const unsigned old = xb_add(&bar[XB_XSUB(b.x)], 1u);
        const unsigned gen = old / nloc;
        if (old + 1u == (gen + 1u) * nloc) {
            __builtin_amdgcn_fence(__ATOMIC_RELEASE, "agent");
            asm volatile("s_waitcnt vmcnt(0)" ::: "memory");
            const unsigned og = xb_add(&bar[XB_TOP], 1u);
            const unsigned tg = og / nx;
            if (og + 1u == (tg + 1u) * nx) xb_add(&bar[XB_TOPGEN], 1u);
            else XB_SPIN(xb_ld(&bar[XB_TOPGEN]) == tg, bar);
            __builtin_amdgcn_fence(__ATOMIC_ACQUIRE, "agent");
            xb_add(&bar[XB_XGEN(b.x)], 1u);
            asm volatile("s_waitcnt vmcnt(0)" ::: "memory");
        } else {
            XB_SPIN(xb_ld(&bar[XB_XGEN(b.x)]) == gen, bar);
            __builtin_amdgcn_fence(__ATOMIC_ACQUIRE, "agent");
            asm volatile("s_waitcnt vmcnt(0)" ::: "memory");
        }
    }
    __syncthreads();
}

struct Args { const float* in[28]; float* out; unsigned char* ws; int ph_lo, ph_hi, flags, pad; };
struct Frame {
    LAS unsigned char* lds; int tid, lane, wave, G, bid;
};
#define KAS __attribute__((address_space(4)))
__device__ __forceinline__ const KAS unsigned char* karg_base() { const KAS unsigned char* p = (const KAS unsigned char*)__builtin_amdgcn_kernarg_segment_ptr(); asm volatile("" : "+s"(p)); return p; }
__device__ __forceinline__ const float* karg_in(int k) { return *(const float* const KAS*)(karg_base() + 8 * k); }
__device__ __forceinline__ float* karg_out() { return *(float* const KAS*)(karg_base() + 8 * 28); }
__device__ __forceinline__ unsigned char* karg_ws() { return *(unsigned char* const KAS*)(karg_base() + 8 * 29); }
#define INP(k) (karg_in(k))
__device__ __forceinline__ Frame fresh(const Frame& F0) { Frame F = F0; int ln = lane_id(); asm volatile("" : "+v"(ln)); F.lane = ln; F.tid = F0.wave * 64 + ln; return F; }

__device__ __forceinline__ void p0_transpose_item(const float* W, int K, int N, bf16_t* WT, int mode, LAS float* scr, int item, int lane, const float* ks0 = nullptr, const float* ks1 = nullptr) {
    const int nblk = N / 64, kb = item / nblk, nb = item % nblk, k0 = 64 * kb, n0 = 64 * nb;
    const int drow0 = mode == 0 ? n0 : ((n0 >> 7) * 256 + (n0 & 127) + (mode == 2 ? 128 : 0));
    f32x4 v[16];
#pragma unroll
    for (int i = 0; i < 16; ++i) v[i] = *(const f32x4*)(W + (size_t)(k0 + 4 * i + (lane >> 4)) * N + n0 + 4 * (lane & 15));
#pragma unroll
    for (int i = 0; i < 16; ++i) { const int kk = 4 * i + (lane >> 4); float sc = 1.0f; if (ks0) sc = (k0 + kk < 1024 ? ks0[k0 + kk] : ks1[k0 + kk - 1024]);
        LAS float* d = scr + kk * 65 + 4 * (lane & 15); d[0] = v[i].x * sc; d[1] = v[i].y * sc; d[2] = v[i].z * sc; d[3] = v[i].w * sc; }
    LDS_WAIT(); asm volatile("" ::: "memory");
    const int c = lane & 7;
#pragma unroll
    for (int j = 0; j < 8; ++j) { const int n = (lane >> 3) + 8 * j; const LAS float* s = scr + (8 * c) * 65 + n;
        u32x4 o; o.x = pk2(s[0 * 65], s[1 * 65]); o.y = pk2(s[2 * 65], s[3 * 65]); o.z = pk2(s[4 * 65], s[5 * 65]); o.w = pk2(s[6 * 65], s[7 * 65]);
        *(u32x4*)(WT + (size_t)(drow0 + n) * K + k0 + 8 * c) = o; }
    LDS_WAIT(); asm volatile("" ::: "memory");
}
__device__ __forceinline__ void phase_prologue(const Frame& F0, const Args& a) { const Frame F = fresh(F0);
    unsigned char* ws = karg_ws();
    bf16_t* WIN = (bf16_t*)(ws + WS_WIN); bf16_t* WOUT = (bf16_t*)(ws + WS_WOUT); bf16_t* WGU = (bf16_t*)(ws + WS_WGU); bf16_t* WDN = (bf16_t*)(ws + WS_WDN);
    LAS float* scr = (LAS float*)(F.lds + F.wave * 16640);
    const int gw = F.bid * NWAVES + F.wave, NGW = F.G * NWAVES;
    constexpr int I_IN = (D / 64) * (ZC / 64), I_OUT = (D / 64) * (D / 64), I_G = (D / 64) * (DFF / 64), I_D = (DFF / 64) * (D / 64), I_L = I_IN + I_OUT + 2 * I_G + I_D;
    for (int it = gw; it < DEPTH * I_L; it += NGW) { const int l = it / I_L; int r = it - l * I_L;
        if (r < I_IN) { p0_transpose_item(INP(9) + (size_t)l * D * ZC, D, ZC, WIN + (size_t)l * ZC * D, 0, scr, r, F.lane); continue; } r -= I_IN;
        if (r < I_OUT) { p0_transpose_item(INP(22) + (size_t)l * D * D, D, D, WOUT + (size_t)l * D * D, 0, scr, r, F.lane, INP(20) + l * 1024, INP(21) + l * 1024); continue; } r -= I_OUT;
        if (r < I_G) { p0_transpose_item(INP(23) + (size_t)l * D * DFF, D, DFF, WGU + (size_t)l * 2 * DFF * D, 1, scr, r, F.lane); continue; } r -= I_G;
        if (r < I_G) { p0_transpose_item(INP(24) + (size_t)l * D * DFF, D, DFF, WGU + (size_t)l * 2 * DFF * D, 2, scr, r, F.lane); continue; } r -= I_G;
        p0_transpose_item(INP(27) + (size_t)l * DFF * D, DFF, D, WDN + (size_t)l * D * DFF, 0, scr, r, F.lane); }
    { bf16_t* LW = (bf16_t*)(ws + WS_LW);
      for (int it = gw; it < DEPTH * 8 * 8 * 16; it += NGW) { const int ks = it & 3, gs = (it >> 2) & 3, w = (it >> 4) & 7, n = (it >> 7) & 7, l = it >> 10;
          const float* src = (gs < 2 ? INP(15) : INP(17)) + ((size_t)((l * 2 + (gs & 1)) * 8 + n) * 128) * 128;
          const int c0 = 32 * ks + 8 * (F.lane >> 4), jc = 16 * w + (F.lane & 15); float v[8];
#pragma unroll
          for (int j = 0; j < 8; ++j) v[j] = src[(size_t)(c0 + j) * 128 + jc];
          u32x4 o; o.x = pk2(v[0], v[1]); o.y = pk2(v[2], v[3]); o.z = pk2(v[4], v[5]); o.w = pk2(v[6], v[7]);
          *(u32x4*)(LW + ((size_t)it * 64 + F.lane) * 8) = o; } }
    { float* LSP = (float*)(ws + WS_LSP); for (int i = F.bid * 512 + F.tid; i < DEPTH * 2048; i += F.G * 512) LSP[i] = log1pf(expf(-INP(19)[i])); }
    WG_BAR();
    { LAS float* cs = (LAS float*)F.lds; LAS float* red = (LAS float*)(F.lds + 81920); float* MOD = (float*)(ws + WS_MOD);
      const float* c_p = INP(2); const float* c_s = INP(3); const float* w_mod = INP(5); const float* b_mod = INP(6); const float* n1g = INP(7); const float* n2g = INP(8);
      for (int i = F.tid; i < NB * D; i += 512) { const int b = i >> 11, k = i & 2047; const float c = b < 2 ? c_p[b * D + k] : c_s[(b - 2) * D + k]; cs[i] = c / (1.0f + __expf(-c)); }
      WG_BAR();
      for (int item = F.bid; item < DEPTH * 192; item += F.G) { const int l = item / 192, col0 = (item % 192) * 64, w = F.wave, lane = F.lane;
          float acc[NB];
#pragma unroll
          for (int b = 0; b < NB; ++b) acc[b] = 0.f;
          const float* W = w_mod + (size_t)l * D * MODSTRIDE + col0 + lane;
          for (int k0 = 256 * w; k0 < 256 * w + 256; k0 += 16) { float wv[16];
#pragma unroll
              for (int j = 0; j < 16; ++j) wv[j] = W[(size_t)(k0 + j) * MODSTRIDE];
#pragma unroll
              for (int j4 = 0; j4 < 4; ++j4)
#pragma unroll
                  for (int b = 0; b < NB; ++b) { const f32x4 c4 = *(const LAS f32x4*)(cs + b * D + k0 + 4 * j4); acc[b] += (c4.x * wv[4 * j4] + c4.y * wv[4 * j4 + 1]) + (c4.z * wv[4 * j4 + 2] + c4.w * wv[4 * j4 + 3]); } }
#pragma unroll
          for (int b = 0; b < NB; ++b) red[(w * NB + b) * 64 + lane] = acc[b];
          WG_BAR();
          for (int i = F.tid; i < NB * 64; i += 512) { const int b = i >> 6, cc = i & 63, col = col0 + cc; float s = b_mod[l * MODSTRIDE + col];
#pragma unroll
              for (int ww = 0; ww < 8; ++ww) s += red[(ww * NB + b) * 64 + cc];
              const int slot = col >> 11, c = col & 2047;
              if (slot == 1) s = n1g[l * D + c] * (1.0f + s); else if (slot == 4) s = n2g[l * D + c] * (1.0f + s);
              MOD[((size_t)l * NB + b) * MODSTRIDE + col] = s; }
          WG_BAR(); } }
}

__device__ __forceinline__ void phase_norm0(const Frame& F0, const float* x_p, const float* x_s, const float* mod0, bf16_t* XG, float* RSTD) { const Frame F = fresh(F0);
    const int gw = F.bid * NWAVES + F.wave, NGW = F.G * NWAVES, lane = F.lane;
    for (int row = gw; row < T; row += NGW) { const int b = row < ROWS_P ? (row >> 13) : 2 + ((row - ROWS_P) >> 12);
        const float* xr = row < ROWS_P ? x_p + (size_t)row * D : x_s + (size_t)(row - ROWS_P) * D; const float* gm = mod0 + (size_t)b * MODSTRIDE + D;
        f32x4 v[8]; float ss = 0.f;
#pragma unroll
        for (int j = 0; j < 8; ++j) { v[j] = ((const f32x4*)xr)[lane + 64 * j]; ss += (v[j].x * v[j].x + v[j].y * v[j].y) + (v[j].z * v[j].z + v[j].w * v[j].w); }
        ss = wave_sum(ss); if (lane == 0) RSTD[row] = rsqrtf(ss * (1.0f / D) + EPS);
#pragma unroll
        for (int j = 0; j < 8; ++j) { const f32x4 g = ((const f32x4*)gm)[lane + 64 * j]; const f32x4 o = v[j] * g; u32x2 p; p.x = pk2(o.x, o.y); p.y = pk2(o.z, o.w); ((u32x2*)(XG + (size_t)row * D))[lane + 64 * j] = p; } }
}
__device__ __forceinline__ void phase_rstd(const Frame& F0, int mode, const float* SSQX, float* RSTD, const float* SSQA, const float* SSQL, float* RATIO, float* S2) { const Frame F = fresh(F0);
    for (int row = F.bid * 512 + F.tid; row < T; row += F.G * 512) {
        if (mode == 0) { const f32x4* p = (const f32x4*)(SSQX + (size_t)row * 32); f32x4 s = p[0];
#pragma unroll
            for (int j = 1; j < 8; ++j) s += p[j];
            RSTD[row] = rsqrtf(((s.x + s.y) + (s.z + s.w)) * (1.0f / D) + EPS); }
        else { const f32x4* pa = (const f32x4*)(SSQA + (size_t)row * 8); const f32x4* pl = (const f32x4*)(SSQL + (size_t)row * 8); const f32x4 a = pa[0] + pa[1], l = pl[0] + pl[1];
            const float s1 = rsqrtf(((a.x + a.y) + (a.z + a.w)) * (1.0f / 1024.0f) + EPS), s2 = rsqrtf(((l.x + l.y) + (l.z + l.w)) * (1.0f / 1024.0f) + EPS);
            RATIO[row] = s1 / s2; S2[row] = s2; } }
}
__device__ __forceinline__ void phase_bias(const Frame& F0, const float* MOD, const bf16_t* WIN, const bf16_t* WGU, float* BIN, float* BGU) { const Frame F = fresh(F0);
    const int fr = F.lane & 15, fq = F.lane >> 4;
    constexpr int T_IN = ZC / 16, T_GU = 2 * DFF / 16, T_L = T_IN + T_GU;
    for (int tile = F.bid * NWAVES + F.wave; tile < DEPTH * T_L; tile += F.G * NWAVES) { const int l = tile / T_L; int r = tile - l * T_L; const int which = r >= T_IN ? 1 : 0; if (which) r -= T_IN;
        const int N = which ? 2 * DFF : ZC, n0 = 16 * r;
        const bf16_t* wp = (which ? WGU + (size_t)l * 2 * DFF * D : WIN + (size_t)l * ZC * D) + (size_t)(n0 + fr) * D + 8 * fq;
        const float* sp = MOD + ((size_t)l * NB + (fr < NB ? fr : 0)) * MODSTRIDE + (which ? 3 : 0) * D + 8 * fq;
        f32x4 acc = (f32x4){0.f, 0.f, 0.f, 0.f};
#pragma unroll 4
        for (int ks = 0; ks < D / 32; ++ks) { const bf16x8 af = *(const bf16x8*)(wp + 32 * ks); f32x4 s0 = *(const f32x4*)(sp + 32 * ks), s1 = *(const f32x4*)(sp + 32 * ks + 4);
            if (fr >= NB) { s0 = (f32x4){0.f, 0.f, 0.f, 0.f}; s1 = s0; }
            unsigned hi[4], lo[4]; const float sv[8] = {s0.x, s0.y, s0.z, s0.w, s1.x, s1.y, s1.z, s1.w};
#pragma unroll
            for (int j = 0; j < 4; ++j) { const unsigned h0 = f2bf(sv[2 * j]), h1 = f2bf(sv[2 * j + 1]); hi[j] = h0 | (h1 << 16); lo[j] = pk2(sv[2 * j] - __uint_as_float(h0 << 16), sv[2 * j + 1] - __uint_as_float(h1 << 16)); }
            const u32x4 hv = (u32x4){hi[0], hi[1], hi[2], hi[3]}, lv = (u32x4){lo[0], lo[1], lo[2], lo[3]};
            acc = __builtin_amdgcn_mfma_f32_16x16x32_bf16(af, __builtin_bit_cast(bf16x8, hv), acc, 0, 0, 0); acc = __builtin_amdgcn_mfma_f32_16x16x32_bf16(af, __builtin_bit_cast(bf16x8, lv), acc, 0, 0, 0); }
        if (fr < NB) { float* bp = (which ? BGU + (size_t)l * NB * 2 * DFF : BIN + (size_t)l * NB * ZC) + (size_t)fr * N + n0 + 4 * fq; *(f32x4*)bp = acc; }
    }
}

constexpr int AT_ROW = 272, AT_BUF = 2 * 64 * AT_ROW + 256  , AT_KS = 0, AT_VS = 64 * AT_ROW, AT_RSK = 2 * 64 * AT_ROW, AT_BIAS = 2 * AT_BUF, AT_GQ = AT_BIAS + 8 * 384 * 4;
static_assert(AT_GQ + 512 <= LDS_CTL, "attention LDS map");
constexpr float LOG2E = 1.4426950408889634f;
__device__ __forceinline__ int t5_bucket(int rel) { const int n = rel < 0 ? -rel : rel; int v; if (n < 8) v = n; else { v = (31 - __clz(n * n)) + 2; v = v > 15 ? 15 : v; } return (rel > 0 ? 16 : 0) + v; }
__device__ __forceinline__ s16x4 lds_tr16(LAS unsigned char* p) { typedef short v4i16_t __attribute__((ext_vector_type(4))); return __builtin_bit_cast(s16x4, __builtin_amdgcn_ds_read_tr16_b64_v4i16((LAS v4i16_t*)p)); }
__device__ __forceinline__ void phase_attn(const Frame& F0, const bf16_t* Z, const float* qg, const float* kg, const float* sink, const float* relb, bf16_t* MRG, float* SSQA) { const Frame F = fresh(F0);
    LAS unsigned char* lds = F.lds; const int tid = F.tid, lane = F.lane, w = F.wave, fr = lane & 15, fq = lane >> 4, g = w & 3, hq = w >> 2;
    LAS float* bias = (LAS float*)(lds + AT_BIAS);
    for (int i = tid; i < 8 * 384; i += 512) { const int h = i / 384, rel = i - 384 * h - 192; bias[i] = (rel >= -128 && rel <= 128) ? relb[t5_bucket(rel) * 8 + h] * LOG2E - 12.0f : -1e30f; }
    LAS float* gqt = (LAS float*)(lds + AT_GQ);
    if (tid < 128) gqt[tid] = qg[tid] * kg[tid];
    WG_BAR();
    const int p0 = tid, p1 = tid + 512;
    const int per_x = ((T / 64) * 2 + 7) / 8, slots = F.G / 8;
    for (int it_ = F.bid >> 3; it_ < per_x; it_ += slots) { const int item = (F.bid & 7) * per_x + it_; if (item >= (T / 64) * 2) break;
        const int qb = item >> 1, kvh = item & 1, q0 = qb * 64, h = kvh * 4 + g; int b_, t0, S; rowinfo(q0, b_, t0, S); const int seq0 = q0 - t0;
        bf16x8 Qf[2][4];
#pragma unroll
        for (int qt = 0; qt < 2; ++qt) { const bf16_t* qp = Z + (size_t)(q0 + 32 * hq + 16 * qt + fr) * ZC + ZQ + h * 128 + 8 * fq; u32x4 raw[4]; float ss = 0.f;
#pragma unroll
            for (int ks = 0; ks < 4; ++ks) { raw[ks] = *(const u32x4*)(qp + 32 * ks); const unsigned rw[4] = {raw[ks].x, raw[ks].y, raw[ks].z, raw[ks].w};
#pragma unroll
                for (int e = 0; e < 4; ++e) { const float a0 = bflo(rw[e]), a1 = bfhi(rw[e]); ss += a0 * a0 + a1 * a1; } }
            ss += __shfl_xor(ss, 16); ss += __shfl_xor(ss, 32);
            const float rs = rsqrtf(ss * (1.0f / 128.0f) + EPS) * (0.08838834764831845f * LOG2E);
#pragma unroll
            for (int ks = 0; ks < 4; ++ks) { const unsigned rw[4] = {raw[ks].x, raw[ks].y, raw[ks].z, raw[ks].w}; u32x4 o;
                const f32x4 g0 = *(const LAS f32x4*)(gqt + 32 * ks + 8 * fq), g1 = *(const LAS f32x4*)(gqt + 32 * ks + 8 * fq + 4);
                o.x = pg8::cvt_pk_bf16(bflo(rw[0]) * rs * g0[0], bfhi(rw[0]) * rs * g0[1]); o.y = pg8::cvt_pk_bf16(bflo(rw[1]) * rs * g0[2], bfhi(rw[1]) * rs * g0[3]);
                o.z = pg8::cvt_pk_bf16(bflo(rw[2]) * rs * g1[0], bfhi(rw[2]) * rs * g1[1]); o.w = pg8::cvt_pk_bf16(bflo(rw[3]) * rs * g1[2], bfhi(rw[3]) * rs * g1[3]);
                Qf[qt][ks] = __builtin_bit_cast(bf16x8, o); } }
        f32x4 O[8][2];
#pragma unroll
        for (int dt = 0; dt < 8; ++dt) { O[dt][0] = (f32x4){0.f, 0.f, 0.f, 0.f}; O[dt][1] = (f32x4){0.f, 0.f, 0.f, 0.f}; }
        float lsum[2] = {0.f, 0.f};
        const int c_lo = t0 >= 128 ? 0 : (128 - t0) / 64, c_hi = (t0 + 192 <= S) ? 4 : 4 - (t0 + 192 - S) / 64;
        u32x4 kr[2], vr[2];
#define AT_FETCH(c) do { const size_t rb = (size_t)(seq0 + t0 - 128 + 64 * (c)); \
          kr[0] = *(const u32x4*)(Z + (rb + (p0 >> 4)) * ZC + ZK + kvh * 128 + 8 * (p0 & 15)); kr[1] = *(const u32x4*)(Z + (rb + (p1 >> 4)) * ZC + ZK + kvh * 128 + 8 * (p1 & 15)); \
          vr[0] = *(const u32x4*)(Z + (rb + (p0 >> 4)) * ZC + ZV + kvh * 128 + 8 * (p0 & 15)); vr[1] = *(const u32x4*)(Z + (rb + (p1 >> 4)) * ZC + ZV + kvh * 128 + 8 * (p1 & 15)); } while (0)
#define AT_PARK(buf) do { LAS unsigned char* bb = lds + (buf) * AT_BUF; _Pragma("unroll") for (int i = 0; i < 2; ++i) { const int p = i ? p1 : p0, key = p >> 4, part = p & 15; \
                *(LAS u32x4*)(bb + AT_KS + key * AT_ROW + part * 16) = kr[i]; *(LAS u32x4*)(bb + AT_VS + key * AT_ROW + part * 16) = vr[i]; \
                const unsigned kw[4] = {kr[i].x, kr[i].y, kr[i].z, kr[i].w}; float ss = 0.f; \
                _Pragma("unroll") for (int e = 0; e < 4; ++e) { const float a0 = bflo(kw[e]), a1 = bfhi(kw[e]); ss += a0 * a0 + a1 * a1; } \
                ss += __shfl_xor(ss, 1); ss += __shfl_xor(ss, 2); ss += __shfl_xor(ss, 4); ss += __shfl_xor(ss, 8); \
                if (part == 0) ((LAS float*)(bb + AT_RSK))[key] = rsqrtf(ss * (1.0f / 128.0f) + EPS); } } while (0)
        AT_FETCH(c_lo);
        WG_BAR();
        AT_PARK(0);
        WG_BAR();
        for (int c = c_lo; c <= c_hi; ++c) { LAS unsigned char* bb = lds + ((c - c_lo) & 1) * AT_BUF;
            if (c < c_hi) AT_FETCH(c + 1);
            f32x4 Sx[4][2];
#pragma unroll
            for (int kt = 0; kt < 4; ++kt) { Sx[kt][0] = (f32x4){0.f, 0.f, 0.f, 0.f}; Sx[kt][1] = (f32x4){0.f, 0.f, 0.f, 0.f};
#pragma unroll
                for (int ks = 0; ks < 4; ++ks) { const bf16x8 kf = *(const LAS bf16x8*)(bb + AT_KS + (16 * kt + fr) * AT_ROW + (32 * ks + 8 * fq) * 2);
                    Sx[kt][0] = __builtin_amdgcn_mfma_f32_16x16x32_bf16(kf, Qf[0][ks], Sx[kt][0], 0, 0, 0); Sx[kt][1] = __builtin_amdgcn_mfma_f32_16x16x32_bf16(kf, Qf[1][ks], Sx[kt][1], 0, 0, 0); } }
            bf16x8 Pf[2][2];
            f32x4 rk[4];
#pragma unroll
            for (int kt = 0; kt < 4; ++kt) rk[kt] = *(const LAS f32x4*)(bb + AT_RSK + (16 * kt + 4 * fq) * 4);
#pragma unroll
            for (int qt = 0; qt < 2; ++qt) { float pv[4][4]; const LAS float* bp = bias + h * 384 + 64 * c + 64 + 4 * fq - (32 * hq + 16 * qt + fr);
#pragma unroll
                for (int kt = 0; kt < 4; ++kt)
#pragma unroll
                    for (int i = 0; i < 4; ++i) { const float p = __builtin_amdgcn_exp2f(Sx[kt][qt][i] * rk[kt][i] + bp[16 * kt + i]); pv[kt][i] = p; lsum[qt] += p; }
#pragma unroll
                for (int s = 0; s < 2; ++s) { u32x4 o; o.x = pg8::cvt_pk_bf16(pv[2 * s][0], pv[2 * s][1]); o.y = pg8::cvt_pk_bf16(pv[2 * s][2], pv[2 * s][3]); o.z = pg8::cvt_pk_bf16(pv[2 * s + 1][0], pv[2 * s + 1][1]); o.w = pg8::cvt_pk_bf16(pv[2 * s + 1][2], pv[2 * s + 1][3]);
                    Pf[qt][s] = __builtin_bit_cast(bf16x8, o); } }
#pragma unroll
            for (int dt = 0; dt < 8; ++dt)
#pragma unroll
                for (int s = 0; s < 2; ++s) { LAS unsigned char* vb = bb + AT_VS + (32 * s + 4 * fq + (fr >> 2)) * AT_ROW + (16 * dt + 4 * (fr & 3)) * 2;
                    const s16x4 lo = lds_tr16(vb), hi = lds_tr16(vb + 16 * AT_ROW);
                    const bf16x8 vf = (bf16x8){lo[0], lo[1], lo[2], lo[3], hi[0], hi[1], hi[2], hi[3]};
                    O[dt][0] = __builtin_amdgcn_mfma_f32_16x16x32_bf16(vf, Pf[0][s], O[dt][0], 0, 0, 0); O[dt][1] = __builtin_amdgcn_mfma_f32_16x16x32_bf16(vf, Pf[1][s], O[dt][1], 0, 0, 0); }
            if (c < c_hi) { AT_PARK(((c - c_lo) & 1) ^ 1); WG_BAR(); }
        }
#undef AT_FETCH
#undef AT_PARK
        const float sk = __builtin_amdgcn_exp2f(sink[h] * LOG2E - 12.0f);
#pragma unroll
        for (int qt = 0; qt < 2; ++qt) { float l = lsum[qt]; l += __shfl_xor(l, 16); l += __shfl_xor(l, 32); const float inv = 1.0f / (l + sk);
            const int row = q0 + 32 * hq + 16 * qt + fr; bf16_t* op = MRG + (size_t)row * D + h * 128 + 4 * fq; float ss = 0.f;
#pragma unroll
            for (int dt = 0; dt < 8; ++dt) { u32x2 o; o.x = pg8::cvt_pk_bf16(O[dt][qt][0] * inv, O[dt][qt][1] * inv); o.y = pg8::cvt_pk_bf16(O[dt][qt][2] * inv, O[dt][qt][3] * inv); *(u32x2*)(op + 16 * dt) = o;
                const float e0 = bflo(o.x), e1 = bfhi(o.x), e2 = bflo(o.y), e3 = bfhi(o.y); ss += (e0 * e0 + e1 * e1) + (e2 * e2 + e3 * e3); }
            ss += __shfl_xor(ss, 16); ss += __shfl_xor(ss, 32); if (fq == 0) SSQA[(size_t)row * 8 + h] = ss; }
    }
    WG_BAR();
}

constexpr int LR_HF = 0, LR_HF_ROW = 528, LR_XCB = 67584, LR_YG = 102656, LR_YG_ROW = 272, LR_END = 137472;
static_assert(LR_END <= LDS_CTL, "LRU LDS map");
__device__ __forceinline__ int xcb_off(int tok) { return tok * 272 + (tok >> 5) * 64; }
struct LruConsts { float ba_f, ba_b, bx_f, bx_b, sp_f, sp_b; };
__device__ __forceinline__ void lru_fetch_xr(const Frame& F, const bf16_t* Z, int row0, int n, unsigned (&xr)[19]) {
    const int cp = F.tid & 63, tg = F.tid >> 6, ch = 128 * n + 2 * cp; int b_, t0, S; rowinfo(row0, b_, t0, S);
#pragma unroll
    for (int i = 0; i < 19; ++i) { const int tt = t0 + 16 * tg - 2 + i; unsigned v = 0u; if (tt >= 0 && tt < S) v = *(const unsigned*)(Z + (size_t)(row0 + 16 * tg - 2 + i) * ZC + ZX + ch); xr[i] = v; }
}
__device__ __forceinline__ void lru_park_xc(const Frame& F, const float* cw, const float* cb, int n, const unsigned (&xr)[19]) {
    const int cp = F.tid & 63, tg = F.tid >> 6, ch = 128 * n + 2 * cp;
    const float w00 = cw[ch], w01 = cw[ch + 1], w10 = cw[1024 + ch], w11 = cw[1024 + ch + 1], w20 = cw[2048 + ch], w21 = cw[2048 + ch + 1], w30 = cw[3072 + ch], w31 = cw[3072 + ch + 1], b0 = cb[ch], b1 = cb[ch + 1];
#pragma unroll
    for (int i = 0; i < 16; ++i) { const float y0 = b0 + w00 * bflo(xr[i]) + w10 * bflo(xr[i + 1]) + w20 * bflo(xr[i + 2]) + w30 * bflo(xr[i + 3]), y1 = b1 + w01 * bfhi(xr[i]) + w11 * bfhi(xr[i + 1]) + w21 * bfhi(xr[i + 2]) + w31 * bfhi(xr[i + 3]);
        const int tk = 16 * tg + i; *(LAS unsigned*)(F.lds + LR_XCB + xcb_off(tk) + 4 * cp) = pk2(y0, y1); }
}
typedef _Float16 f16x8 __attribute__((ext_vector_type(8)));
__device__ __forceinline__ void lru_ab2(f32x2 ga, f32x2 gx, f32x2 xc, float ba, float bx, float sp, f32x2& la, f32x2& a, f32x2& b) {
    const f32x2 ta = (ga + ba) * (-LOG2E), tx = (gx + bx) * (-LOG2E);
    f32x2 da, dx; da.x = 1.0f + __builtin_amdgcn_exp2f(ta.x); da.y = 1.0f + __builtin_amdgcn_exp2f(ta.y); dx.x = 1.0f + __builtin_amdgcn_exp2f(tx.x); dx.y = 1.0f + __builtin_amdgcn_exp2f(tx.y);
    const f32x2 dd = da * dx; f32x2 rc; rc.x = __builtin_amdgcn_rcpf(dd.x); rc.y = __builtin_amdgcn_rcpf(dd.y);
    const f32x2 r = dx * rc, ig = da * rc;
    la = r * (-8.0f * sp);
    const f32x2 tl = la * LOG2E; a.x = __builtin_amdgcn_exp2f(tl.x); a.y = __builtin_amdgcn_exp2f(tl.y);
    const f32x2 x2 = la * 2.0f;
    const f32x2 ser = -x2 * (1.0f + x2 * (0.5f + x2 * 0.16666667f)), alt = (1.0f - a) * (1.0f + a);
    f32x2 om; om.x = x2.x > -0.25f ? ser.x : alt.x; om.y = x2.y > -0.25f ? ser.y : alt.y;
    f32x2 sq; sq.x = __builtin_amdgcn_sqrtf(om.x); sq.y = __builtin_amdgcn_sqrtf(om.y);
    b = sq * ig * xc;
}
__device__ __forceinline__ void lru_load_w(const bf16_t* LWl, int n, int w, int lane, int gs, bf16x8 (&Wf)[4]) {
    int lo = lane * 8; asm volatile("" : "+v"(lo));
#pragma unroll
    for (int ks = 0; ks < 4; ++ks) Wf[ks] = *(const bf16x8*)(LWl + (size_t)(((n * 8 + w) * 4 + gs) * 4 + ks) * 512 + lo);
}
__device__ __forceinline__ LruConsts lru_consts(const float* b_a, const float* b_x, const float* lam, int ch) {
    LruConsts c; c.ba_f = b_a[ch]; c.ba_b = b_a[1024 + ch]; c.bx_f = b_x[ch]; c.bx_b = b_x[1024 + ch]; c.sp_f = lam[ch]; c.sp_b = lam[1024 + ch]; return c;
}
__device__ __forceinline__ void phase_lru1(const Frame& F0, const bf16_t* Z, const bf16_t* LWl, const float* cw, const float* cb, const float* b_a, const float* b_x, const float* lam, float* SUM, f16x8* LC) { const Frame F = fresh(F0);
    const int lane = F.lane, w = F.wave, fr = lane & 15, fq = lane >> 4, n = F.bid & 7, ch = 128 * n + 16 * w + fr;
    bf16x8 Waf[4], Wab[4], Wxf[4], Wxb[4]; lru_load_w(LWl, n, w, lane, 0, Waf); lru_load_w(LWl, n, w, lane, 1, Wab); lru_load_w(LWl, n, w, lane, 2, Wxf); lru_load_w(LWl, n, w, lane, 3, Wxb);
    const LruConsts C = lru_consts(b_a, b_x, lam, ch);
    const int arow = 32 * (fr >> 2) + (fr & 3);
    unsigned xr[19];
    if (F.bid < (T / 128) * 8) lru_fetch_xr(F, Z, (F.bid >> 3) * 128, n, xr);
    for (int item = F.bid; item < (T / 128) * 8; item += F.G) { const int chunk = item >> 3;
        WG_BAR(); lru_park_xc(F, cw, cb, n, xr);
        if (item + F.G < (T / 128) * 8) lru_fetch_xr(F, Z, ((item + F.G) >> 3) * 128, n, xr);
        asm volatile("s_waitcnt lgkmcnt(0)" ::: "memory"); __builtin_amdgcn_s_barrier(); asm volatile("" ::: "memory");
        float RAf = 1.f, RBf = 0.f, RAb = 1.f, RBb = 0.f;
#pragma unroll 2
        for (int tau = 0; tau < 8; ++tau) {
            f32x4 gaf = (f32x4){0.f, 0.f, 0.f, 0.f}, gab = gaf, gxf = gaf, gxb = gaf;
#pragma unroll
            for (int ks = 0; ks < 4; ++ks) { const bf16x8 af = *(const LAS bf16x8*)(F.lds + LR_XCB + xcb_off(arow + 4 * tau) + (32 * ks + 8 * fq) * 2);
                gaf = __builtin_amdgcn_mfma_f32_16x16x32_bf16(af, Waf[ks], gaf, 0, 0, 0); gab = __builtin_amdgcn_mfma_f32_16x16x32_bf16(af, Wab[ks], gab, 0, 0, 0);
                gxf = __builtin_amdgcn_mfma_f32_16x16x32_bf16(af, Wxf[ks], gxf, 0, 0, 0); gxb = __builtin_amdgcn_mfma_f32_16x16x32_bf16(af, Wxb[ks], gxb, 0, 0, 0); }
            float xc[4];
#pragma unroll
            for (int i = 0; i < 4; ++i) xc[i] = bf2f(*(const LAS bf16_t*)(F.lds + LR_XCB + xcb_off(32 * fq + 4 * tau + i) + (16 * w + fr) * 2));
            f16x8 cf, cbk;
#pragma unroll
            for (int p = 0; p < 2; ++p) { f32x2 la, a, b; const f32x2 x = (f32x2){xc[2 * p], xc[2 * p + 1]};
                lru_ab2((f32x2){gaf[2 * p], gaf[2 * p + 1]}, (f32x2){gxf[2 * p], gxf[2 * p + 1]}, x, C.ba_f, C.bx_f, C.sp_f, la, a, b);
                RBf = a.x * RBf + b.x; RAf = a.x * RAf; RBf = a.y * RBf + b.y; RAf = a.y * RAf;
                cf[4 * p] = (_Float16)la.x; cf[4 * p + 1] = (_Float16)b.x; cf[4 * p + 2] = (_Float16)la.y; cf[4 * p + 3] = (_Float16)b.y;
                lru_ab2((f32x2){gab[2 * p], gab[2 * p + 1]}, (f32x2){gxb[2 * p], gxb[2 * p + 1]}, x, C.ba_b, C.bx_b, C.sp_b, la, a, b);
                RBb = RAb * b.x + RBb; RAb = RAb * a.x; RBb = RAb * b.y + RBb; RAb = RAb * a.y;
                cbk[4 * p] = (_Float16)la.x; cbk[4 * p + 1] = (_Float16)b.x; cbk[4 * p + 2] = (_Float16)la.y; cbk[4 * p + 3] = (_Float16)b.y; }
            f16x8* cp = LC + ((size_t)(item * 8 + w) * 16 + tau) * 64 + lane;
            __builtin_nontemporal_store(cf, cp); __builtin_nontemporal_store(cbk, cp + 8 * 64); }
#pragma unroll
        for (int st = 0; st < 2; ++st) { const int o = 16 << st; const bool early = ((fq >> st) & 1) == 0;
            const float pAf = __shfl_xor(RAf, o), pBf = __shfl_xor(RBf, o), pAb = __shfl_xor(RAb, o), pBb = __shfl_xor(RBb, o);
            const float XAf = early ? RAf : pAf, XBf = early ? RBf : pBf, YAf = early ? pAf : RAf, YBf = early ? pBf : RBf;
            const float XAb = early ? RAb : pAb, XBb = early ? RBb : pBb, YAb = early ? pAb : RAb, YBb = early ? pBb : RBb;
            RAf = YAf * XAf; RBf = YAf * XBf + YBf; RAb = XAb * YAb; RBb = XAb * YBb + XBb; }
        if (fq == 0) { float* s = SUM + (size_t)chunk * 4096 + ch; s[0] = RAf; s[1024] = RBf; s[2048] = RAb; s[3072] = RBb; }
    }
    WG_BAR();
}
__device__ __forceinline__ void phase_lru_carry(const Frame& F0, const float* SUM, float* CAR) { const Frame F = fresh(F0);
    for (int id = F.bid * 512 + F.tid; id < NB * 2048; id += F.G * 512) { const int s = id >> 11, dir = (id >> 10) & 1, ch = id & 1023;
        const int c0 = s < 2 ? 64 * s : 128 + 32 * (s - 2), nc = s < 2 ? 64 : 32; float h = 0.f;
        for (int j0 = 0; j0 < nc; j0 += 8) { float A[8], B[8];
#pragma unroll
            for (int k = 0; k < 8; ++k) { const int j = dir == 0 ? j0 + k : nc - 1 - (j0 + k); const size_t o = (size_t)(c0 + j) * 4096 + (dir ? 2048 : 0) + ch; A[k] = SUM[o]; B[k] = SUM[o + 1024]; }
#pragma unroll
            for (int k = 0; k < 8; ++k) { const int j = dir == 0 ? j0 + k : nc - 1 - (j0 + k); CAR[(size_t)(c0 + j) * 2048 + (dir ? 1024 : 0) + ch] = h; h = A[k] * h + B[k]; } } }
}
__device__ __forceinline__ void lru_unpack_ab(const f16x8 (&c)[8], float (&a)[32], float (&b)[32]) {
#pragma unroll
    for (int tau = 0; tau < 8; ++tau)
#pragma unroll
        for (int i = 0; i < 4; ++i) { a[4 * tau + i] = __builtin_amdgcn_exp2f((float)c[tau][2 * i] * LOG2E); b[4 * tau + i] = (float)c[tau][2 * i + 1]; }
}
__device__ __forceinline__ void phase_lru2(const Frame& F0, const bf16_t* Z, const f16x8* LC, const float* CAR, bf16_t* MRG, float* SSQL) { const Frame F = fresh(F0);
    const int lane = F.lane, w = F.wave, fr = lane & 15, fq = lane >> 4, n = 7 - (F.bid & 7)  , ch = 128 * n + 16 * w + fr;
    constexpr int NITEM = (T / 128) * 8;
    f16x8 cf_[8], cb_[8]; float cf = 0.f, cbk = 0.f; u32x4 yv[4];
#define LR2_FETCH(it) do { const int chunk_ = (it) >> 3; const f16x8* cp_ = LC + (size_t)((it) * 8 + w) * 16 * 64 + lane; \
        _Pragma("unroll") for (int tau = 0; tau < 8; ++tau) { cf_[tau] = __builtin_nontemporal_load(cp_ + tau * 64); cb_[tau] = __builtin_nontemporal_load(cp_ + (8 + tau) * 64); } \
        cf = CAR[(size_t)chunk_ * 2048 + ch]; cbk = CAR[(size_t)chunk_ * 2048 + 1024 + ch]; \
        _Pragma("unroll") for (int i = 0; i < 4; ++i) { const int p = F.tid + 512 * i, tk = p >> 4, part = p & 15; yv[i] = *(const u32x4*)(Z + (size_t)(chunk_ * 128 + tk) * ZC + ZY + 128 * n + 8 * part); } } while (0)
    if (F.bid < NITEM) LR2_FETCH(NITEM - 1 - F.bid);
    for (int it_ = F.bid; it_ < NITEM; it_ += F.G) { const int item = NITEM - 1 - it_, chunk = item >> 3, row0 = chunk * 128;
        WG_BAR();
#pragma unroll
        for (int i = 0; i < 4; ++i) { const int p = F.tid + 512 * i, tk = p >> 4, part = p & 15; *(LAS u32x4*)(F.lds + LR_YG + tk * LR_YG_ROW + part * 16) = yv[i]; }
        float a[32], b[32], hf[32]; const float cfw = cf, cbw = cbk;
        lru_unpack_ab(cf_, a, b);
        { float IA = 1.f, IB = 0.f;
#pragma unroll
          for (int t = 0; t < 32; ++t) { IB = a[t] * IB + b[t]; IA = a[t] * IA; }
          { const float xA = __shfl_up(IA, 16), xB = __shfl_up(IB, 16); if (fq >= 1) { IB = IA * xB + IB; IA = IA * xA; } }
          { const float xA = __shfl_up(IA, 32), xB = __shfl_up(IB, 32); if (fq >= 2) { IB = IA * xB + IB; IA = IA * xA; } }
          float EA = __shfl_up(IA, 16), EB = __shfl_up(IB, 16); if (fq == 0) { EA = 1.f; EB = 0.f; }
          float h = EA * cfw + EB;
#pragma unroll
          for (int t = 0; t < 32; ++t) { h = a[t] * h + b[t]; hf[t] = h; } }
        lru_unpack_ab(cb_, a, b);
        if (it_ + F.G < NITEM) LR2_FETCH(item - F.G);
        asm volatile("s_waitcnt lgkmcnt(0)" ::: "memory"); __builtin_amdgcn_s_barrier(); asm volatile("" ::: "memory");
        { float IA = 1.f, IB = 0.f;
#pragma unroll
          for (int t = 31; t >= 0; --t) { IB = a[t] * IB + b[t]; IA = a[t] * IA; }
          { const float xA = __shfl_down(IA, 16), xB = __shfl_down(IB, 16); if (fq <= 2) { IB = IA * xB + IB; IA = IA * xA; } }
          { const float xA = __shfl_down(IA, 32), xB = __shfl_down(IB, 32); if (fq <= 1) { IB = IA * xB + IB; IA = IA * xA; } }
          float EA = __shfl_down(IA, 16), EB = __shfl_down(IB, 16); if (fq == 3) { EA = 1.f; EB = 0.f; }
          float h = EA * cbw + EB;
#pragma unroll
          for (int t = 31; t >= 0; --t) { h = a[t] * h + b[t]; LAS bf16_t* yp = (LAS bf16_t*)(F.lds + LR_YG + (32 * fq + t) * LR_YG_ROW + (16 * w + fr) * 2);
              *yp = (bf16_t)f2bf((hf[t] + h) * pg8::gelu_tanh_f(bf2f(*yp))); if ((t & 7) == 0) __builtin_amdgcn_sched_barrier(0); } }
        asm volatile("s_waitcnt lgkmcnt(0)" ::: "memory"); __builtin_amdgcn_s_barrier(); asm volatile("" ::: "memory");
#pragma unroll
        for (int i = 0; i < 4; ++i) { const int p = F.tid + 512 * i, tk = p >> 4, part = p & 15; const u32x4 v = *(const LAS u32x4*)(F.lds + LR_YG + tk * LR_YG_ROW + part * 16);
            *(u32x4*)(MRG + (size_t)(row0 + tk) * D + 1024 + 128 * n + 8 * part) = v;
            float ss = (bflo(v.x) * bflo(v.x) + bfhi(v.x) * bfhi(v.x)) + (bflo(v.y) * bflo(v.y) + bfhi(v.y) * bfhi(v.y)) + (bflo(v.z) * bflo(v.z) + bfhi(v.z) * bfhi(v.z)) + (bflo(v.w) * bflo(v.w) + bfhi(v.w) * bfhi(v.w));
            ss += __shfl_xor(ss, 1); ss += __shfl_xor(ss, 2); ss += __shfl_xor(ss, 4); ss += __shfl_xor(ss, 8); if (part == 0) SSQL[(size_t)(row0 + tk) * 8 + n] = ss; }
    }
#undef LR2_FETCH
    WG_BAR();
}

__device__ __forceinline__ void phase_glu_fix(const Frame& F0, const float* HALO, const float* cw, const float* cb, bf16_t* ACT) { const Frame F = fresh(F0);
    for (int id = F.bid * 512 + F.tid; id < 384 * (DFF / 4); id += F.G * 512) { const int e = id / (DFF / 4), c = (id - e * (DFF / 4)) * 4, pm = e >> 1, side = e & 1, row = 256 * pm + (side ? 255 : 0);
        int b_, t, S; rowinfo(row, b_, t, S);
        const float* hp = HALO + (size_t)pm * 6 * DFF + c; const f32x4 z = (f32x4){0.f, 0.f, 0.f, 0.f};
        f32x4 gp, gc, gn, up;
        if (side == 0) { gp = t == 0 ? z : *(const f32x4*)(hp - 6 * DFF + 3 * DFF); gc = *(const f32x4*)(hp); gn = *(const f32x4*)(hp + DFF); up = *(const f32x4*)(hp + 4 * DFF); }
        else { gp = *(const f32x4*)(hp + 2 * DFF); gc = *(const f32x4*)(hp + 3 * DFF); gn = t == S - 1 ? z : *(const f32x4*)(hp + 6 * DFF); up = *(const f32x4*)(hp + 5 * DFF); }
        const f32x4 g = *(const f32x4*)(cw + c) * gp + *(const f32x4*)(cw + DFF + c) * gc + *(const f32x4*)(cw + 2 * DFF + c) * gn + *(const f32x4*)(cb + c);
        u32x2 o; o.x = pg8::cvt_pk_bf16(pg8::gelu_tanh_f(g[0]) * up[0], pg8::gelu_tanh_f(g[1]) * up[1]); o.y = pg8::cvt_pk_bf16(pg8::gelu_tanh_f(g[2]) * up[2], pg8::gelu_tanh_f(g[3]) * up[3]);
        *(u32x2*)(ACT + (size_t)row * DFF + c) = o; }
}

constexpr int PH_PER_LAYER = 11, PH0 = 2, N_PHASES = PH0 + DEPTH * PH_PER_LAYER;
#ifndef PHMASK
#define PHMASK 0xfff
#endif
#define PEN(k) ((PHMASK >> (k)) & 1)
#ifndef DBLMASK
#define DBLMASK 0
#endif
#define REP(k) for (int rep_ = 0; rep_ < 1 + ((DBLMASK >> (k)) & 1); ++rep_)
__global__ void __launch_bounds__(NWAVES * 64, 2) mega_fwd(Args a) {
    extern __shared__ __attribute__((aligned(16))) unsigned char lds_raw[];
    Frame F; F.lds = (LAS unsigned char*)lds_raw; F.tid = threadIdx.x; F.lane = F.tid & 63; F.wave = __builtin_amdgcn_readfirstlane(F.tid >> 6); F.G = gridDim.x; F.bid = blockIdx.x;
    unsigned char* ws = karg_ws();
    volatile LAS unsigned* MISC = (volatile LAS unsigned*)(F.lds + LDS_CTL);
    if (F.tid < 64) MISC[F.tid] = 0u;
    __syncthreads();
    const int lo = a.ph_lo, hi = a.ph_hi;
    XcdBarrier bar; bar.bar = (unsigned*)(ws + WS_CTL) + CW_BAR; bar.x = 0; bar.st = MISC; bar.wv = F.wave;
    if (hi - lo > 1) bar = xcd_barrier_post((unsigned*)(ws + WS_CTL) + CW_BAR, MISC, F.wave);
#define IN(k) (lo <= (k) && (k) < hi)
#define SEAM(k) do { if (IN(k) && IN((k) + 1)) xcd_barrier(bar); } while (0)
#define WSP(type, off) ((type*)(karg_ws() + (off)))
    PG8_LAS unsigned char* ring = (PG8_LAS unsigned char*)lds_raw;

    if (PEN(0) && IN(0)) { REP(0) phase_prologue(F, a); } SEAM(0);
    if (PEN(11) && IN(1)) { phase_bias(F, WSP(float, WS_MOD), WSP(bf16_t, WS_WIN), WSP(bf16_t, WS_WGU), WSP(float, WS_BIN), WSP(float, WS_BGU)); phase_norm0(F, karg_in(0), karg_in(1), WSP(float, WS_MOD), WSP(bf16_t, WS_H), WSP(float, WS_RSTD)); } SEAM(1);
    for (int l = 0; l < DEPTH; ++l) {
        const int pb = PH0 + PH_PER_LAYER * l;
        const float* bp = l == 0 ? karg_in(0) : karg_out(); const float* bs = l == 0 ? karg_in(1) : karg_out() + (size_t)ROWS_P * D;
        if (PEN(1) && IN(pb + 0)) { if (l > 0) phase_rstd(F, 0, WSP(float, WS_SSQX), WSP(float, WS_RSTD), nullptr, nullptr, nullptr, nullptr); } SEAM(pb + 0);
        if (PEN(2) && IN(pb + 1)) { REP(2) { pg8::Gemm g{WSP(bf16_t, WS_H), WSP(bf16_t, WS_WIN) + (size_t)l * ZC * D, T, ZC, D}; pg8::StaticOrder S; S.init(T, ZC, F.G, F.bid); pg8::EpiStoreBf16N E{WSP(bf16_t, WS_Z), ZC, WSP(float, WS_RSTD), WSP(float, WS_BIN) + (size_t)l * NB * ZC};
            pg8::gemm_phase(ring, g, S, E, pg8::IdentMap{}, F.wave); } } SEAM(pb + 1);
        if (IN(pb + 2)) {
            if (PEN(3)) REP(3) phase_attn(F, WSP(bf16_t, WS_Z), karg_in(10) + l * 128, karg_in(11) + l * 128, karg_in(12) + l * 8, karg_in(4), WSP(bf16_t, WS_MRG), WSP(float, WS_SSQA));
            if (PEN(4)) REP(4) phase_lru1(F, WSP(bf16_t, WS_Z), WSP(bf16_t, WS_LW) + (size_t)l * 512 * 1024, karg_in(13) + (size_t)l * 4096, karg_in(14) + l * 1024, karg_in(16) + l * 2048, karg_in(18) + l * 2048, WSP(float, WS_LSP) + l * 2048, WSP(float, WS_SUM), (f16x8*)karg_out()); } SEAM(pb + 2);
        if (IN(pb + 3)) { if (PEN(5)) REP(5) phase_lru_carry(F, WSP(float, WS_SUM), WSP(float, WS_CAR)); } SEAM(pb + 3);
        if (IN(pb + 4)) { if (PEN(6)) REP(6) phase_lru2(F, WSP(bf16_t, WS_Z), (const f16x8*)karg_out(), WSP(float, WS_CAR), WSP(bf16_t, WS_MRG), WSP(float, WS_SSQL)); } SEAM(pb + 4);
        if (PEN(7) && IN(pb + 5)) { phase_rstd(F, 1, nullptr, nullptr, WSP(float, WS_SSQA), WSP(float, WS_SSQL), WSP(float, WS_RATIO), WSP(float, WS_S2)); } SEAM(pb + 5);
        if (PEN(8) && IN(pb + 6)) for (int rep_ = 0; rep_ < 1 + ((l == 0) ? ((DBLMASK >> 8) & 1) : 0); ++rep_) { const float* modl = WSP(float, WS_MOD) + (size_t)l * NB * MODSTRIDE; pg8::Gemm g{WSP(bf16_t, WS_MRG), WSP(bf16_t, WS_WOUT) + (size_t)l * D * D, T, D, D}; pg8::StaticOrder S; S.init(T, D, F.G, F.bid);
            pg8::EpiResid2<true> E{modl + D, nullptr, modl + 2 * D, modl + 4 * D, WSP(bf16_t, WS_H), WSP(float, WS_SSQX), WSP(float, WS_RATIO), WSP(float, WS_S2)}; pg8::gemm_phase(ring, g, S, E, pg8::IdentMap{}, F.wave); } SEAM(pb + 6);
        if (PEN(1) && IN(pb + 7)) { phase_rstd(F, 0, WSP(float, WS_SSQX), WSP(float, WS_RSTD), nullptr, nullptr, nullptr, nullptr); } SEAM(pb + 7);
        if (IN(pb + 8)) { if (PEN(9)) REP(9) { pg8::Gemm g{WSP(bf16_t, WS_H), WSP(bf16_t, WS_WGU) + (size_t)l * 2 * DFF * D, T, 2 * DFF, D}; pg8::StaticOrder S; S.init(T, 2 * DFF, F.G, F.bid);
            pg8::EpiGLU2 E{WSP(bf16_t, WS_ACT), karg_in(25) + (size_t)l * 3 * DFF, karg_in(26) + l * DFF, WSP(float, WS_RSTD), WSP(float, WS_BGU) + (size_t)l * NB * 2 * DFF, WSP(float, WS_HALO), (PG8_LAS float*)(ring + pg8::STAGE_BYTES)};
            pg8::gemm_phase(ring, g, S, E, pg8::IdentMap{}, F.wave); } } SEAM(pb + 8);
        if (IN(pb + 9)) { if (PEN(9)) phase_glu_fix(F, WSP(float, WS_HALO), karg_in(25) + (size_t)l * 3 * DFF, karg_in(26) + l * DFF, WSP(bf16_t, WS_ACT)); } SEAM(pb + 9);
        if (IN(pb + 10)) { if (PEN(10)) { const float* modl = WSP(float, WS_MOD) + (size_t)l * NB * MODSTRIDE; pg8::Gemm g{WSP(bf16_t, WS_ACT), WSP(bf16_t, WS_WDN) + (size_t)l * D * DFF, T, D, DFF}; pg8::StaticOrder S; S.init(T, D, F.G, F.bid);
            pg8::EpiResid2<false> E{modl + 4 * D, l + 1 < DEPTH ? nullptr : karg_out(), modl + 5 * D, l + 1 < DEPTH ? modl + (size_t)NB * MODSTRIDE + D : nullptr, WSP(bf16_t, WS_H), WSP(float, WS_SSQX), nullptr, nullptr};
            pg8::gemm_phase(ring, g, S, E, pg8::IdentMap{}, F.wave); } } SEAM(pb + 10);
    }
#undef IN
#undef SEAM
}
#ifndef HYB
#define HYB 0
#endif
extern "C" void kernel_launch(void* const* d_in, const int* in_sizes, int n_in, void* d_out, int out_size, void* d_ws, size_t ws_size, hipStream_t stream) {
    static int grid = 0;
    if (grid == 0) {
        if (n_in != 28 || ws_size < WS_END || out_size != T * D) { fprintf(stderr, "kernel_launch: unexpected sizes (n_in %d, ws %zu, out %d)\n", n_in, ws_size, out_size); grid = -1; return; }
        int dev = 0, cus = 0, per_cu = 0;
        if (hipGetDevice(&dev) != hipSuccess || hipDeviceGetAttribute(&cus, hipDeviceAttributeMultiprocessorCount, dev) != hipSuccess) { grid = -1; return; }
        if (hipFuncSetAttribute((const void*)mega_fwd, hipFuncAttributeMaxDynamicSharedMemorySize, LDS_BYTES) != hipSuccess) { fprintf(stderr, "kernel_launch: hipFuncSetAttribute failed\n"); grid = -1; return; }
        if (hipOccupancyMaxActiveBlocksPerMultiprocessor(&per_cu, (const void*)mega_fwd, NWAVES * 64, LDS_BYTES) != hipSuccess || per_cu < 1) { fprintf(stderr, "kernel_launch: occupancy query says %d blocks per CU\n", per_cu); grid = -1; (void)hipGetLastError(); return; }
        grid = cus & ~7;
    }
    if (grid < 0) return;
    (void)hipMemsetAsync((char*)d_ws + WS_CTL, 0, CTL_ZERO_BYTES, stream);
    Args a{};
    for (int i = 0; i < 28; ++i) a.in[i] = (const float*)d_in[i];
    a.out = (float*)d_out; a.ws = (unsigned char*)d_ws; a.flags = 0; a.pad = 0;
#if HYB & 8
    for (int p = 0; p < N_PHASES; ++p) { a.ph_lo = p; a.ph_hi = p + 1; hipLaunchKernelGGL(mega_fwd, dim3(grid), dim3(NWAVES * 64), LDS_BYTES, stream, a); }
#else
    a.ph_lo = 0; a.ph_hi = N_PHASES; hipLaunchKernelGGL(mega_fwd, dim3(grid), dim3(NWAVES * 64), LDS_BYTES, stream, a);
#endif
}
```
